# Optimizing an MI355X kernel written in HIP

```python
import jax, jax.numpy as jnp
from jax import lax
import numpy as np

D_MODEL = 1024
BATCH = 16
SEQ = 2048
DEPTH = 2

HEAD_DIM = 64
D_MIX = D_MODEL
RET_HEADS = 4
GMLP_GROUPS = 4
NSA_HEADS = 8
NSA_KV_HEADS = 2
NSA_GROUP = NSA_HEADS // NSA_KV_HEADS
RET_WIDTH = RET_HEADS * HEAD_DIM
GMLP_WIDTH = GMLP_GROUPS * HEAD_DIM
NSA_WIDTH = NSA_HEADS * HEAD_DIM
KV_WIDTH = NSA_KV_HEADS * HEAD_DIM
N_BRANCH = 3
RET_CHUNK = 128
GMLP_CHUNK = 128
CMP_LEN = 32
CMP_STRIDE = 16
CMP_HIDDEN = 128
SEL_BLOCK = 64
SEL_TOPK = 8
WINDOW = 512
NSA_Q_BLOCK = 64
ROPE_THETA = 10000.0
N_EXPERTS = 16
N_EXPERT_GROUPS = 4
EXPERTS_PER_GROUP = N_EXPERTS // N_EXPERT_GROUPS
EXPERT_TOPK = 2
D_EXPERT = 512
NORM_EPS = 1e-6
NEG_INF = -1e30
FORCE_SCORE = 1e4
IN_SPLITS = (RET_WIDTH, RET_WIDTH, RET_WIDTH, RET_WIDTH, GMLP_WIDTH, GMLP_WIDTH, NSA_WIDTH,
             KV_WIDTH, KV_WIDTH, KV_WIDTH, KV_WIDTH, KV_WIDTH, KV_WIDTH, NSA_HEADS * N_BRANCH)
N_IN = sum(IN_SPLITS)

kernel_name = "hybrid_retention_gmlp_nsa_grouped_moe"


def rms_norm(x, g):
    xf = x.astype(jnp.float32)
    y = xf * lax.rsqrt(jnp.mean(xf * xf, axis=-1, keepdims=True) + NORM_EPS)
    return (y * g.astype(jnp.float32)).astype(x.dtype)


def layer_norm(x, g):
    xf = x.astype(jnp.float32)
    mu = jnp.mean(xf, axis=-1, keepdims=True)
    var = jnp.mean(jnp.square(xf - mu), axis=-1, keepdims=True)
    return ((xf - mu) * lax.rsqrt(var + NORM_EPS) * g.astype(jnp.float32)).astype(x.dtype)


def rope(x, pos):
    half = x.shape[-1] // 2
    inv_freq = jnp.power(ROPE_THETA, -jnp.arange(half, dtype=jnp.float32) / half)
    ang = pos.astype(jnp.float32)[..., None] * inv_freq
    cos = jnp.cos(ang)[:, :, None, :]
    sin = jnp.sin(ang)[:, :, None, :]
    xf = x.astype(jnp.float32)
    x1, x2 = xf[..., :half], xf[..., half:]
    return jnp.concatenate([x1 * cos - x2 * sin, x1 * sin + x2 * cos], axis=-1).astype(x.dtype)


def retention(q, k, v, g, pos, norm_g):
    B, S, H, d = q.shape
    C = RET_CHUNK
    nC = S // C
    dt = q.dtype
    q = rope(q, pos)
    k = rope(k, pos) * (d ** -0.5)
    log_gamma = jnp.log1p(-jnp.power(2.0, -5.0 - jnp.arange(H, dtype=jnp.float32)))
    idx = jnp.arange(C, dtype=jnp.float32)
    diff = idx[:, None] - idx[None, :]
    decay_in = jnp.where(diff >= 0, jnp.exp(jnp.maximum(diff, 0.0)[None] * log_gamma[:, None, None]), 0.0).astype(dt)
    decay_q = jnp.exp((idx + 1.0)[:, None] * log_gamma[None]).astype(dt)
    decay_k = jnp.exp((C - 1.0 - idx)[:, None] * log_gamma[None]).astype(dt)
    decay_chunk = jnp.exp(C * log_gamma).astype(dt)
    qc = q.reshape(B, nC, C, H, d).swapaxes(0, 1)
    kc = k.reshape(B, nC, C, H, d).swapaxes(0, 1)
    vc = v.reshape(B, nC, C, H, d).swapaxes(0, 1)

    def step(state, qkv):
        qb, kb, vb = qkv
        inner = jnp.einsum('bnhd,bmhd->bhnm', qb, kb) * decay_in
        o = jnp.einsum('bhnm,bmhe->bnhe', inner, vb)
        o = o + jnp.einsum('bnhd,bhde->bnhe', qb, state) * decay_q[None, :, :, None]
        state = state * decay_chunk[None, :, None, None] + jnp.einsum('bmhd,bmhe->bhde', kb * decay_k[None, :, :, None], vb)
        return state, o

    state0 = jnp.zeros((B, H, d, d), dt)
    _, o = lax.scan(step, state0, (qc, kc, vc))
    o = rms_norm(o.swapaxes(0, 1).reshape(B, S, H, d), norm_g)
    return o.reshape(B, S, H * d) * jax.nn.silu(g)


def chunked_spatial_gating(u, v, ln_g, w_s, b_s):
    B, S, _ = u.shape
    nC = S // GMLP_CHUNK
    u = jax.nn.gelu(u)
    v = layer_norm(jax.nn.gelu(v), ln_g)
    vc = v.reshape(B, nC, GMLP_CHUNK, GMLP_GROUPS, HEAD_DIM)
    causal = jnp.tril(jnp.ones((GMLP_CHUNK, GMLP_CHUNK), dtype=bool))
    w = jnp.where(causal[None], w_s, 0.0)
    s = jnp.einsum('gts,bnsgc->bntgc', w, vc) + b_s.T[None, None, :, :, None]
    return u * s.reshape(B, S, GMLP_WIDTH)


def compress_blocks(kv, pe, w1, w2):
    B, S, G, d = kv.shape
    chunks = kv.reshape(B, S // CMP_STRIDE, CMP_STRIDE, G, d)
    blocks = jnp.concatenate([chunks[:, :-1], chunks[:, 1:]], axis=2)
    h = jax.nn.gelu(jnp.einsum('bnlgd,ldh->bngh', blocks + pe[None, None, :, None, :], w1))
    return jnp.einsum('bngh,hd->bngd', h, w2)


def masked_softmax(s, mask):
    p = jax.nn.softmax(jnp.where(mask, s.astype(jnp.float32), NEG_INF), axis=-1)
    return p * mask


def native_sparse_attention(q, kc_raw, vc_raw, ks, vs, kw, vw, gate_logits, pos,
                            q_norm_g, k_norm_g, pe_k, pe_v, w1_k, w2_k, w1_v, w2_v):
    B, S, H, d = q.shape
    G, R = NSA_KV_HEADS, NSA_GROUP
    dt = q.dtype
    scale = d ** -0.5
    q = rope(rms_norm(q, q_norm_g), pos)
    kc = compress_blocks(kc_raw, pe_k, w1_k, w2_k)
    vc = compress_blocks(vc_raw, pe_v, w1_v, w2_v)
    kc = rope(rms_norm(kc, k_norm_g[0]), pos[:, CMP_LEN - 1::CMP_STRIDE])
    ks = rope(rms_norm(ks, k_norm_g[1]), pos)
    kw = rope(rms_norm(kw, k_norm_g[2]), pos)
    n_cmp = kc.shape[1]
    n_sel = S // SEL_BLOCK
    top_n = min(SEL_TOPK, n_sel)
    cmp_start = jnp.arange(n_cmp) * CMP_STRIDE
    cmp_end = cmp_start + CMP_LEN - 1
    sel_start = jnp.arange(n_sel) * SEL_BLOCK
    overlap = ((cmp_start[:, None] < sel_start[None] + SEL_BLOCK) & (cmp_start[:, None] + CMP_LEN > sel_start[None])).astype(jnp.float32)
    ks_blk = ks.reshape(B, n_sel, SEL_BLOCK, G, d).transpose(0, 3, 1, 2, 4)
    vs_blk = vs.reshape(B, n_sel, SEL_BLOCK, G, d).transpose(0, 3, 1, 2, 4)
    kw_pad = jnp.pad(kw, ((0, 0), (WINDOW, 0), (0, 0), (0, 0)))
    vw_pad = jnp.pad(vw, ((0, 0), (WINDOW, 0), (0, 0), (0, 0)))
    gates = jax.nn.sigmoid(gate_logits.reshape(B, S, G, R, N_BRANCH))
    n_blk = S // NSA_Q_BLOCK
    q_blocks = q.reshape(B, n_blk, NSA_Q_BLOCK, G, R, d).swapaxes(0, 1)
    g_blocks = gates.reshape(B, n_blk, NSA_Q_BLOCK, G, R, N_BRANCH).swapaxes(0, 1)
    b_ix = jnp.arange(B)[:, None, None, None]
    g_ix = jnp.arange(G)[None, :, None, None]
    sel_off = jnp.arange(SEL_BLOCK)
    win_off = jnp.arange(NSA_Q_BLOCK + WINDOW) - WINDOW
    j = jnp.arange(n_sel)

    def block(args):
        i, qb, gb = args
        t = i * NSA_Q_BLOCK + jnp.arange(NSA_Q_BLOCK)
        s_c = jnp.einsum('bqgrd,bngd->bgrqn', qb, kc) * scale
        p_c = masked_softmax(s_c, cmp_end[None, :] <= t[:, None])
        o_c = jnp.einsum('bgrqn,bngd->bqgrd', p_c.astype(dt), vc)
        imp = jnp.einsum('bgrqn,nj->bgqj', p_c, overlap)
        cur = t // SEL_BLOCK
        forced = (j[None] == 0) | (j[None] == cur[:, None]) | (j[None] == cur[:, None] - 1)
        allowed = sel_start[None] <= t[:, None]
        score = jnp.where(forced, FORCE_SCORE, jnp.where(allowed, imp, -1.0))
        _, idx = lax.top_k(score, top_n)
        k_g = ks_blk[b_ix, g_ix, idx]
        v_g = vs_blk[b_ix, g_ix, idx]
        tok = idx[..., None] * SEL_BLOCK + sel_off
        m_s = (tok <= t[None, None, :, None, None]).reshape(B, G, 1, NSA_Q_BLOCK, top_n * SEL_BLOCK)
        s_s = jnp.einsum('bqgrd,bgqkld->bgrqkl', qb, k_g).reshape(B, G, R, NSA_Q_BLOCK, top_n * SEL_BLOCK) * scale
        p_s = masked_softmax(s_s, m_s).reshape(B, G, R, NSA_Q_BLOCK, top_n, SEL_BLOCK)
        o_s = jnp.einsum('bgrqkl,bgqkld->bqgrd', p_s.astype(dt), v_g)
        start = i * NSA_Q_BLOCK
        k_w = lax.dynamic_slice_in_dim(kw_pad, start, NSA_Q_BLOCK + WINDOW, axis=1)
        v_w = lax.dynamic_slice_in_dim(vw_pad, start, NSA_Q_BLOCK + WINDOW, axis=1)
        spos = start + win_off
        m_w = (spos[None] <= t[:, None]) & (t[:, None] - spos[None] < WINDOW) & (spos[None] >= 0)
        s_w = jnp.einsum('bqgrd,bsgd->bgrqs', qb, k_w) * scale
        p_w = masked_softmax(s_w, m_w)
        o_w = jnp.einsum('bgrqs,bsgd->bqgrd', p_w.astype(dt), v_w)
        return gb[..., 0:1] * o_c + gb[..., 1:2] * o_s + gb[..., 2:3] * o_w

    out = lax.map(block, (jnp.arange(n_blk), q_blocks, g_blocks))
    return out.swapaxes(0, 1).reshape(B, S, H * d)


def grouped_moe(h, router_w, router_b, w_gate, w_up, w_down):
    B, S, D = h.shape
    probs = jax.nn.softmax((h @ router_w).astype(jnp.float32), axis=-1)
    sel = (probs + router_b.astype(jnp.float32)).reshape(B, S, N_EXPERT_GROUPS, EXPERTS_PER_GROUP)
    group_score = jnp.sum(lax.top_k(sel, EXPERT_TOPK)[0], axis=-1)
    best_group = jnp.argmax(group_score, axis=-1)
    in_group = (best_group[..., None] == jnp.arange(N_EXPERT_GROUPS))[..., None]
    sel = jnp.where(in_group, sel, NEG_INF).reshape(B, S, N_EXPERTS)
    _, top_idx = lax.top_k(sel, EXPERT_TOPK)
    top_w = jnp.take_along_axis(probs, top_idx, axis=-1)
    top_w = top_w / jnp.sum(top_w, axis=-1, keepdims=True)
    gates = jnp.einsum('bske,bsk->bse', jax.nn.one_hot(top_idx, N_EXPERTS, dtype=jnp.float32), top_w).astype(h.dtype)
    out = jnp.zeros_like(h)
    for e in range(N_EXPERTS):
        a = jax.nn.silu(h @ w_gate[e]) * (h @ w_up[e])
        out = out + (gates[..., e:e + 1] * a) @ w_down[e]
    return out


def setup_inputs(seed: int = 0) -> dict:
    key = jax.random.key(seed)
    ks = jax.random.split(key, 32)
    f32 = jnp.float32
    nrm = lambda k, shape, s: jax.random.normal(k, shape, f32) * s
    L = DEPTH
    return {
        "x": nrm(ks[0], (BATCH, SEQ, D_MODEL), 1.0),
        "c": nrm(ks[1], (BATCH, D_MODEL), 1.0),
        "positions": (jnp.arange(SEQ, dtype=jnp.int32)[None, :] + jax.random.randint(ks[2], (BATCH, 1), 0, 1024, dtype=jnp.int32)),
        "ada_w": nrm(ks[3], (L, D_MODEL, 6 * D_MODEL), 0.5 * D_MODEL ** -0.5),
        "ada_b": nrm(ks[4], (L, 6 * D_MODEL), 0.02),
        "norm_mix_g": 1.0 + nrm(ks[5], (L, D_MODEL), 0.05),
        "norm_ffn_g": 1.0 + nrm(ks[6], (L, D_MODEL), 0.05),
        "w_in": nrm(ks[7], (L, D_MODEL, N_IN), D_MODEL ** -0.5),
        "w_out": nrm(ks[8], (L, D_MIX, D_MODEL), D_MIX ** -0.5),
        "ret_norm_g": 1.0 + nrm(ks[9], (L, RET_HEADS, HEAD_DIM), 0.05),
        "gmlp_ln_g": 1.0 + nrm(ks[10], (L, GMLP_WIDTH), 0.05),
        "gmlp_ws": nrm(ks[11], (L, GMLP_GROUPS, GMLP_CHUNK, GMLP_CHUNK), GMLP_CHUNK ** -0.5),
        "gmlp_b": 1.0 + nrm(ks[12], (L, GMLP_GROUPS, GMLP_CHUNK), 0.05),
        "nsa_q_norm_g": 1.0 + nrm(ks[13], (L, HEAD_DIM), 0.05),
        "nsa_k_norm_g": 1.0 + nrm(ks[14], (L, N_BRANCH, HEAD_DIM), 0.05),
        "cmp_pe_k": nrm(ks[15], (L, CMP_LEN, HEAD_DIM), 0.1),
        "cmp_pe_v": nrm(ks[16], (L, CMP_LEN, HEAD_DIM), 0.1),
        "cmp_w1_k": nrm(ks[17], (L, CMP_LEN, HEAD_DIM, CMP_HIDDEN), (CMP_LEN * HEAD_DIM) ** -0.5),
        "cmp_w2_k": nrm(ks[18], (L, CMP_HIDDEN, HEAD_DIM), CMP_HIDDEN ** -0.5),
        "cmp_w1_v": nrm(ks[19], (L, CMP_LEN, HEAD_DIM, CMP_HIDDEN), (CMP_LEN * HEAD_DIM) ** -0.5),
        "cmp_w2_v": nrm(ks[20], (L, CMP_HIDDEN, HEAD_DIM), CMP_HIDDEN ** -0.5),
        "router_w": nrm(ks[21], (D_MODEL, N_EXPERTS), D_MODEL ** -0.5),
        "router_b": nrm(ks[22], (N_EXPERTS,), 0.01),
        "moe_w_gate": nrm(ks[23], (L, N_EXPERTS, D_MODEL, D_EXPERT), D_MODEL ** -0.5),
        "moe_w_up": nrm(ks[24], (L, N_EXPERTS, D_MODEL, D_EXPERT), D_MODEL ** -0.5),
        "moe_w_down": nrm(ks[25], (L, N_EXPERTS, D_EXPERT, D_MODEL), D_EXPERT ** -0.5),
    }


def reference(x, c, positions, ada_w, ada_b, norm_mix_g, norm_ffn_g, w_in, w_out,
              ret_norm_g, gmlp_ln_g, gmlp_ws, gmlp_b, nsa_q_norm_g, nsa_k_norm_g,
              cmp_pe_k, cmp_pe_v, cmp_w1_k, cmp_w2_k, cmp_w1_v, cmp_w2_v,
              router_w, router_b, moe_w_gate, moe_w_up, moe_w_down):
    B, S, _ = x.shape
    offsets = [int(o) for o in np.cumsum(IN_SPLITS)[:-1]]
    for l in range(DEPTH):
        mod = jax.nn.silu(c) @ ada_w[l] + ada_b[l]
        sh1, sc1, g1, sh2, sc2, g2 = [m[:, None, :] for m in jnp.split(mod, 6, axis=-1)]
        h = rms_norm(x, norm_mix_g[l]) * (1.0 + sc1) + sh1
        z = h @ w_in[l]
        rq, rk, rv, rg, gu, gv, nq, kc, vc, kse, vse, kwi, vwi, gl = jnp.split(z, offsets, axis=-1)
        head = lambda a, n: a.reshape(B, S, n, HEAD_DIM)
        y_ret = retention(head(rq, RET_HEADS), head(rk, RET_HEADS), head(rv, RET_HEADS), rg, positions, ret_norm_g[l])
        y_gmlp = chunked_spatial_gating(gu, gv, gmlp_ln_g[l], gmlp_ws[l], gmlp_b[l])
        y_nsa = native_sparse_attention(
            head(nq, NSA_HEADS), head(kc, NSA_KV_HEADS), head(vc, NSA_KV_HEADS),
            head(kse, NSA_KV_HEADS), head(vse, NSA_KV_HEADS), head(kwi, NSA_KV_HEADS), head(vwi, NSA_KV_HEADS),
            gl, positions, nsa_q_norm_g[l], nsa_k_norm_g[l],
            cmp_pe_k[l], cmp_pe_v[l], cmp_w1_k[l], cmp_w2_k[l], cmp_w1_v[l], cmp_w2_v[l])
        y = jnp.concatenate([y_ret, y_gmlp, y_nsa], axis=-1) @ w_out[l]
        x = x + g1 * y
        h2 = rms_norm(x, norm_ffn_g[l]) * (1.0 + sc2) + sh2
        x = x + g2 * grouped_moe(h2, router_w, router_b, moe_w_gate[l], moe_w_up[l], moe_w_down[l])
    return x
```

```cpp
#include <hip/hip_runtime.h>
#include <cstdio>
#include <cstdint>
#define HD __device__ __attribute__((always_inline))
__device__ __forceinline__ int tid_fresh() { int t = threadIdx.x; asm volatile("" : "+v"(t)); return t; }
__device__ __forceinline__ int bid_fresh() { int t = blockIdx.x; asm volatile("" : "+s"(t)); return t; }
__device__ __forceinline__ int grid_fresh() { int t = gridDim.x; asm volatile("" : "+s"(t)); return t; }
#ifndef CFG_B
#define CFG_B 16
#endif
#ifndef CFG_S
#define CFG_S 2048
#endif
constexpr int NB = CFG_B, NS = CFG_S, M = NB * NS, D = 1024, NIN = 2840, ZW = 2816, NL = 2;
constexpr int C_RQ = 0, C_RK = 256, C_RV = 512, C_RG = 768, C_GU = 1024, C_GV = 1280, C_NQ = 1536, C_KC = 2048, C_VC = 2176,
              C_KS = 2304, C_VS = 2432, C_KW = 2560, C_VW = 2688;
constexpr int NCMP = NS / 16 - 1, NSEL = NS / 64, NCH = NS / 128;
constexpr float EPS = 1e-6f;

typedef unsigned short bf16;
HD inline bf16 f2bf(float f) { unsigned u = __builtin_bit_cast(unsigned, f); u += 0x7FFFu + ((u >> 16) & 1u); return (bf16)(u >> 16); }
HD inline float bf2f(bf16 b) { return __builtin_bit_cast(float, ((unsigned)b) << 16); }
HD inline float silu_f(float x) { return x / (1.f + expf(-x)); }
HD inline float sigm_f(float x) { return 1.f / (1.f + expf(-x)); }
HD inline float gelu_f(float x) { return 0.5f * x * (1.f + tanhf(0.7978845608028654f * (x + 0.044715f * x * x * x))); }
#ifndef HOST_EMU
__device__ __forceinline__ float gelu_fast(float x) { const float u = 1.5957691216057308f * (x + 0.044715f * x * x * x); return x * __builtin_amdgcn_rcpf(1.f + __expf(-u)); }
__device__ __forceinline__ float silu_fast(float x) { return x * __builtin_amdgcn_rcpf(1.f + __expf(-x)); }
#endif
HD inline float invfreq(int i) { return exp2f(-(float)i * (13.287712379549449f / 32.f)); }

constexpr size_t MiB = 1u << 20;
constexpr size_t al(size_t x) { return (x + 255) & ~(size_t)255; }
constexpr size_t WS_CTL = 0;
constexpr int CW_BAR = 4096, CW_CNT = 16384;
constexpr size_t WS_MOD = 1 * MiB;
constexpr size_t WS_RS = WS_MOD + al((size_t)NL * NB * 6144 * 4);
constexpr size_t WS_GL = WS_RS + al((size_t)M * 4);
constexpr size_t WS_LOG = WS_GL + al((size_t)M * 24 * 4);
constexpr size_t WS_ROUT = WS_LOG + al((size_t)M * 16 * 4);
constexpr size_t WS_KC = WS_ROUT + al((size_t)M * 16);
constexpr size_t WS_VC = WS_KC + al((size_t)NB * 2 * (NCMP + 1) * 64 * 2);
constexpr size_t WS_HID = WS_VC + al((size_t)NB * 2 * (NCMP + 1) * 64 * 2);
constexpr size_t WS_CRAW = WS_HID + al((size_t)NB * NCMP * 4 * 128 * 4);
constexpr size_t WS_SEL = WS_CRAW + al((size_t)NB * NCMP * 4 * 64 * 4);
constexpr size_t WS_CS = WS_SEL + al((size_t)M * 16 * 4);
constexpr size_t WS_CSB = WS_CS + al((size_t)M * 64 * 4);
constexpr size_t WS_PEB = WS_CSB + al((size_t)M * 64 * 2);
constexpr size_t WS_BND = WS_PEB + 4096;
constexpr size_t WS_KVS = WS_BND + 256;
constexpr size_t WS_CTOK = WS_KVS + al((size_t)NB * 4 * NCH * 4096 * 4);
constexpr size_t WS_CWT = WS_CTOK + al((size_t)24 * M * 4);
constexpr size_t WS_WIN_T = WS_CWT + al((size_t)24 * M * 8);
constexpr size_t WS_WGL_T = WS_WIN_T + al((size_t)NL * ZW * D * 2);
constexpr size_t WS_WOUT_T = WS_WGL_T + al((size_t)NL * 32 * D * 2);
constexpr size_t WS_WGU_T = WS_WOUT_T + al((size_t)NL * D * D * 2);
constexpr size_t WS_WD_T = WS_WGU_T + al((size_t)NL * 16 * 1024 * D * 2);
constexpr size_t WS_CW1_T = WS_WD_T + al((size_t)NL * 16 * D * 512 * 2);
constexpr size_t WS_CW2_T = WS_CW1_T + al((size_t)NL * 2 * 256 * 1024 * 2);
constexpr size_t WS_GWS = WS_CW2_T + al((size_t)NL * 2 * 64 * 128 * 2);
constexpr size_t WS_H = al(WS_GWS + (size_t)NL * 4 * 128 * 128 * 2);
constexpr size_t WS_Z = WS_H + al((size_t)M * D * 2);
constexpr size_t WS_XB = WS_Z + 88 * MiB;
constexpr size_t WS_MIX = WS_Z + al((size_t)M * ZW * 2);
constexpr size_t WS_END = WS_MIX + al((size_t)M * D * 2);
constexpr size_t WS_PB = WS_END;
constexpr size_t WS_END_NAIVE = WS_PB + al((size_t)M * 2 * 128 * 4);
constexpr size_t WS_YN = WS_H;
constexpr size_t WS_ACTN = WS_Z;
static_assert(WS_XB + (size_t)M * D * 2 <= WS_Z + (size_t)M * ZW * 2, "XB must fit in Z above ACT");
static_assert(CFG_B != 16 || CFG_S != 2048 || WS_END <= 512 * MiB, "workspace map exceeds 512 MiB");

struct P {
    const float *x, *c; const int* pos;
    const float *ada_w, *ada_b, *norm_mix_g, *norm_ffn_g, *w_in, *w_out, *ret_norm_g, *gmlp_ln_g, *gmlp_ws, *gmlp_b, *nsa_q_norm_g, *nsa_k_norm_g,
        *cmp_pe_k, *cmp_pe_v, *cmp_w1_k, *cmp_w2_k, *cmp_w1_v, *cmp_w2_v, *router_w, *router_b, *moe_w_gate, *moe_w_up, *moe_w_down;
    float* out; unsigned char* ws;
};
struct Rout { int e0, e1; float w0, w1; };

#define WSP(T, off) ((T*)(p.ws + (off)))

#define XB_TMO      128
#define XB_XCNT(j)  (256  + 64 * (j))
#define XB_XSUB(j)  (1280 + 64 * (j))
#define XB_XGEN(j)  (2304 + 64 * (j))
#define XB_TOP      3328
#define XB_TOPGEN   3392
#define XCD_BAR_WORDS 3456
#ifndef XB_SPIN_CAP
#define XB_SPIN_CAP (1u << 15)
#endif
#define LAS __attribute__((address_space(3)))
__device__ __forceinline__ unsigned xb_ld(unsigned* p)              { return __hip_atomic_load(p, __ATOMIC_RELAXED, __HIP_MEMORY_SCOPE_AGENT); }
__device__ __forceinline__ unsigned xb_add(unsigned* p, unsigned v) { return __hip_atomic_fetch_add(p, v, __ATOMIC_RELAXED, __HIP_MEMORY_SCOPE_AGENT); }
__device__ __forceinline__ unsigned xb_xcc_id() { return (unsigned)__builtin_amdgcn_s_getreg((3 << 11) | 20) & 0xFu; }
#define XB_SPIN(cond, bar) do { unsigned _sp = 0; while (cond) { __builtin_amdgcn_s_sleep(1); \
    if ((++_sp & 255u) == 0u) { if (xb_ld(&(bar)[XB_TMO])) break; if (_sp > XB_SPIN_CAP) { atomicAdd(&(bar)[XB_TMO], 1u); break; } } } } while (0)
struct XcdBarrier { unsigned* bar; unsigned x; volatile LAS unsigned* st; };
__device__ __forceinline__ XcdBarrier xcd_barrier_post(unsigned* bar, volatile LAS unsigned* st) {
    XcdBarrier b; b.bar = bar; b.x = xb_xcc_id(); b.st = st;
    if (threadIdx.x == 0) (void)xb_add(&bar[XB_XCNT(b.x)], 1u);
    return b;
}
__device__ __forceinline__ void xcd_barrier_complete(unsigned* bar, unsigned x, unsigned& nloc, unsigned& nx) {
    const unsigned G = gridDim.x * gridDim.y * gridDim.z;
    unsigned sum, cnt, mine, sp = 0u;
    for (;;) {
        sum = 0u; cnt = 0u; mine = 0u;
#pragma unroll
        for (unsigned j = 0; j < 16; ++j) { const unsigned c = xb_ld(&bar[XB_XCNT(j)]); sum += c; cnt += (c > 0u) ? 1u : 0u; mine = (j == x) ? c : mine; }
        if (sum == G) break;
        __builtin_amdgcn_s_sleep(1);
        if ((++sp & 255u) == 0u) { if (xb_ld(&bar[XB_TMO])) break; if (sp > XB_SPIN_CAP) { atomicAdd(&bar[XB_TMO], 1u); break; } }
    }
    nloc = mine > 0u ? mine : 1u; nx = cnt > 0u ? cnt : 1u;
}
__device__ __forceinline__ void xcd_barrier(const XcdBarrier& b) {
    asm volatile("s_waitcnt vmcnt(0)" ::: "memory");
    __syncthreads();
    if (threadIdx.x == 0) {
        unsigned* bar = b.bar;
        __builtin_amdgcn_s_waitcnt(0);
        unsigned nloc = b.st[0], nx = b.st[1];
        if (nloc == 0u) { xcd_barrier_complete(bar, b.x, nloc, nx); b.st[0] = nloc; b.st[1] = nx; }
        const unsigned old = xb_add(&bar[XB_XSUB(b.x)], 1u);
        const unsigned gen = old / nloc;
        if (old + 1u == (gen + 1u) * nloc) {
            __builtin_amdgcn_fence(__ATOMIC_RELEASE, "agent");
            asm volatile("s_waitcnt vmcnt(0)" ::: "memory");
            const unsigned og = xb_add(&bar[XB_TOP], 1u);
            const unsigned tg = og / nx;
            if (og + 1u == (tg + 1u) * nx) xb_add(&bar[XB_TOPGEN], 1u);
            else XB_SPIN(xb_ld(&bar[XB_TOPGEN]) == tg, bar);
            __builtin_amdgcn_fence(__ATOMIC_ACQUIRE, "agent");
            xb_add(&bar[XB_XGEN(b.x)], 1u);
            asm volatile("s_waitcnt vmcnt(0)" ::: "memory");
        } else {
            XB_SPIN(xb_ld(&bar[XB_XGEN(b.x)]) == gen, bar);
            __builtin_amdgcn_fence(__ATOMIC_ACQUIRE, "agent");
            asm volatile("s_waitcnt vmcnt(0)" ::: "memory");
        }
    }
    __syncthreads();
}
namespace pg8 {
#define PG8_LAS __attribute__((address_space(3)))
typedef short bf16x8 __attribute__((ext_vector_type(8)));
typedef float f32x4 __attribute__((ext_vector_type(4)));
typedef float f32x2 __attribute__((ext_vector_type(2)));
typedef unsigned u32x4 __attribute__((ext_vector_type(4)));
typedef unsigned u32x2 __attribute__((ext_vector_type(2)));
constexpr int BM = 256, BK = 64, HALF = 128, HTB = HALF * BK * 2, STAGE_BYTES = 8 * HTB, NXCD = 8, WGM = 8;
__device__ __forceinline__ int lds_byte(int r, int c) { const int st = (r >> 4) * 2 + (c >> 5), rr = r & 15, cc = c & 31, ob = rr * 64 + cc * 2; return st * 1024 + (ob ^ (((ob >> 9) & 1) << 5)); }
__device__ __forceinline__ void stage_rc(int b, int& R, int& C) { const int st = b / 1024, sb = b % 1024, swz = sb ^ (((sb >> 9) & 1) << 5); R = (st >> 1) * 16 + swz / 64; C = (st & 1) * 32 + (swz % 64) / 2; }
__device__ __forceinline__ int perm32(int rho) { const int n = rho >> 4, i = rho & 15; return 8 * (i >> 2) + 4 * n + (i & 3); }
__device__ __forceinline__ unsigned cvt_pk_bf16(float lo, float hi) { unsigned r; asm volatile("v_cvt_pk_bf16_f32 %0, %1, %2" : "=v"(r) : "v"(lo), "v"(hi)); return r; }

struct Unit { int pm, pn, aux, half; };
__device__ __forceinline__ bool deal_unit(int i, int G, int c, int U, int& L, int& half) {
    const int F = (U / G) * G, R = U - F; const long Li = (long)i * G + c; half = 0;
    if (Li < F) { L = (int)Li; return true; }
    if (R == 0 || i > U / G) return false;
    if (2 * R <= G) { if (c >= 2 * R) return false; L = F + (c >> 1); half = 1 + (c & 1); return true; }
    if (Li >= U) return false; L = (int)Li; return true; }
struct StaticSched {
    static constexpr bool GATHER = false; static constexpr int GOFF_LDS = 0;
    const char* A; const char* Bt; int K, nM, nN, nwg, G, c;
    __device__ void init(const void* A_, const void* Bt_, int M_, int N_, int K_, int G_, int c_) { A = (const char*)A_; Bt = (const char*)Bt_; K = K_; nM = M_ / BM; nN = N_ / BM; nwg = nM * nN; G = G_; c = c_; }
    __device__ __forceinline__ bool next(int i, Unit& u) const {
        int L, hf; if (!deal_unit(i, G, c, nwg, L, hf)) return false; u.half = hf;
        int wgid = L; { const int q = nwg / NXCD, r = nwg % NXCD, xcd = wgid % NXCD, off = wgid / NXCD; wgid = (xcd < r ? xcd * (q + 1) : r * (q + 1) + (xcd - r) * q) + off; }
        const int nig = WGM * nN, gid = wgid / nig, fm = gid * WGM, gsz = (nM - fm) < WGM ? (nM - fm) : WGM;
        u.pm = fm + ((wgid % nig) % gsz); u.pn = (wgid % nig) / gsz; u.aux = 0; return true;
    }
    __device__ __forceinline__ int ktiles() const { return K / BK; }
    __device__ __forceinline__ const char* a_base() const { return A; }
    __device__ __forceinline__ size_t a_kstep() const { return BK * 2; }
    __device__ __forceinline__ unsigned a_off(const Unit& u, int row, int C) const { return (unsigned)((u.pm * BM + row) * K + C) * 2u; }
    __device__ __forceinline__ unsigned b_ld() const { return (unsigned)K * 2u; }
    __device__ __forceinline__ const char* b_tile(const Unit& u, int t) const { return Bt + (size_t)u.pn * BM * K * 2 + (size_t)t * (BK * 2); }
};

#ifndef PG8_SP2
#define PG8_SP2 true
#endif
#ifndef PG8_ALIGN
#define PG8_ALIGN true
#endif
template <class Epi, class Sched, bool SP2 = PG8_SP2, bool ALIGN_EPI = PG8_ALIGN>
__device__ __forceinline__ void gemm_phase(PG8_LAS unsigned char* lds, const Sched& S, const Epi& E) {
    const int tid = tid_fresh(), wid = __builtin_amdgcn_readfirstlane(tid >> 6), lane = tid & 63, wr = wid >> 2, wc = wid & 3, fr = lane & 15, fq = lane >> 4;
    const int nt = S.ktiles();
    unsigned voffB[2];
    const unsigned ldb = S.b_ld();
#pragma unroll
    for (int i = 0; i < 2; ++i) { int R, C; stage_rc(tid * 16 + i * 8192, R, C); const int Rb = Epi::PERM ? ((R & ~31) + perm32(R & 31)) : R; voffB[i] = (unsigned)Rb * ldb + (unsigned)C * 2u; }
    const unsigned hstepB = (unsigned)HALF * ldb;
    const unsigned ldsw = (unsigned)wid * 1024u;
    const int aoff = lds_byte(wr * 64 + fr, fq * 8), boff = lds_byte(wc * 32 + fr, fq * 8);
    const char* gA = S.a_base(); const size_t akst = S.a_kstep();
#define PG8_SA(b, h) (((b) * 2 + (h)) * HTB)
#define PG8_SB(b, h) ((4 + (b) * 2 + (h)) * HTB)
#define PG8_STAGE_A(bufoff, offarr, h, tt) do { _Pragma("unroll") for (int _i = 0; _i < 2; ++_i) \
        __builtin_amdgcn_global_load_lds((const unsigned*)(gA + (size_t)(tt) * akst + (offarr)[h][_i]), (PG8_LAS unsigned*)(lds + (bufoff) + ldsw + _i * 8192), 16, 0, 0); } while (0)
#define PG8_STAGE_B(bufoff, bptr, h) do { _Pragma("unroll") for (int _i = 0; _i < 2; ++_i) \
        __builtin_amdgcn_global_load_lds((const unsigned*)((bptr) + (h) * hstepB + voffB[_i]), (PG8_LAS unsigned*)(lds + (bufoff) + ldsw + _i * 8192), 16, 0, 0); } while (0)
#define PG8_LDA(dst, b, h) do { _Pragma("unroll") for (int m = 0; m < 4; ++m) _Pragma("unroll") for (int k = 0; k < 2; ++k) dst[m][k] = *(const PG8_LAS bf16x8*)(lds + PG8_SA(b, h) + aoff + m * 2048 + k * 1024); } while (0)
#define PG8_LDB(dst, b, h) do { _Pragma("unroll") for (int n = 0; n < 2; ++n) _Pragma("unroll") for (int k = 0; k < 2; ++k) dst[n][k] = *(const PG8_LAS bf16x8*)(lds + PG8_SB(b, h) + boff + n * 2048 + k * 1024); } while (0)
#define PG8_MMA(ai, bj, At, Bt) do { __builtin_amdgcn_s_setprio(1); _Pragma("unroll") for (int m = 0; m < 4; ++m) _Pragma("unroll") for (int n = 0; n < 2; ++n) _Pragma("unroll") for (int k = 0; k < 2; ++k) \
        acc[ai][bj][m][n] = __builtin_amdgcn_mfma_f32_16x16x32_bf16(Bt[n][k], At[m][k], acc[ai][bj][m][n], 0, 0, 0); __builtin_amdgcn_s_setprio(0); } while (0)
#define PG8_WAIT_V(n) asm volatile("s_waitcnt vmcnt(" #n ")" ::: "memory")
#define PG8_WAIT_L(n) asm volatile("s_waitcnt lgkmcnt(" #n ")" ::: "memory")
#define PG8_BAR __builtin_amdgcn_s_barrier()
#define PG8_SCHED __builtin_amdgcn_sched_barrier(0)
#define PG8_AOFFS(dst, u) do { _Pragma("unroll") for (int _i = 0; _i < 2; ++_i) { int _R, _C; stage_rc(tid * 16 + _i * 8192, _R, _C); _Pragma("unroll") for (int _h = 0; _h < 2; ++_h) dst[_h][_i] = S.a_off(u, ((u).half ? ((u).half == 2 ? HALF : 0) : _h * HALF) + _R, _C); } } while (0)
#define PG8_NOFF_PUT() do { *(PG8_LAS u32x4*)(lds + Sched::GOFF_LDS + tid * 16) = (u32x4){noff[0][0], noff[0][1], noff[1][0], noff[1][1]}; } while (0)
#define PG8_NOFF_GET(dst) do { const u32x4 _v = *(const PG8_LAS u32x4*)(lds + Sched::GOFF_LDS + tid * 16); dst[0][0] = _v.x; dst[0][1] = _v.y; dst[1][0] = _v.z; dst[1][1] = _v.w; } while (0)
    Unit cur, nxt; int ui = 0;
    if (!S.next(0, cur)) return;
    f32x4 acc[2][2][4][2];
#pragma unroll
    for (int a = 0; a < 2; ++a)
#pragma unroll
        for (int b = 0; b < 2; ++b)
#pragma unroll
            for (int m = 0; m < 4; ++m)
#pragma unroll
                for (int n = 0; n < 2; ++n) acc[a][b][m][n] = (f32x4){0.f, 0.f, 0.f, 0.f};
    bf16x8 At[4][2], B0[2][2], B1[2][2];
    constexpr bool GATHER = Sched::GATHER;
    unsigned coff[2][2], noff[2][2];
    PG8_AOFFS(coff, cur);
    { const char* b0 = S.b_tile(cur, 0); const char* b1 = S.b_tile(cur, 1);
      if constexpr (SP2) {
      PG8_STAGE_B(PG8_SB(0, 0), b0, 0); PG8_STAGE_B(PG8_SB(0, 1), b0, 1); PG8_STAGE_A(PG8_SA(0, 0), coff, 0, 0); PG8_STAGE_A(PG8_SA(0, 1), coff, 1, 0);
      if (wr == 1) PG8_BAR;
      PG8_WAIT_V(2); PG8_BAR;
      PG8_STAGE_B(PG8_SB(1, 0), b1, 0); PG8_STAGE_A(PG8_SA(1, 0), coff, 0, 1); PG8_STAGE_B(PG8_SB(1, 1), b1, 1);
      PG8_WAIT_V(6); PG8_BAR;
      } else {
      PG8_STAGE_B(PG8_SB(0, 0), b0, 0); PG8_STAGE_A(PG8_SA(0, 0), coff, 0, 0); PG8_STAGE_B(PG8_SB(0, 1), b0, 1); PG8_STAGE_A(PG8_SA(0, 1), coff, 1, 0);
      if (wr == 1) PG8_BAR;
      PG8_WAIT_V(4); PG8_BAR;
      PG8_STAGE_B(PG8_SB(1, 0), b1, 0); PG8_STAGE_A(PG8_SA(1, 0), coff, 0, 1); PG8_STAGE_B(PG8_SB(1, 1), b1, 1);
      PG8_WAIT_V(6); PG8_BAR; } }
    for (;;) {
        const bool has_next = S.next(ui + 1, nxt);
        if (has_next) { if constexpr (GATHER) { PG8_AOFFS(noff, nxt); PG8_NOFF_PUT(); } }
        else { nxt = cur;
#pragma unroll
            for (int _h = 0; _h < 2; ++_h)
#pragma unroll
                for (int _i = 0; _i < 2; ++_i) if constexpr (GATHER) noff[_h][_i] = coff[_h][_i]; if constexpr (GATHER) PG8_NOFF_PUT(); }
        for (int t = 0; t < nt; t += 2) {
            const bool last = (t == nt - 2);
            const int t2 = last ? 0 : t + 2, t3 = t2 + 1;
            const char* b2 = last ? S.b_tile(nxt, 0) : S.b_tile(cur, t + 2);
            const char* b3 = last ? S.b_tile(nxt, 1) : S.b_tile(cur, t + 3);
            unsigned o2[2][2];
            if constexpr (GATHER) {
#pragma unroll
                for (int _h = 0; _h < 2; ++_h)
#pragma unroll
                    for (int _i = 0; _i < 2; ++_i) o2[_h][_i] = coff[_h][_i];
                if (last) PG8_NOFF_GET(o2); }
            else { if (last) PG8_AOFFS(o2, nxt); else PG8_AOFFS(o2, cur); PG8_AOFFS(coff, cur); }
            if constexpr (SP2) {
            PG8_LDB(B0, 0, 0); PG8_LDB(B1, 0, 1); PG8_SCHED; PG8_LDA(At, 0, 0); PG8_STAGE_A(PG8_SA(1, 1), coff, 1, t + 1);
            PG8_WAIT_V(8); PG8_WAIT_L(0); PG8_BAR; PG8_MMA(0, 0, At, B0); PG8_MMA(0, 1, At, B1); PG8_BAR; PG8_SCHED;
            PG8_LDA(At, 0, 1); PG8_STAGE_B(PG8_SB(0, 0), b2, 0); PG8_STAGE_B(PG8_SB(0, 1), b2, 1); PG8_STAGE_A(PG8_SA(0, 0), o2, 0, t2);
            PG8_WAIT_V(8); PG8_WAIT_L(0); PG8_BAR; if (!cur.half) { PG8_MMA(1, 0, At, B0); PG8_MMA(1, 1, At, B1); } PG8_BAR; PG8_SCHED;
            PG8_LDB(B0, 1, 0); PG8_LDB(B1, 1, 1); PG8_SCHED; PG8_LDA(At, 1, 0); PG8_STAGE_A(PG8_SA(0, 1), o2, 1, t2);
            PG8_WAIT_V(8); PG8_WAIT_L(0); PG8_BAR; PG8_MMA(0, 0, At, B0); PG8_MMA(0, 1, At, B1); PG8_BAR; PG8_SCHED;
            PG8_LDA(At, 1, 1); PG8_STAGE_B(PG8_SB(1, 0), b3, 0); PG8_STAGE_B(PG8_SB(1, 1), b3, 1); PG8_STAGE_A(PG8_SA(1, 0), o2, 0, t3);
            PG8_WAIT_V(8); PG8_WAIT_L(0); PG8_BAR; if (!cur.half) { PG8_MMA(1, 0, At, B0); PG8_MMA(1, 1, At, B1); } PG8_BAR; PG8_SCHED;
            } else {
            PG8_LDB(B0, 0, 0); PG8_SCHED; PG8_LDA(At, 0, 0); PG8_STAGE_A(PG8_SA(1, 1), coff, 1, t + 1);
            PG8_WAIT_L(8); PG8_BAR; PG8_WAIT_L(0); PG8_MMA(0, 0, At, B0); PG8_BAR; PG8_SCHED;
            PG8_LDB(B1, 0, 1); PG8_STAGE_B(PG8_SB(0, 0), b2, 0);
            PG8_BAR; PG8_WAIT_L(0); PG8_MMA(0, 1, At, B1); PG8_BAR;
            PG8_LDA(At, 0, 1); PG8_STAGE_A(PG8_SA(0, 0), o2, 0, t2);
            PG8_BAR; PG8_WAIT_L(0); PG8_MMA(1, 0, At, B0); PG8_BAR; PG8_SCHED;
            PG8_STAGE_B(PG8_SB(0, 1), b2, 1);
            PG8_WAIT_V(6); PG8_BAR; PG8_MMA(1, 1, At, B1); PG8_BAR;
            PG8_LDB(B0, 1, 0); PG8_SCHED; PG8_LDA(At, 1, 0); PG8_STAGE_A(PG8_SA(0, 1), o2, 1, t2);
            PG8_WAIT_L(8); PG8_BAR; PG8_WAIT_L(0); PG8_MMA(0, 0, At, B0); PG8_BAR; PG8_SCHED;
            PG8_LDB(B1, 1, 1); PG8_STAGE_B(PG8_SB(1, 0), b3, 0);
            PG8_BAR; PG8_WAIT_L(0); PG8_MMA(0, 1, At, B1); PG8_BAR;
            PG8_LDA(At, 1, 1); PG8_STAGE_A(PG8_SA(1, 0), o2, 0, t3);
            PG8_BAR; PG8_WAIT_L(0); PG8_MMA(1, 0, At, B0); PG8_BAR; PG8_SCHED;
            PG8_STAGE_B(PG8_SB(1, 1), b3, 1);
            PG8_WAIT_V(6); PG8_BAR; PG8_MMA(1, 1, At, B1); PG8_BAR;
            }
        }
        if constexpr (ALIGN_EPI) { if (wr == 0) PG8_BAR; }
        if constexpr (!Epi::AFTER_DRAIN) E(acc, cur, wr, wc, fr, fq);
        if (!has_next) break;
#pragma unroll
        for (int a = 0; a < 2; ++a)
#pragma unroll
            for (int b = 0; b < 2; ++b)
#pragma unroll
                for (int m = 0; m < 4; ++m)
#pragma unroll
                    for (int n = 0; n < 2; ++n) acc[a][b][m][n] = (f32x4){0.f, 0.f, 0.f, 0.f};
        cur = nxt; ++ui;
        if constexpr (ALIGN_EPI) { if (wr == 1) PG8_BAR; }
#pragma unroll
        for (int _h = 0; _h < 2; ++_h)
#pragma unroll
            for (int _i = 0; _i < 2; ++_i) if constexpr (GATHER) coff[_h][_i] = 0u;
        if constexpr (GATHER) PG8_NOFF_GET(coff);
    }
    PG8_WAIT_V(0);
    if constexpr (!ALIGN_EPI) { if (wr == 0) PG8_BAR; }
    PG8_BAR;
    if constexpr (Epi::AFTER_DRAIN) E.fused(acc, cur, wr, wc, fr, fq, lds);
#undef PG8_SA
#undef PG8_SB
#undef PG8_STAGE_A
#undef PG8_STAGE_B
#undef PG8_LDA
#undef PG8_LDB
#undef PG8_MMA
#undef PG8_WAIT_V
#undef PG8_WAIT_L
#undef PG8_BAR
#undef PG8_SCHED
#undef PG8_AOFFS
#undef PG8_NOFF_PUT
#undef PG8_NOFF_GET
}

struct EpiBf16Store {
    static constexpr bool PERM = true, AFTER_DRAIN = false;
    bf16* O; int ldc;
    __device__ __forceinline__ void operator()(const f32x4 (&acc)[2][2][4][2], const Unit& u, int wr, int wc, int fr, int fq) const {
        const int row0 = u.pm * BM + wr * 64 + fr, col0 = u.pn * BM + wc * 32 + 8 * fq;
#pragma unroll
        for (int ai = 0; ai < 2; ++ai)
#pragma unroll
            for (int m = 0; m < 4; ++m) { bf16* rowp = O + (size_t)(row0 + ai * HALF + m * 16) * ldc + col0;
#pragma unroll
                for (int bj = 0; bj < 2; ++bj) { const f32x4 v0 = acc[ai][bj][m][0], v1 = acc[ai][bj][m][1];
                    u32x4 w; w.x = cvt_pk_bf16(v0[0], v0[1]); w.y = cvt_pk_bf16(v0[2], v0[3]); w.z = cvt_pk_bf16(v1[0], v1[1]); w.w = cvt_pk_bf16(v1[2], v1[3]);
                    *(u32x4*)(rowp + bj * HALF) = w; } }
    }
};
struct EpiResidual {
    static constexpr bool PERM = true, AFTER_DRAIN = false;
    const void* xs; bool xbf; bf16* out; const float* gate;
    __device__ __forceinline__ void operator()(const f32x4 (&acc)[2][2][4][2], const Unit& u, int wr, int wc, int fr, int fq) const {
        const int row0 = u.pm * BM + wr * 64 + fr + (u.half == 2 ? HALF : 0), col0 = u.pn * BM + wc * 32 + 8 * fq;
        const float* gp = gate + (size_t)((u.pm * BM) / NS) * 6144 + col0;
        f32x4 gv[2][2];
#pragma unroll
        for (int bj = 0; bj < 2; ++bj)
#pragma unroll
            for (int n = 0; n < 2; ++n) gv[bj][n] = *(const f32x4*)(gp + bj * HALF + n * 4);
#pragma unroll
        for (int ai = 0; ai < 2; ++ai) { if (ai == 1 && u.half) continue;
#pragma unroll
          for (int mp = 0; mp < 2; ++mp) {
            f32x4 x0[2][2], x1[2][2];
#pragma unroll
            for (int mm = 0; mm < 2; ++mm) { const size_t ro = (size_t)(row0 + ai * HALF + (2 * mp + mm) * 16) * D + col0;
#pragma unroll
                for (int bj = 0; bj < 2; ++bj) {
                    if (xbf) { const u32x4 w = *(const u32x4*)((const bf16*)xs + ro + bj * HALF);
                        x0[mm][bj] = (f32x4){__builtin_bit_cast(float, w.x << 16), __builtin_bit_cast(float, w.x & 0xffff0000u), __builtin_bit_cast(float, w.y << 16), __builtin_bit_cast(float, w.y & 0xffff0000u)};
                        x1[mm][bj] = (f32x4){__builtin_bit_cast(float, w.z << 16), __builtin_bit_cast(float, w.z & 0xffff0000u), __builtin_bit_cast(float, w.w << 16), __builtin_bit_cast(float, w.w & 0xffff0000u)}; }
                    else { x0[mm][bj] = *(const f32x4*)((const float*)xs + ro + bj * HALF); x1[mm][bj] = *(const f32x4*)((const float*)xs + ro + bj * HALF + 4); } } }
#pragma unroll
            for (int mm = 0; mm < 2; ++mm) { const int m = 2 * mp + mm; const size_t ro = (size_t)(row0 + ai * HALF + m * 16) * D + col0;
#pragma unroll
                for (int bj = 0; bj < 2; ++bj) { const f32x4 y0 = x0[mm][bj] + gv[bj][0] * acc[ai][bj][m][0], y1 = x1[mm][bj] + gv[bj][1] * acc[ai][bj][m][1];
                    u32x4 o; o.x = cvt_pk_bf16(y0[0], y0[1]); o.y = cvt_pk_bf16(y0[2], y0[3]); o.z = cvt_pk_bf16(y1[0], y1[1]); o.w = cvt_pk_bf16(y1[2], y1[3]);
                    *(u32x4*)(out + ro + bj * HALF) = o; } } } }
    }
};
}
constexpr int NTH = 512;
typedef float f32x4_t __attribute__((ext_vector_type(4)));
typedef unsigned u32x4_t __attribute__((ext_vector_type(4)));
typedef unsigned u32x2_t __attribute__((ext_vector_type(2)));
typedef short s16x8_t __attribute__((ext_vector_type(8)));
#define LDSP(T, off) ((LAS T*)(lds + (off)))
__device__ __forceinline__ float wave_sum(float v) {
#pragma unroll
    for (int o = 1; o < 64; o <<= 1) v += __shfl_xor(v, o);
    return v;
}
__device__ __forceinline__ unsigned pk_bf16(float lo, float hi) { return pg8::cvt_pk_bf16(lo, hi); }

constexpr int CVT_WIN = 2 * 16 * 44, CVT_WOUT = 2 * 16 * 16, CVT_G = 32 * 16 * 8, CVT_U = CVT_G, CVT_D = 32 * 8 * 16, CVT_C1 = 4 * 32 * 2, CVT_C2 = 4 * 2;
constexpr int CVT_TOTAL = CVT_WIN + CVT_WOUT + CVT_G + CVT_U + CVT_D + CVT_C1 + CVT_C2;
__device__ __forceinline__ void cvt_job(const P& p, int T, const float*& src, size_t& lds_, bf16*& dst, size_t& ldd, bool& perm) {
    perm = false;
    if (T < CVT_WIN) { const int l = T / 704, r = T % 704, kt = r / 44, nt = r % 44;
        src = p.w_in + (size_t)l * D * NIN + (size_t)kt * 64 * NIN + nt * 64; lds_ = NIN; dst = WSP(bf16, WS_WIN_T) + (size_t)l * ZW * D + (size_t)((nt / 4) * 256 + (nt % 4) * 32) * D + kt * 64; ldd = D; perm = true; return; }
    T -= CVT_WIN;
    if (T < CVT_WOUT) { const int l = T / 256, r = T % 256, kt = r / 16, nt = r % 16;
        src = p.w_out + (size_t)l * D * D + (size_t)kt * 64 * D + nt * 64; lds_ = D; dst = WSP(bf16, WS_WOUT_T) + (size_t)l * D * D + (size_t)nt * 64 * D + kt * 64; ldd = D; return; }
    T -= CVT_WOUT;
    if (T < CVT_G + CVT_U) { const int up = T >= CVT_G; if (up) T -= CVT_G; const int le = T / 128, r = T % 128, kt = r / 8, nt = r % 8;
        src = (up ? p.moe_w_up : p.moe_w_gate) + (size_t)le * D * 512 + (size_t)kt * 64 * 512 + nt * 64; lds_ = 512;
        const int row0 = 256 * (nt / 2) + 64 * (nt % 2) + (up ? 128 : 0);
        dst = WSP(bf16, WS_WGU_T) + (size_t)le * 1024 * D + (size_t)row0 * D + kt * 64; ldd = D; return; }
    T -= CVT_G + CVT_U;
    if (T < CVT_D) { const int le = T / 128, r = T % 128, kt = r / 16, nt = r % 16;
        src = p.moe_w_down + (size_t)le * 512 * D + (size_t)kt * 64 * D + nt * 64; lds_ = D; dst = WSP(bf16, WS_WD_T) + (size_t)le * D * 512 + (size_t)nt * 64 * 512 + kt * 64; ldd = 512; return; }
    T -= CVT_D;
    if (T < CVT_C1) { const int lk = T / 64, l = lk / 2, kv = lk % 2, r = T % 64, kt = r / 2, nt = r % 2;
        src = (kv ? p.cmp_w1_v : p.cmp_w1_k) + (size_t)l * 2048 * 128 + (size_t)kt * 64 * 128 + nt * 64; lds_ = 128; dst = WSP(bf16, WS_CW1_T) + (size_t)lk * 256 * 1024 + (size_t)((kt >= 16 ? 128 : 0) + nt * 64) * 1024 + (kt & 15) * 64; ldd = 1024; return; }
    T -= CVT_C1;
    { const int lk = T / 2, l = lk / 2, kv = lk % 2, kt = T % 2;
        src = (kv ? p.cmp_w2_v : p.cmp_w2_k) + (size_t)l * 128 * 64 + (size_t)kt * 64 * 64; lds_ = 64; dst = WSP(bf16, WS_CW2_T) + (size_t)lk * 64 * 128 + kt * 64; ldd = 128; }
}
__device__ __forceinline__ void p0_prologue(const P& p, LAS unsigned char* lds) {
    const int tid = tid_fresh();
    if (bid_fresh() < 192) {
        LAS float* sc = LDSP(float, 0);
        LAS float* red = LDSP(float, 65536);
        for (int i = tid; i < NB * D; i += NTH) sc[i] = silu_f(p.c[i]);
        __syncthreads();
        const int lane = tid & 63, wv_ = tid >> 6, col = bid_fresh() * 64 + lane, l = col / 6144, n = col % 6144;
        float acc[NB];
#pragma unroll
        for (int b = 0; b < NB; ++b) acc[b] = 0.f;
        const float* w = p.ada_w + (size_t)l * D * 6144 + n;
        for (int k = wv_ * 128; k < wv_ * 128 + 128; k += 16) { float wv[16];
#pragma unroll
            for (int u = 0; u < 16; ++u) wv[u] = w[(size_t)(k + u) * 6144];
#pragma unroll
            for (int u = 0; u < 16; ++u)
#pragma unroll
                for (int b = 0; b < NB; ++b) acc[b] += sc[b * D + k + u] * wv[u]; }
#pragma unroll
        for (int b = 0; b < NB; ++b) red[(wv_ * NB + b) * 64 + lane] = acc[b];
        __syncthreads();
        for (int i = tid; i < NB * 64; i += NTH) { const int b = i >> 6, c = i & 63, cc = bid_fresh() * 64 + c, ll = cc / 6144, nn = cc % 6144; float s = p.ada_b[ll * 6144 + nn];
#pragma unroll
            for (int q = 0; q < 8; ++q) s += red[(q * NB + b) * 64 + c];
            WSP(float, WS_MOD)[((size_t)ll * NB + b) * 6144 + nn] = s; }
        __syncthreads();
    }
    { constexpr int TP = 8; const int G = grid_fresh(), bx = bid_fresh();
      for (int T0 = bx * TP; T0 < CVT_TOTAL; T0 += G * TP) {
        f32x4_t va[TP], vb[TP]; bf16* dst[TP]; size_t ld[TP]; bool perm[TP];
        const int k = tid >> 3, ns = (tid & 7) * 8;
#pragma unroll
        for (int q = 0; q < TP; ++q) { const int T = T0 + q < CVT_TOTAL ? T0 + q : CVT_TOTAL - 1; const float* src; size_t ls; cvt_job(p, T, src, ls, dst[q], ld[q], perm[q]);
            va[q] = *(const f32x4_t*)(src + (size_t)k * ls + ns); vb[q] = *(const f32x4_t*)(src + (size_t)k * ls + ns + 4); }
#pragma unroll
        for (int q = 0; q < TP; ++q) { LAS float* tile = LDSP(float, q * 64 * 65 * 4);
#pragma unroll
            for (int j = 0; j < 4; ++j) { tile[k * 65 + ns + j] = va[q][j]; tile[k * 65 + ns + 4 + j] = vb[q][j]; } }
        __syncthreads();
#pragma unroll
        for (int q = 0; q < TP; ++q) { if (T0 + q < CVT_TOTAL) { LAS float* tile = LDSP(float, q * 64 * 65 * 4); const int n = tid >> 3, ks = (tid & 7) * 8; u32x4_t w;
            w.x = pk_bf16(tile[(ks + 0) * 65 + n], tile[(ks + 1) * 65 + n]); w.y = pk_bf16(tile[(ks + 2) * 65 + n], tile[(ks + 3) * 65 + n]);
            w.z = pk_bf16(tile[(ks + 4) * 65 + n], tile[(ks + 5) * 65 + n]); w.w = pk_bf16(tile[(ks + 6) * 65 + n], tile[(ks + 7) * 65 + n]);
            const int nrow = perm[q] ? 128 * (n >> 5) + (n & 31) : n;
            *(u32x4_t*)(dst[q] + (size_t)nrow * ld[q] + ks) = w; } }
        __syncthreads();
      } }
    const long gid = (long)bid_fresh() * NTH + tid, gsz = (long)grid_fresh() * NTH;
    for (long i = gid; i < 2L * 32 * D; i += gsz) { const int k = (int)(i % D), j = (int)((i / D) % 32), l = (int)(i / (32 * D));
        WSP(bf16, WS_WGL_T)[i] = j < 24 ? f2bf(p.w_in[(size_t)l * D * NIN + (size_t)k * NIN + ZW + j]) : (bf16)0; }
    { const int lane = tid & 63, gw = (int)(gid >> 6), nw = (int)(gsz >> 6);
      for (int o = gw; o < 2 * 2 * 128; o += nw) { const int j = o % 128, kv = (o / 128) % 2, l = o / 256;
        const float* pe = (kv ? p.cmp_pe_v : p.cmp_pe_k) + (size_t)l * 2048; const float* w1 = (kv ? p.cmp_w1_v : p.cmp_w1_k) + (size_t)l * 2048 * 128 + j; float sacc = 0.f;
#pragma unroll 8
        for (int k = lane; k < 2048; k += 64) sacc += pe[k] * w1[(size_t)k * 128];
        sacc = wave_sum(sacc); if (lane == 0) WSP(float, WS_PEB)[o] = sacc; } }
    if (gid < 6) { const int l = (int)gid / 3, br = (int)gid % 3; float mq = 0.f, mk = 0.f;
        for (int e = 0; e < 64; ++e) { mq = fmaxf(mq, fabsf(p.nsa_q_norm_g[l * 64 + e])); mk = fmaxf(mk, fabsf(p.nsa_k_norm_g[(l * 3 + br) * 64 + e])); }
        WSP(float, WS_BND)[gid] = 8.f * mq * mk * 1.4426950408889634f; }
    for (long i = gid; i < 2L * 4 * 128 * 128; i += gsz) { const int s = (int)(i % 128), t = (int)((i / 128) % 128); WSP(bf16, WS_GWS)[i] = s <= t ? f2bf(p.gmlp_ws[i]) : (bf16)0; }
    for (long i = gid; i < (long)M * 32; i += gsz) { const long m = i / 32; const int j = (int)(i % 32); const float ang = (float)p.pos[m] * invfreq(j);
        const float cv = cosf(ang), sv = sinf(ang); WSP(float, WS_CS)[m * 64 + j] = cv; WSP(float, WS_CS)[m * 64 + 32 + j] = sv; WSP(bf16, WS_CSB)[m * 64 + j] = f2bf(cv); WSP(bf16, WS_CSB)[m * 64 + 32 + j] = f2bf(sv); }
}

__device__ __forceinline__ f32x4_t ld4x(const void* base, size_t idx, bool isbf) {
    if (isbf) { const u32x2_t w = *(const u32x2_t*)((const bf16*)base + idx); return (f32x4_t){__builtin_bit_cast(float, w.x << 16), __builtin_bit_cast(float, w.x & 0xffff0000u), __builtin_bit_cast(float, w.y << 16), __builtin_bit_cast(float, w.y & 0xffff0000u)}; }
    return *(const f32x4_t*)((const float*)base + idx); }
__device__ __forceinline__ void norm_phase(const P& p, LAS unsigned char* lds, const void* xs, bool xbf, int l, int which, int cbank = -1) {
    if (cbank < 0) cbank = l;
    const int tid = tid_fresh(), lane = tid & 63, wave = tid >> 6;
    const float* g = (which ? p.norm_ffn_g : p.norm_mix_g) + l * D;
    bf16* H = WSP(bf16, WS_H);
    LAS float* wr_l = LDSP(float, 0);
    LAS float* lg_l = LDSP(float, 65536);
    LAS int* lcnt = LDSP(int, 65536 + 8192);
    LAS float* red_l = LDSP(float, 65536 + 8192 + 256);
    LAS float* rs_l = LDSP(float, 65536 + 8192 + 256 + 2048);
    for (int rb = bid_fresh(); rb < M / 128; rb += grid_fresh()) {
        const int b = (rb * 128) / NS; const float* mod = WSP(float, WS_MOD) + ((size_t)l * NB + b) * 6144 + which * 3072;
        if (which) {
            __syncthreads();
            if (tid < 48) lcnt[tid] = 0;
            for (int i = tid; i < D * 16; i += NTH) { const int k = i >> 4, e = i & 15; wr_l[(k >> 4) * 256 + ((k >> 2) & 3) * 64 + e * 4 + (k & 3)] = g[k] * (1.f + mod[1024 + k]) * p.router_w[i]; }
            if (tid < 256) { const int e = tid & 15, part = tid >> 4; float s = 0.f; for (int k = part * 64; k < part * 64 + 64; ++k) s += mod[k] * p.router_w[k * 16 + e]; red_l[part * 16 + e] = s; }
            __syncthreads();
            if (tid < 16) { float s = 0.f;
#pragma unroll
                for (int q = 0; q < 16; ++q) s += red_l[q * 16 + tid]; red_l[256 + tid] = s; }
            __syncthreads();
            const int r = lane & 15, kq = lane >> 4; const size_t xr = (size_t)((long)rb * 128 + wave * 16 + r) * D + 4 * kq;
            f32x4_t acc = {0.f, 0.f, 0.f, 0.f}; float ss = 0.f;
#pragma unroll 8
            for (int t = 0; t < 64; ++t) { const f32x4_t xv = ld4x(xs, xr + 16 * t, xbf); const f32x4_t av = *(const LAS f32x4_t*)(wr_l + t * 256 + kq * 64 + r * 4);
                ss += xv[0] * xv[0] + xv[1] * xv[1] + xv[2] * xv[2] + xv[3] * xv[3];
                acc = __builtin_amdgcn_mfma_f32_16x16x4f32(av[0], xv[0], acc, 0, 0, 0); acc = __builtin_amdgcn_mfma_f32_16x16x4f32(av[1], xv[1], acc, 0, 0, 0);
                acc = __builtin_amdgcn_mfma_f32_16x16x4f32(av[2], xv[2], acc, 0, 0, 0); acc = __builtin_amdgcn_mfma_f32_16x16x4f32(av[3], xv[3], acc, 0, 0, 0); }
            ss += __shfl_xor(ss, 16); ss += __shfl_xor(ss, 32);
            const float rs = 1.0f / sqrtf(ss * (1.f / D) + EPS);
            if (kq == 0) rs_l[wave * 16 + r] = rs;
#pragma unroll
            for (int reg = 0; reg < 4; ++reg) lg_l[(wave * 16 + r) * 16 + 4 * kq + reg] = rs * acc[reg] + red_l[256 + 4 * kq + reg];
        }
#pragma unroll 1
        for (int grp = 0; grp < 4; ++grp) {
            const long row0 = (long)rb * 128 + wave * 16 + grp * 4;
            f32x4_t hv[4][4]; float ss[4];
#pragma unroll
            for (int r = 0; r < 4; ++r) { ss[r] = 0.f;
#pragma unroll
                for (int i = 0; i < 4; ++i) { hv[r][i] = ld4x(xs, (size_t)(row0 + r) * D + 256 * i + 4 * lane, xbf); if (!which) ss[r] += hv[r][i][0] * hv[r][i][0] + hv[r][i][1] * hv[r][i][1] + hv[r][i][2] * hv[r][i][2] + hv[r][i][3] * hv[r][i][3]; } }
#pragma unroll
            for (int r = 0; r < 4; ++r) ss[r] = which ? rs_l[wave * 16 + grp * 4 + r] : 1.0f / sqrtf(wave_sum(ss[r]) * (1.f / D) + EPS);
#pragma unroll
            for (int i = 0; i < 4; ++i) { const int k0 = 256 * i + 4 * lane;
                const f32x4_t gv = *(const f32x4_t*)(g + k0), sh = *(const f32x4_t*)(mod + k0), sc = *(const f32x4_t*)(mod + 1024 + k0);
                f32x4_t gm;
#pragma unroll
                for (int j = 0; j < 4; ++j) gm[j] = gv[j] * (1.f + sc[j]);
#pragma unroll
                for (int r = 0; r < 4; ++r) { hv[r][i] = hv[r][i] * ss[r] * gm + sh;
                    u32x2_t w; w.x = pk_bf16(hv[r][i][0], hv[r][i][1]); w.y = pk_bf16(hv[r][i][2], hv[r][i][3]); *(u32x2_t*)(H + (row0 + r) * D + k0) = w; } }
        }
        if (which) {
            int cls = -1, rank = 0; float wa = 0.f, wb = 0.f; const long row = (long)rb * 128 + wave * 16 + lane;
            __builtin_amdgcn_s_waitcnt(0);
            if (lane < 16) {
                const LAS float* q = lg_l + (wave * 16 + lane) * 16;
                float mx = q[0];
#pragma unroll
                for (int e = 1; e < 16; ++e) mx = fmaxf(mx, q[e]);
                float den = 0.f;
#pragma unroll
                for (int e = 0; e < 16; ++e) den += expf(q[e] - mx);
                float bestg = -3e38f; int bg = 0;
#pragma unroll
                for (int gI = 0; gI < 4; ++gI) { float a = -3e38f, b2 = -3e38f;
#pragma unroll
                    for (int j = 0; j < 4; ++j) { const float s = expf(q[gI * 4 + j] - mx) / den + p.router_b[gI * 4 + j]; if (s > a) { b2 = a; a = s; } else if (s > b2) b2 = s; }
                    if (a + b2 > bestg) { bestg = a + b2; bg = gI; } }
                float a = -3e38f, b2 = -3e38f; int ia = 0, ib = 0;
#pragma unroll
                for (int j = 0; j < 4; ++j) { const float s = expf(q[bg * 4 + j] - mx) / den + p.router_b[bg * 4 + j];
                    if (s > a) { b2 = a; ib = ia; a = s; ia = j; } else if (s > b2) { b2 = s; ib = j; } }
                const float p0 = expf(q[bg * 4 + ia] - mx) / den, p1 = expf(q[bg * 4 + ib] - mx) / den;
                const float w0 = p0 / (p0 + p1), w1 = p1 / (p0 + p1);
                const int lo = ia < ib ? ia : ib, hi = ia < ib ? ib : ia;
                wa = ia < ib ? w0 : w1; wb = ia < ib ? w1 : w0;
                const int pairidx = lo == 0 ? hi - 1 : (lo == 1 ? hi + 1 : 5);
                cls = bg * 6 + pairidx;
                rank = atomicAdd((int*)&lcnt[cls], 1);
                Rout r; r.e0 = bg * 4 + ia; r.e1 = bg * 4 + ib; r.w0 = w0; r.w1 = w1; WSP(Rout, WS_ROUT)[row] = r;
            }
            __syncthreads();
            if (tid < 24) { const int c = lcnt[tid]; lcnt[24 + tid] = c ? atomicAdd(WSP(int, WS_CTL) + CW_CNT + cbank * 64 + tid, c) : 0; }
            __syncthreads();
            if (lane < 16) { const int slot = lcnt[24 + cls] + rank; WSP(int, WS_CTOK)[(size_t)cls * M + slot] = (int)row; float* wp = WSP(float, WS_CWT) + ((size_t)cls * M + slot) * 2; wp[0] = wa; wp[1] = wb; }
            __syncthreads();
            if (tid < 24) lcnt[tid] = 0;
            __syncthreads();
        }
    }
}

__device__ __forceinline__ void gl_tail(const P& p, int l) {
    const int tid = tid_fresh(), lane = tid & 63, wave = tid >> 6, fr = lane & 15, fq = lane >> 4;
    const bf16* H = WSP(bf16, WS_H); const bf16* W = WSP(bf16, WS_WGL_T) + (size_t)l * 32 * D; float* GL = WSP(float, WS_GL);
    for (int rt = bid_fresh() * 8 + wave; rt < M / 16; rt += grid_fresh() * 8) {
        pg8::f32x4 acc0 = {0.f, 0.f, 0.f, 0.f}, acc1 = {0.f, 0.f, 0.f, 0.f};
        const bf16* ap = H + (size_t)(rt * 16 + fr) * D + fq * 8; const bf16* bp0 = W + (size_t)fr * D + fq * 8; const bf16* bp1 = W + (size_t)(16 + fr) * D + fq * 8;
#pragma unroll 4
        for (int s = 0; s < 32; ++s) { const s16x8_t a = *(const s16x8_t*)(ap + s * 32), b0 = *(const s16x8_t*)(bp0 + s * 32), b1 = *(const s16x8_t*)(bp1 + s * 32);
            acc0 = __builtin_amdgcn_mfma_f32_16x16x32_bf16(a, b0, acc0, 0, 0, 0); acc1 = __builtin_amdgcn_mfma_f32_16x16x32_bf16(a, b1, acc1, 0, 0, 0); }
#pragma unroll
        for (int r = 0; r < 4; ++r) { const long m = (long)rt * 16 + 4 * fq + r; GL[m * 24 + fr] = acc0[r]; if (fr < 8) GL[m * 24 + 16 + fr] = acc1[r]; }
    }
}

struct EpiZ {
    static constexpr bool PERM = true, AFTER_DRAIN = false;
    const P* pp; int l;
    __device__ __forceinline__ void operator()(const pg8::f32x4 (&acc)[2][2][4][2], const pg8::Unit& u, int wr, int wc, int fr, int fq) const {
        const P& p = *pp; bf16* Z = WSP(bf16, WS_Z); const bf16* CSB = WSP(bf16, WS_CSB);
        const int pn = u.pn;
        int mode = 0; float scale = 1.f; const float* gain = nullptr;
        if (pn == 0) mode = 1; else if (pn == 1) { mode = 1; scale = 0.125f; } else if (pn == 3) mode = 3; else if (pn == 4 || pn == 5) mode = 4;
        else if (pn == 6 || pn == 7) { mode = 2; scale = 0.125f; gain = p.nsa_q_norm_g + l * 64; }
        else if (pn == 9 && wc < 2) { mode = 2; gain = p.nsa_k_norm_g + (l * 3 + 1) * 64; }
        else if (pn == 10 && wc < 2) { mode = 2; gain = p.nsa_k_norm_g + (l * 3 + 2) * 64; }
        float g0[8], g1[8];
        if (mode == 2) {
#pragma unroll
            for (int j = 0; j < 8; ++j) { g0[j] = gain[8 * fq + j] * scale; g1[j] = gain[32 + 8 * fq + j] * scale; } }
        else {
#pragma unroll
            for (int j = 0; j < 8; ++j) { g0[j] = scale; g1[j] = scale; } }
        const int row0 = u.pm * 256 + wr * 64 + fr + (u.half == 2 ? 128 : 0), col0 = pn * 256 + wc * 64 + 8 * fq;
#pragma unroll
        for (int ai = 0; ai < 2; ++ai) { if (ai == 1 && u.half) continue;
#pragma unroll
         for (int mp = 0; mp < 2; ++mp) {
          pg8::u32x4 cwa[2], swa[2];
          if (mode == 1 || mode == 2) {
#pragma unroll
            for (int mm = 0; mm < 2; ++mm) { const long row = row0 + ai * 128 + (2 * mp + mm) * 16; cwa[mm] = *(const pg8::u32x4*)(CSB + row * 64 + 8 * fq); swa[mm] = *(const pg8::u32x4*)(CSB + row * 64 + 32 + 8 * fq); } }
#pragma unroll
            for (int mm = 0; mm < 2; ++mm) { const int m = 2 * mp + mm; const long row = row0 + ai * 128 + m * 16;
                float a[8], b[8];
#pragma unroll
                for (int j = 0; j < 4; ++j) { a[j] = acc[ai][0][m][0][j]; a[4 + j] = acc[ai][0][m][1][j]; b[j] = acc[ai][1][m][0][j]; b[4 + j] = acc[ai][1][m][1][j]; }
                if (mode == 1 || mode == 2) {
                    float r = 1.f;
                    if (mode == 2) { float ss = 0.f;
#pragma unroll
                        for (int j = 0; j < 8; ++j) ss += a[j] * a[j] + b[j] * b[j];
                        ss += __shfl_xor(ss, 16); ss += __shfl_xor(ss, 32); r = 1.0f / sqrtf(ss * (1.f / 64.f) + EPS); }
                    const pg8::u32x4 cw = cwa[mm], sw = swa[mm];
#pragma unroll
                    for (int j = 0; j < 8; ++j) { const unsigned cu = cw[j >> 1], su = sw[j >> 1];
                        const float cs = __builtin_bit_cast(float, (j & 1) ? (cu & 0xffff0000u) : (cu << 16)), sn = __builtin_bit_cast(float, (j & 1) ? (su & 0xffff0000u) : (su << 16));
                        const float x1 = a[j] * r * g0[j], x2 = b[j] * r * g1[j];
                        a[j] = x1 * cs - x2 * sn; b[j] = x1 * sn + x2 * cs; } }
                else if (mode == 3) {
#pragma unroll
                    for (int j = 0; j < 8; ++j) { a[j] = silu_fast(a[j]); b[j] = silu_fast(b[j]); } }
                else if (mode == 4) {
#pragma unroll
                    for (int j = 0; j < 8; ++j) { a[j] = gelu_fast(a[j]); b[j] = gelu_fast(b[j]); } }
                pg8::u32x4 wa, wb;
                wa.x = pk_bf16(a[0], a[1]); wa.y = pk_bf16(a[2], a[3]); wa.z = pk_bf16(a[4], a[5]); wa.w = pk_bf16(a[6], a[7]);
                wb.x = pk_bf16(b[0], b[1]); wb.y = pk_bf16(b[2], b[3]); wb.z = pk_bf16(b[4], b[5]); wb.w = pk_bf16(b[6], b[7]);
                *(pg8::u32x4*)(Z + row * ZW + col0) = wa; *(pg8::u32x4*)(Z + row * ZW + col0 + 32) = wb; } } }
    }
};
typedef short s16x4_t __attribute__((ext_vector_type(4)));
typedef float f32x4m __attribute__((ext_vector_type(4)));
#define MFMA16(a, b, c) __builtin_amdgcn_mfma_f32_16x16x32_bf16((a), (b), (c), 0, 0, 0)
constexpr int LP = 144;
__device__ __forceinline__ s16x4_t lds_tr4(LAS const unsigned char* p) { return __builtin_bit_cast(s16x4_t, __builtin_amdgcn_ds_read_tr16_b64_v4i16((LAS s16x4_t*)p)); }
__device__ __forceinline__ s16x8_t tr_frag(LAS const unsigned char* X, int P, int k0, int c0, int lane) {
    const int fq = lane >> 4, q = (lane & 15) >> 2, pp = lane & 3;
    LAS const unsigned char* a = X + (k0 + 8 * fq + q) * P + (c0 + 4 * pp) * 2;
    const s16x4_t lo = lds_tr4(a), hi = lds_tr4(a + 4 * P);
    return (s16x8_t){lo[0], lo[1], lo[2], lo[3], hi[0], hi[1], hi[2], hi[3]};
}
__device__ __forceinline__ s16x8_t tr_frag_perm(LAS const unsigned char* X, int P, int k0, int c0, int lane) {
    const int fq = lane >> 4, q = (lane & 15) >> 2, pp = lane & 3;
    LAS const unsigned char* a = X + (k0 + 4 * fq + q) * P + (c0 + 4 * pp) * 2;
    const s16x4_t lo = lds_tr4(a), hi = lds_tr4(a + 16 * P);
    return (s16x8_t){lo[0], lo[1], lo[2], lo[3], hi[0], hi[1], hi[2], hi[3]};
}
__device__ __forceinline__ s16x8_t pack8(const f32x4m& a, const f32x4m& b) {
    const unsigned w0 = pk_bf16(a[0], a[1]), w1 = pk_bf16(a[2], a[3]), w2 = pk_bf16(b[0], b[1]), w3 = pk_bf16(b[2], b[3]);
    return __builtin_bit_cast(s16x8_t, (u32x4_t){w0, w1, w2, w3});
}
__device__ __forceinline__ float bflo(unsigned u) { return __builtin_bit_cast(float, u << 16); }
__device__ __forceinline__ float bfhi(unsigned u) { return __builtin_bit_cast(float, u & 0xffff0000u); }

struct CmpSched {
    static constexpr bool GATHER = false; static constexpr int GOFF_LDS = 0;
    const P* pp; int l, c;
    __device__ __forceinline__ bool next(int i, pg8::Unit& u) const { if (i > 0 || c >= 32) return false; u.pm = c & 7; u.pn = 0; u.aux = c >> 3; u.half = 0; return true; }
    __device__ __forceinline__ int ktiles() const { return 16; }
    __device__ __forceinline__ const char* a_base() const { return (const char*)(pp->ws + WS_Z); }
    __device__ __forceinline__ size_t a_kstep() const { return (size_t)ZW * 2; }
    __device__ __forceinline__ unsigned a_off(const pg8::Unit& u, int row, int C) const {
        const int R = u.pm * 256 + row, kv = u.aux & 1, g = u.aux >> 1;
        return (unsigned)(((size_t)R * 16 * ZW + (kv ? C_VC : C_KC) + g * 64 + C) * 2); }
    __device__ __forceinline__ unsigned b_ld() const { return 1024 * 2u; }
    __device__ __forceinline__ const char* b_tile(const pg8::Unit& u, int t) const { return (const char*)(pp->ws + WS_CW1_T) + (size_t)(l * 2 + (u.aux & 1)) * 256 * 1024 * 2 + (size_t)t * 128; }
};
struct EpiCmp {
    static constexpr bool PERM = false, AFTER_DRAIN = true;
    const P* pp; int l;
    __device__ __forceinline__ void operator()(const pg8::f32x4 (&)[2][2][4][2], const pg8::Unit&, int, int, int, int) const {}
    __device__ __forceinline__ void fused(const pg8::f32x4 (&acc)[2][2][4][2], const pg8::Unit& u, int wr, int wc, int fr, int fq, LAS unsigned char* lds) const {
        const P& p = *pp; const int kv = u.aux & 1, g = u.aux >> 1, lane = tid_fresh() & 63, w = tid_fresh() >> 6;
        constexpr int HP = 272;
        constexpr int HOFF = 257 * HP;
        const float* bias = WSP(float, WS_PEB) + (l * 2 + kv) * 128;
#pragma unroll
        for (int n = 0; n < 2; ++n) { const int c = 32 * wc + 16 * n + 4 * fq;
#pragma unroll
            for (int ai = 0; ai < 2; ++ai)
#pragma unroll
                for (int m = 0; m < 4; ++m) { const int r = 128 * ai + 64 * wr + 16 * m + fr; const f32x4m v = acc[ai][1][m][n];
                    u32x2_t o; o.x = pk_bf16(v[0], v[1]); o.y = pk_bf16(v[2], v[3]); *(LAS u32x2_t*)(lds + r * HP + c * 2) = o; } }
        if (tid_fresh() < 32) *(LAS u32x2_t*)(lds + 256 * HP + tid_fresh() * 8) = (u32x2_t){0u, 0u};
        __syncthreads();
#pragma unroll
        for (int n = 0; n < 2; ++n) { const int c = 32 * wc + 16 * n + 4 * fq; const f32x4m bv = *(const f32x4m*)(bias + c);
#pragma unroll
            for (int ai = 0; ai < 2; ++ai)
#pragma unroll
                for (int m = 0; m < 4; ++m) { const int r = 128 * ai + 64 * wr + 16 * m + fr; const u32x2_t u1 = *(const LAS u32x2_t*)(lds + (r + 1) * HP + c * 2);
                    const f32x4m v = acc[ai][0][m][n] + bv + (f32x4m){bflo(u1.x), bfhi(u1.x), bflo(u1.y), bfhi(u1.y)};
                    u32x2_t o; o.x = pk_bf16(gelu_fast(v[0]), gelu_fast(v[1])); o.y = pk_bf16(gelu_fast(v[2]), gelu_fast(v[3])); *(LAS u32x2_t*)(lds + HOFF + r * HP + c * 2) = o; } }
        __syncthreads();
        const bf16* W2 = WSP(bf16, WS_CW2_T) + (size_t)(l * 2 + kv) * 64 * 128;
        const float* gk = p.nsa_k_norm_g + (l * 3 + 0) * 64;
#pragma unroll
        for (int rt = 0; rt < 2; ++rt) {
            f32x4m o[4];
#pragma unroll
            for (int ct = 0; ct < 4; ++ct) o[ct] = (f32x4m){0.f, 0.f, 0.f, 0.f};
#pragma unroll
            for (int s = 0; s < 4; ++s) { const s16x8_t a = *(const LAS s16x8_t*)(lds + HOFF + (32 * w + 16 * rt + fr) * HP + (32 * s + 8 * fq) * 2);
#pragma unroll
                for (int ct = 0; ct < 4; ++ct) { const s16x8_t b = *(const s16x8_t*)(W2 + (16 * ct + fr) * 128 + 32 * s + 8 * fq); o[ct] = MFMA16(a, b, o[ct]); } }
#pragma unroll
            for (int reg = 0; reg < 4; ++reg) { const int R = u.pm * 256 + 32 * w + 16 * rt + 4 * fq + reg, b = R >> 7, n = R & 127;
                float v0 = o[0][reg], v1 = o[1][reg], v2 = o[2][reg], v3 = o[3][reg];
                if (kv == 0) { float ss = v0 * v0 + v1 * v1 + v2 * v2 + v3 * v3;
                    ss += __shfl_xor(ss, 1); ss += __shfl_xor(ss, 2); ss += __shfl_xor(ss, 4); ss += __shfl_xor(ss, 8);
                    const float r = 1.0f / sqrtf(ss * (1.f / 64.f) + EPS);
                    v0 *= r * gk[fr]; v1 *= r * gk[16 + fr]; v2 *= r * gk[32 + fr]; v3 *= r * gk[48 + fr];
                    const int nn = n < NCMP ? n : NCMP - 1; const float* cs = WSP(float, WS_CS) + ((size_t)b * NS + 16 * nn + 31) * 64;
                    const float c0 = cs[fr], s0 = cs[32 + fr], c1 = cs[16 + fr], s1 = cs[48 + fr];
                    const float a0 = v0 * c0 - v2 * s0, a2 = v0 * s0 + v2 * c0, a1 = v1 * c1 - v3 * s1, a3 = v1 * s1 + v3 * c1; v0 = a0; v1 = a1; v2 = a2; v3 = a3; }
                { if (n >= NCMP) { v0 = 0.f; v1 = 0.f; v2 = 0.f; v3 = 0.f; }
                    bf16* dst = (kv ? WSP(bf16, WS_VC) : WSP(bf16, WS_KC)) + ((size_t)(b * 2 + g) * (NCMP + 1) + n) * 64;
                    dst[fr] = f2bf(v0); dst[16 + fr] = f2bf(v1); dst[32 + fr] = f2bf(v2); dst[48 + fr] = f2bf(v3); } }
        }
        __syncthreads();
    }
};
__device__ __forceinline__ void ret_kv_unit(const P& p, LAS unsigned char* lds, int l, int unit) {
    const int tid = tid_fresh(), lane = tid & 63, w = tid >> 6, fr = lane & 15, fq = lane >> 4;
    const int c = unit % NCH, h = (unit / NCH) % 4, b = unit / (NCH * 4);
    const bf16* Z = WSP(bf16, WS_Z); const size_t m0 = (size_t)b * NS + (size_t)c * 128;
    const float lg2 = log2f(1.f - exp2f(-5.f - (float)h));
    LAS unsigned char* KL = lds; LAS unsigned char* VL = lds + 128 * LP;
#pragma unroll
    for (int i = 0; i < 2; ++i) { const int pc = tid + i * NTH, r = pc >> 3, q = pc & 7;
        const u32x4_t kw = *(const u32x4_t*)(Z + (m0 + r) * ZW + C_RK + 64 * h + q * 8), vw = *(const u32x4_t*)(Z + (m0 + r) * ZW + C_RV + 64 * h + q * 8);
        const float dk = exp2f((float)(127 - r) * lg2); u32x4_t ko;
#pragma unroll
        for (int j = 0; j < 4; ++j) ko[j] = pk_bf16(bflo(kw[j]) * dk, bfhi(kw[j]) * dk);
        *(LAS u32x4_t*)(KL + r * LP + q * 16) = ko; *(LAS u32x4_t*)(VL + r * LP + q * 16) = vw; }
    __syncthreads();
    const int et = w >> 1, d0 = 2 * (w & 1);
    f32x4m a0 = {0.f, 0.f, 0.f, 0.f}, a1 = {0.f, 0.f, 0.f, 0.f};
#pragma unroll
    for (int ks = 0; ks < 4; ++ks) { const s16x8_t va = tr_frag(VL, LP, 32 * ks, 16 * et, lane);
        a0 = MFMA16(va, tr_frag(KL, LP, 32 * ks, 16 * d0, lane), a0); a1 = MFMA16(va, tr_frag(KL, LP, 32 * ks, 16 * (d0 + 1), lane), a1); }
    float* KV = WSP(float, WS_KVS) + (size_t)unit * 4096;
#pragma unroll
    for (int reg = 0; reg < 4; ++reg) { const int e = 16 * et + 4 * fq + reg; KV[e * 64 + 16 * d0 + fr] = a0[reg]; KV[e * 64 + 16 * (d0 + 1) + fr] = a1[reg]; }
    __syncthreads();
}

__device__ __forceinline__ void ret_out_unit(const P& p, LAS unsigned char* lds, int l, int unit) {
    const int tid = tid_fresh(), lane = tid & 63, w = tid >> 6, fr = lane & 15, fq = lane >> 4;
    const int c = unit % NCH, h = (unit / NCH) % 4, b = unit / (NCH * 4);
    const bf16* Z = WSP(bf16, WS_Z); bf16* MIX = WSP(bf16, WS_MIX); const size_t m0 = (size_t)b * NS + (size_t)c * 128;
    const float lg2 = log2f(1.f - exp2f(-5.f - (float)h));
    LAS unsigned char* KL = lds; LAS unsigned char* VL = lds + 128 * LP; LAS unsigned char* ST = lds + 256 * LP;
#pragma unroll
    for (int i = 0; i < 2; ++i) { const int pc = tid + i * NTH, r = pc >> 3, q = pc & 7;
        *(LAS u32x4_t*)(KL + r * LP + q * 16) = *(const u32x4_t*)(Z + (m0 + r) * ZW + C_RK + 64 * h + q * 8);
        *(LAS u32x4_t*)(VL + r * LP + q * 16) = *(const u32x4_t*)(Z + (m0 + r) * ZW + C_RV + 64 * h + q * 8); }
    {
        const float lgc = 128.f * lg2; const float* KV = WSP(float, WS_KVS) + (size_t)(unit - c) * 4096 + tid * 8;
        f32x4m s0 = {0.f, 0.f, 0.f, 0.f}, s1 = {0.f, 0.f, 0.f, 0.f};
        f32x4m ld0[NCH - 1], ld1[NCH - 1];
#pragma unroll
        for (int cc = 0; cc < NCH - 1; ++cc) { ld0[cc] = *(const f32x4m*)(KV + (size_t)cc * 4096); ld1[cc] = *(const f32x4m*)(KV + (size_t)cc * 4096 + 4); }
#pragma unroll
        for (int cc = 0; cc < NCH - 1; ++cc) { const float wgt = cc < c ? __builtin_amdgcn_exp2f((float)(c - 1 - cc) * lgc) : 0.f; s0 += ld0[cc] * wgt; s1 += ld1[cc] * wgt; }
        const int e = tid >> 3, d = (tid & 7) * 8; u32x4_t o; o.x = pk_bf16(s0[0], s0[1]); o.y = pk_bf16(s0[2], s0[3]); o.z = pk_bf16(s1[0], s1[1]); o.w = pk_bf16(s1[2], s1[3]);
        *(LAS u32x4_t*)(ST + e * LP + d * 2) = o; }
    __syncthreads();
    const size_t mq = m0 + 16 * w + fr; const int nq = 16 * w + fr;
    s16x8_t qf[2];
#pragma unroll
    for (int s = 0; s < 2; ++s) qf[s] = *(const s16x8_t*)(Z + mq * ZW + C_RQ + 64 * h + 32 * s + 8 * fq);
    f32x4m O[4];
#pragma unroll
    for (int dt = 0; dt < 4; ++dt) O[dt] = (f32x4m){0.f, 0.f, 0.f, 0.f};
    for (int ks = 0; ks <= (w >> 1); ++ks) {
        f32x4m S2[2];
#pragma unroll
        for (int t = 0; t < 2; ++t) { const int kt = 2 * ks + t; f32x4m sacc = {0.f, 0.f, 0.f, 0.f};
#pragma unroll
            for (int s = 0; s < 2; ++s) sacc = MFMA16(*(const LAS s16x8_t*)(KL + (16 * kt + fr) * LP + (32 * s + 8 * fq) * 2), qf[s], sacc);
#pragma unroll
            for (int reg = 0; reg < 4; ++reg) { const int kk = 16 * kt + 4 * fq + reg; sacc[reg] = kk <= nq ? sacc[reg] * __builtin_amdgcn_exp2f((float)(nq - kk) * lg2) : 0.f; }
            S2[t] = sacc; }
        const s16x8_t pf = pack8(S2[0], S2[1]);
#pragma unroll
        for (int dt = 0; dt < 4; ++dt) O[dt] = MFMA16(tr_frag_perm(VL, LP, 32 * ks, 16 * dt, lane), pf, O[dt]);
    }
    { const float dq = exp2f((float)(nq + 1) * lg2);
#pragma unroll
      for (int dt = 0; dt < 4; ++dt) { f32x4m t = {0.f, 0.f, 0.f, 0.f};
#pragma unroll
          for (int s = 0; s < 2; ++s) t = MFMA16(*(const LAS s16x8_t*)(ST + (16 * dt + fr) * LP + (32 * s + 8 * fq) * 2), qf[s], t);
          O[dt] += t * dq; } }
    float ss = 0.f;
#pragma unroll
    for (int dt = 0; dt < 4; ++dt) ss += O[dt][0] * O[dt][0] + O[dt][1] * O[dt][1] + O[dt][2] * O[dt][2] + O[dt][3] * O[dt][3];
    ss += __shfl_xor(ss, 16); ss += __shfl_xor(ss, 32);
    const float r = 1.0f / sqrtf(ss * (1.f / 64.f) + EPS);
#pragma unroll
    for (int dt = 0; dt < 4; ++dt) { const int e = 16 * dt + 4 * fq; const f32x4m gn = *(const f32x4m*)(p.ret_norm_g + (l * 4 + h) * 64 + e);
        const u32x2_t rg = *(const u32x2_t*)(Z + mq * ZW + C_RG + 64 * h + e);
        u32x2_t o; o.x = pk_bf16(O[dt][0] * r * gn[0] * bflo(rg.x), O[dt][1] * r * gn[1] * bfhi(rg.x)); o.y = pk_bf16(O[dt][2] * r * gn[2] * bflo(rg.y), O[dt][3] * r * gn[3] * bfhi(rg.y));
        *(u32x2_t*)(MIX + mq * D + 64 * h + e) = o; }
    __syncthreads();
}
__device__ __forceinline__ void gmlp_unit(const P& p, LAS unsigned char* lds, int l, int unit) {
    const int tid = tid_fresh(), lane = tid & 63, w = tid >> 6, fr = lane & 15, fq = lane >> 4;
    const bf16* Z = WSP(bf16, WS_Z); bf16* MIX = WSP(bf16, WS_MIX); const size_t m0 = (size_t)unit * 128;
    constexpr int VP = 528;
    { const int r = tid >> 2, q = tid & 3; const bf16* src = Z + (m0 + r) * ZW + C_GV + q * 64;
      u32x4_t v[8]; float s = 0.f;
#pragma unroll
      for (int i = 0; i < 8; ++i) { v[i] = *(const u32x4_t*)(src + i * 8);
#pragma unroll
          for (int j = 0; j < 4; ++j) s += bflo(v[i][j]) + bfhi(v[i][j]); }
      s += __shfl_xor(s, 1); s += __shfl_xor(s, 2); const float mu = s * (1.f / 256.f); float s2 = 0.f;
#pragma unroll
      for (int i = 0; i < 8; ++i)
#pragma unroll
          for (int j = 0; j < 4; ++j) { const float a = bflo(v[i][j]) - mu, b2 = bfhi(v[i][j]) - mu; s2 += a * a + b2 * b2; }
      s2 += __shfl_xor(s2, 1); s2 += __shfl_xor(s2, 2); const float rstd = 1.0f / sqrtf(s2 * (1.f / 256.f) + EPS);
      const float* gl = p.gmlp_ln_g + l * 256 + q * 64;
#pragma unroll
      for (int i = 0; i < 8; ++i) { u32x4_t o;
#pragma unroll
          for (int j = 0; j < 4; ++j) o[j] = pk_bf16((bflo(v[i][j]) - mu) * rstd * gl[i * 8 + 2 * j], (bfhi(v[i][j]) - mu) * rstd * gl[i * 8 + 2 * j + 1]);
          *(LAS u32x4_t*)(lds + r * VP + (q * 64 + i * 8) * 2) = o; } }
    __syncthreads();
    const int t0 = 16 * w;
#pragma unroll 1
    for (int g = 0; g < 4; ++g) {
        const bf16* W = WSP(bf16, WS_GWS) + (size_t)(l * 4 + g) * 128 * 128;
        f32x4m acc[4];
#pragma unroll
        for (int ct = 0; ct < 4; ++ct) acc[ct] = (f32x4m){0.f, 0.f, 0.f, 0.f};
        for (int ks = 0; ks <= (w >> 1); ++ks) { const s16x8_t a = *(const s16x8_t*)(W + (t0 + fr) * 128 + 32 * ks + 8 * fq);
#pragma unroll
            for (int ct = 0; ct < 4; ++ct) acc[ct] = MFMA16(a, tr_frag(lds, VP, 32 * ks, 64 * g + 16 * ct, lane), acc[ct]); }
#pragma unroll
        for (int reg = 0; reg < 4; ++reg) { const int t = t0 + 4 * fq + reg; const float bs = p.gmlp_b[(l * 4 + g) * 128 + t];
#pragma unroll
            for (int ct = 0; ct < 4; ++ct) { const int col = 64 * g + 16 * ct + fr; MIX[(m0 + t) * D + 256 + col] = f2bf(bf2f(Z[(m0 + t) * ZW + C_GU + col]) * (acc[ct][reg] + bs)); } }
    }
    __syncthreads();
}
__device__ __forceinline__ void premix_phase(const P& p, LAS unsigned char* lds, int l) {
    { CmpSched S; S.pp = &p; S.l = l; S.c = bid_fresh(); EpiCmp E{&p, l}; pg8::gemm_phase(lds, S, E); }
    const int G = grid_fresh(), bx = bid_fresh();
    if (G > 64) { if (bx >= 32) { for (int u = bx - 32; u < NB * 4 * NCH; u += G - 32) ret_kv_unit(p, lds, l, u); for (int u = bx - 32; u < NB * NCH; u += G - 32) gmlp_unit(p, lds, l, u); } }
    else { for (int u = bx; u < NB * 4 * NCH; u += G) ret_kv_unit(p, lds, l, u); for (int u = bx; u < NB * NCH; u += G) gmlp_unit(p, lds, l, u); }
}

__device__ __forceinline__ s16x8_t tr_frag_perm_swz(LAS const unsigned char* X, int k0, int c0, int lane) {
    const int fq = lane >> 4, q = (lane & 15) >> 2, pp = lane & 3, row = k0 + 4 * fq + q, col = c0 + 4 * pp;
    LAS const unsigned char* a = X + row * 128 + ((((col >> 3) ^ (row & 7))) << 4) + (col & 7) * 2;
    const s16x4_t lo = lds_tr4(a), hi = lds_tr4(a + 16 * 128);
    return (s16x8_t){lo[0], lo[1], lo[2], lo[3], hi[0], hi[1], hi[2], hi[3]};
}
constexpr int NSA_KV = 2 * 64 * 128;
constexpr int NSA_IMP = 3 * NSA_KV, NSA_INVL = NSA_IMP + 8 * 8192, NSA_SELM = NSA_INVL + 64 * 4 * 4;
static_assert(NSA_SELM + 256 <= 147456 - 64, "NSA LDS map");
__device__ __forceinline__ void nsa_unit(const P& p, LAS unsigned char* lds, int l, int b, int g, int i) {
    const int tid = tid_fresh(), lane = tid & 63, w = tid >> 6, fr = lane & 15, fq = lane >> 4;
    const bf16* Z = WSP(bf16, WS_Z); bf16* MIX = WSP(bf16, WS_MIX); const float* GL = WSP(float, WS_GL);
    const size_t mb = (size_t)b * NS;
    const int nc = (i >= 16) ? 2 : 1, wlo = i > 8 ? i - 8 : 0, nblk = nc + (i + 1) + (i - wlo + 1);
    LAS float* IMPH = (LAS float*)(lds + NSA_IMP + w * 8192); LAS float* INVL = (LAS float*)(lds + NSA_INVL); LAS unsigned* SELM = (LAS unsigned*)(lds + NSA_SELM);
    LAS f32x4m* OFL = (LAS f32x4m*)(lds + NSA_IMP + w * 8192 + lane * 16);
    int tok[2]; s16x8_t qf[2][2];
#pragma unroll
    for (int qt = 0; qt < 2; ++qt) { tok[qt] = 8 * w + 4 * qt + (fr >> 2);
#pragma unroll
        for (int s = 0; s < 2; ++s) qf[qt][s] = *(const s16x8_t*)(Z + (mb + 64 * i + tok[qt]) * ZW + C_NQ + 64 * (4 * g + (fr & 3)) + 32 * s + 8 * fq); }
    f32x4m O[2][4]; float lsum[2] = {0.f, 0.f}; float carry[2] = {0.f, 0.f}; unsigned selm[2] = {0u, 0u};
#pragma unroll
    for (int qt = 0; qt < 2; ++qt)
#pragma unroll
        for (int dt = 0; dt < 4; ++dt) O[qt][dt] = (f32x4m){0.f, 0.f, 0.f, 0.f};
    const int skey = tid >> 3, spx = (tid & 7) ^ (skey & 7);
    auto kv_ptrs = [&](int it, const bf16*& kp, const bf16*& vp) {
        if (it < nc) { const size_t o = ((size_t)(b * 2 + g) * (NCMP + 1) + 64 * it + skey) * 64 + spx * 8; kp = WSP(bf16, WS_KC) + o; vp = WSP(bf16, WS_VC) + o; }
        else if (it < nc + i + 1) { const size_t o = (mb + 64 * (it - nc) + skey) * ZW + 64 * g + spx * 8; kp = Z + o + C_KS; vp = Z + o + C_VS; }
        else { const size_t o = (mb + 64 * (wlo + it - nc - i - 1) + skey) * ZW + 64 * g + spx * 8; kp = Z + o + C_KW; vp = Z + o + C_VW; } };
    asm volatile("" : "+v"(qf[0][0]), "+v"(qf[0][1]), "+v"(qf[1][0]), "+v"(qf[1][1]));
    float bnd_c = WSP(float, WS_BND)[l * 3 + 0], bnd_s = WSP(float, WS_BND)[l * 3 + 1], bnd_w = WSP(float, WS_BND)[l * 3 + 2];
    asm volatile("" : "+v"(bnd_c), "+v"(bnd_s), "+v"(bnd_w));
#define NSA_DMA(IT, BUF) do { const bf16 *kp_, *vp_; kv_ptrs((IT), kp_, vp_); \
        const unsigned lb_ = (unsigned)__builtin_amdgcn_readfirstlane((int)((unsigned)(size_t)lds + (unsigned)((BUF) * NSA_KV) + (unsigned)w * 1024u)); unsigned sv_; \
        asm volatile("s_mov_b32 %0, m0\n\ts_mov_b32 m0, %3\n\ts_nop 0\n\tglobal_load_lds_dwordx4 %1, off\n\ts_add_u32 m0, m0, 0x2000\n\ts_nop 0\n\tglobal_load_lds_dwordx4 %2, off\n\ts_mov_b32 m0, %0" \
                     : "=&s"(sv_) : "v"(kp_), "v"(vp_), "s"(lb_) : "memory"); } while (0)
    __syncthreads();
    NSA_DMA(0, 0);
    if (nblk > 1) { NSA_DMA(1, 1); asm volatile("s_waitcnt vmcnt(2)" ::: "memory"); } else asm volatile("s_waitcnt vmcnt(0)" ::: "memory");
    __builtin_amdgcn_s_barrier(); asm volatile("" ::: "memory");
    int bufc = 0;
#pragma unroll 1
    for (int it = 0; it < nblk; ++it) {
        const bool dma_now = it + 2 < nblk;
        if (dma_now) { const int bn = bufc == 0 ? 2 : bufc - 1; NSA_DMA(it + 2, bn); }
        LAS const unsigned char* Kb = lds + bufc * NSA_KV; LAS const unsigned char* Vb = Kb + 8192;
        const int br = it < nc ? 0 : (it < nc + i + 1 ? 1 : 2);
        const int j = br == 0 ? it : (br == 1 ? it - nc : wlo + it - nc - i - 1);
        const float bnd = br == 0 ? bnd_c : (br == 1 ? bnd_s : bnd_w);
        const bool needmask = (br == 0) || (j == i) || (br == 2 && j == i - 8);
        const bool lower = (br == 2 && j == i - 8);
        bool rowok[2]; int thr[2]; float oa[2], ob[2];
#pragma unroll
        for (int qt = 0; qt < 2; ++qt) {
            rowok[qt] = (br == 1) ? (((selm[qt] >> j) & 1u) != 0u) : true;
            thr[qt] = (br == 0) ? ((64 * i + tok[qt] - 31) >> 4) - 64 * j : tok[qt];
            const float on = rowok[qt] ? bnd : 1e30f;
            oa[qt] = lower ? 1e30f : on; ob[qt] = lower ? on : 1e30f; }
        const bool act0 = __ballot(rowok[0]) != 0ull, act1 = __ballot(rowok[1]) != 0ull;
        if (act0 || act1) {
            f32x4m pv[2][4];
#pragma unroll
            for (int qt = 0; qt < 2; ++qt)
#pragma unroll
                for (int kt = 0; kt < 4; ++kt) pv[qt][kt] = (f32x4m){0.f, 0.f, 0.f, 0.f};
#pragma unroll
            for (int sI = 0; sI < 2; ++sI) { s16x8_t kf[4];
#pragma unroll
                for (int kt = 0; kt < 4; ++kt) kf[kt] = *(const LAS s16x8_t*)(Kb + (16 * kt + fr) * 128 + (((4 * sI + fq) ^ (fr & 7)) << 4));
#pragma unroll
                for (int kt = 0; kt < 4; ++kt)
#pragma unroll
                    for (int qt = 0; qt < 2; ++qt) pv[qt][kt] = MFMA16(kf[kt], qf[qt][sI], pv[qt][kt]); }
            if (needmask) {
#pragma unroll
                for (int qt = 0; qt < 2; ++qt)
#pragma unroll
                    for (int kt = 0; kt < 4; ++kt)
#pragma unroll
                        for (int reg = 0; reg < 4; ++reg) { const int kk = 16 * kt + 4 * fq + reg; const float off = kk <= thr[qt] ? oa[qt] : ob[qt];
                            pv[qt][kt][reg] = __builtin_amdgcn_exp2f(pv[qt][kt][reg] * 1.4426950408889634f - off); lsum[qt] += pv[qt][kt][reg]; } }
            else {
#pragma unroll
                for (int qt = 0; qt < 2; ++qt)
#pragma unroll
                    for (int kt = 0; kt < 4; ++kt)
#pragma unroll
                        for (int reg = 0; reg < 4; ++reg) { pv[qt][kt][reg] = __builtin_amdgcn_exp2f(pv[qt][kt][reg] * 1.4426950408889634f - oa[qt]); lsum[qt] += pv[qt][kt][reg]; } }
            if (br == 0) {
                const int src = (lane + 48) & 63;
#pragma unroll
                for (int qt = 0; qt < 2; ++qt) {
#pragma unroll
                    for (int kt = 0; kt < 4; ++kt) { const float a4 = pv[qt][kt][0] + pv[qt][kt][1] + pv[qt][kt][2] + pv[qt][kt][3];
                        const float xs = __shfl(pv[qt][kt][3], src), xp = __shfl(kt == 0 ? carry[qt] : pv[qt][kt > 0 ? kt - 1 : 0][3], src);
                        IMPH[((4 * qt + (fr >> 2)) * 4 + (fr & 3)) * 32 + 16 * j + 4 * kt + fq] = a4 + (fq == 0 ? xp : xs); }
                    carry[qt] = pv[qt][3][3]; } }
            const s16x8_t pf00 = pack8(pv[0][0], pv[0][1]), pf01 = pack8(pv[0][2], pv[0][3]), pf10 = pack8(pv[1][0], pv[1][1]), pf11 = pack8(pv[1][2], pv[1][3]);
#pragma unroll
            for (int ks = 0; ks < 2; ++ks) { s16x8_t vf[4];
#pragma unroll
                for (int dt = 0; dt < 4; ++dt) vf[dt] = tr_frag_perm_swz(Vb, 32 * ks, 16 * dt, lane);
#pragma unroll
                for (int dt = 0; dt < 4; ++dt) { O[0][dt] = MFMA16(vf[dt], ks ? pf01 : pf00, O[0][dt]); O[1][dt] = MFMA16(vf[dt], ks ? pf11 : pf10, O[1][dt]); } }
        }
        const bool bend = (it == nc - 1) || (it == nc + i) || (it == nblk - 1);
        if (bend) {
            float scl[2];
#pragma unroll
            for (int qt = 0; qt < 2; ++qt) { float ls = lsum[qt]; ls += __shfl_xor(ls, 16); ls += __shfl_xor(ls, 32);
                const float inv = ls > 0.f ? 1.0f / ls : 0.f;
                const float gate = 1.0f / (1.0f + __expf(-GL[(mb + 64 * i + tok[qt]) * 24 + (4 * g + (fr & 3)) * 3 + br]));
                scl[qt] = gate * inv; lsum[qt] = 0.f;
                if (br == 0 && fq == 0) INVL[tok[qt] * 4 + (fr & 3)] = inv; }
            if (br == 0) {
#pragma unroll 1
                for (int rnd = 0; rnd < 4; ++rnd) { const int tk = 8 * w + 2 * rnd + (lane >> 5), jj = lane & 31;
                    const bool forced = (jj == 0) || (jj == i) || (jj == i - 1);
                    float sc = -1.f;
                    if (jj <= i) { sc = 0.f;
#pragma unroll
                        for (int r = 0; r < 4; ++r) sc += IMPH[((2 * rnd + (lane >> 5)) * 4 + r) * 32 + jj] * INVL[tk * 4 + r]; }
                    if (forced) sc = 1e4f;
                    int rank = 0;
#pragma unroll
                    for (int d = 1; d < 32; ++d) { const int oj = (jj + d) & 31; const float o = __shfl(sc, (lane & 32) | oj); rank += (o > sc || (o == sc && oj < jj)) ? 1 : 0; }
                    const unsigned long long bal = __ballot(rank < 8);
                    if (lane == 0) { SELM[8 * w + 2 * rnd] = (unsigned)bal; SELM[8 * w + 2 * rnd + 1] = (unsigned)(bal >> 32); } }
                selm[0] = SELM[tok[0]]; selm[1] = SELM[tok[1]];
            }
#pragma unroll
            for (int qt = 0; qt < 2; ++qt)
#pragma unroll
                for (int dt = 0; dt < 4; ++dt) { const f32x4m prev = br == 0 ? (f32x4m){0.f, 0.f, 0.f, 0.f} : OFL[(qt * 4 + dt) * 64]; OFL[(qt * 4 + dt) * 64] = prev + O[qt][dt] * scl[qt]; O[qt][dt] = (f32x4m){0.f, 0.f, 0.f, 0.f}; }
        }
        if (dma_now) asm volatile("s_waitcnt vmcnt(2)" ::: "memory"); else asm volatile("s_waitcnt vmcnt(0)" ::: "memory");
        asm volatile("s_waitcnt lgkmcnt(0)" ::: "memory");
        __builtin_amdgcn_s_barrier(); asm volatile("" ::: "memory");
        bufc = bufc == 2 ? 0 : bufc + 1;
    }
#undef NSA_DMA
#pragma unroll
    for (int qt = 0; qt < 2; ++qt)
#pragma unroll
        for (int dt = 0; dt < 4; ++dt) { const f32x4m of = OFL[(qt * 4 + dt) * 64]; u32x2_t o; o.x = pk_bf16(of[0], of[1]); o.y = pk_bf16(of[2], of[3]);
            *(u32x2_t*)(MIX + (mb + 64 * i + tok[qt]) * D + 512 + 64 * (4 * g + (fr & 3)) + 16 * dt + 4 * fq) = o; }
}
__device__ __forceinline__ void nsa_units(const P& p, LAS unsigned char* lds, int l, int vcu, int G) {
    for (int u = vcu; u < NB * 2 * NSEL; u += G) { const int k = u >> 8, v = u & 255, bg = v >> 3, r8 = v & 7;
        const int i = k == 0 ? 31 - r8 : (k == 1 ? 16 + r8 : (k == 2 ? 15 - r8 : r8));
        nsa_unit(p, lds, l, bg >> 1, bg & 1, i); }
}
constexpr int MOE_TAB = 131072;
constexpr size_t WS_ACT = WS_Z;
static_assert((size_t)(M + 24 * 256) * 1024 * 2 <= (size_t)M * ZW * 2, "ACT must fit inside Z");
__device__ __forceinline__ void moe_table(const P& p, LAS unsigned char* lds, int l) {
    LAS int* tab = LDSP(int, MOE_TAB);
    if (tid_fresh() == 0) { int acc = 0; for (int c = 0; c < 24; ++c) { const int n = WSP(int, WS_CTL)[CW_CNT + l * 64 + c]; tab[c] = acc; tab[25 + c] = n; acc += (n + 255) >> 8; } tab[24] = acc; }
    __syncthreads();
}
__device__ __forceinline__ void pair_experts(int cls, int& ea, int& eb) { const int g = cls / 6, pr = cls % 6; const int lo = pr < 3 ? 0 : (pr < 5 ? 1 : 2), hi = pr < 3 ? pr + 1 : (pr < 5 ? pr - 1 : 3); ea = g * 4 + lo; eb = g * 4 + hi; }
template <int NPN> struct MoeSchedBase {
    const P* pp; LAS int* tab; int l, G, c;
    __device__ __forceinline__ bool next(int i, pg8::Unit& u) const {
        int L, hf; if (!pg8::deal_unit(i, G, c, tab[24] * NPN, L, hf)) return false; u.half = hf;
        const int rt = L / NPN; int cls = 0;
        for (int k = 1; k < 24; ++k) cls = (tab[k] <= rt) ? k : cls;
        while (tab[25 + cls] == 0 && cls > 0) --cls;
        u.pm = rt; u.pn = L % NPN; u.aux = cls | ((rt - tab[cls]) << 8); return true;
    }
};
struct MoeSchedA : MoeSchedBase<8> {
    static constexpr bool GATHER = true; static constexpr int GOFF_LDS = MOE_TAB + 1024;
    __device__ __forceinline__ int ktiles() const { return D / 64; }
    __device__ __forceinline__ size_t a_kstep() const { return 128; }
    __device__ __forceinline__ const char* a_base() const { return (const char*)(pp->ws + WS_H); }
    __device__ __forceinline__ unsigned a_off(const pg8::Unit& u, int row, int C) const {
        const P& p = *pp; const int cls = u.aux & 255, slot = (u.aux >> 8) * 256 + row, n = tab[25 + cls];
        const int tok = WSP(int, WS_CTOK)[(size_t)cls * M + (slot < n ? slot : 0)];
        return (unsigned)(tok * D + C) * 2u; }
    __device__ __forceinline__ unsigned b_ld() const { return D * 2u; }
    __device__ __forceinline__ const char* b_tile(const pg8::Unit& u, int t) const {
        int ea, eb; pair_experts(u.aux & 255, ea, eb); const int e = u.pn < 4 ? ea : eb;
        return (const char*)(pp->ws + WS_WGU_T) + ((size_t)(l * 16 + e) * 1024 + (size_t)(u.pn & 3) * 256) * D * 2 + (size_t)t * 128; }
};
struct MoeSchedB : MoeSchedBase<4> {
    static constexpr bool GATHER = false; static constexpr int GOFF_LDS = 0;
    __device__ __forceinline__ int ktiles() const { return 16; }
    __device__ __forceinline__ size_t a_kstep() const { return 128; }
    __device__ __forceinline__ const char* a_base() const { return (const char*)(pp->ws + WS_ACT); }
    __device__ __forceinline__ unsigned a_off(const pg8::Unit& u, int row, int C) const { return (unsigned)((u.pm * 256 + row) * 1024 + C) * 2u; }
    __device__ __forceinline__ unsigned b_ld() const { return 512 * 2u; }
    __device__ __forceinline__ const char* b_tile(const pg8::Unit& u, int t) const {
        int ea, eb; pair_experts(u.aux & 255, ea, eb); const int e = t < 8 ? ea : eb;
        return (const char*)(pp->ws + WS_WD_T) + ((size_t)(l * 16 + e) * D + (size_t)u.pn * 256) * 512 * 2 + (size_t)(t & 7) * 128; }
};
struct EpiMoeA {
    static constexpr bool PERM = true, AFTER_DRAIN = false;
    const P* pp; LAS int* tab;
    __device__ __forceinline__ void operator()(const pg8::f32x4 (&acc)[2][2][4][2], const pg8::Unit& u, int wr, int wc, int fr, int fq) const {
        const P& p = *pp; const int cls = u.aux & 255, s0 = (u.aux >> 8) * 256, n = tab[25 + cls], which = u.pn >> 2;
        bf16* O = WSP(bf16, WS_ACT);
        float wts[2][4];
#pragma unroll
        for (int ai = 0; ai < 2; ++ai)
#pragma unroll
            for (int m = 0; m < 4; ++m) { const int slot = s0 + (u.half ? 0 : ai * 128) + wr * 64 + m * 16 + fr + (u.half == 2 ? 128 : 0); wts[ai][m] = slot < n ? WSP(float, WS_CWT)[((size_t)cls * M + slot) * 2 + which] : 0.f; }
#pragma unroll
        for (int ai = 0; ai < 2; ++ai)
#pragma unroll
            for (int m = 0; m < 4; ++m) { if (ai == 1 && u.half) continue; const int r = ai * 128 + wr * 64 + m * 16 + fr + (u.half == 2 ? 128 : 0);
                const float w = wts[ai][m];
                const pg8::f32x4 g0 = acc[ai][0][m][0], g1 = acc[ai][0][m][1], u0 = acc[ai][1][m][0], u1 = acc[ai][1][m][1];
                float v[8];
#pragma unroll
                for (int j = 0; j < 4; ++j) { v[j] = w * silu_fast(g0[j]) * u0[j]; v[4 + j] = w * silu_fast(g1[j]) * u1[j]; }
                pg8::u32x4 o; o.x = pk_bf16(v[0], v[1]); o.y = pk_bf16(v[2], v[3]); o.z = pk_bf16(v[4], v[5]); o.w = pk_bf16(v[6], v[7]);
                *(pg8::u32x4*)(O + (size_t)(u.pm * 256 + r) * 1024 + u.pn * 128 + wc * 32 + 8 * fq) = o; }
    }
};
struct EpiMoeB {
    static constexpr bool PERM = true, AFTER_DRAIN = false;
    const P* pp; LAS int* tab; int l; bool dry; const bf16* xin; void* xout; bool obf;
    __device__ __forceinline__ void operator()(const pg8::f32x4 (&acc)[2][2][4][2], const pg8::Unit& u, int wr, int wc, int fr, int fq) const {
        const P& p = *pp; const int cls = u.aux & 255, s0 = (u.aux >> 8) * 256, n = dry ? 0 : tab[25 + cls], col0 = u.pn * 256 + wc * 32 + 8 * fq;
        int toks[2][4];
#pragma unroll
        for (int ai = 0; ai < 2; ++ai)
#pragma unroll
            for (int m = 0; m < 4; ++m) { const int slot = s0 + (u.half ? 0 : ai * 128) + wr * 64 + m * 16 + fr + (u.half == 2 ? 128 : 0); toks[ai][m] = slot < n ? WSP(int, WS_CTOK)[(size_t)cls * M + slot] : -1; }
#pragma unroll
        for (int ai = 0; ai < 2; ++ai) { if (ai == 1 && u.half) continue;
#pragma unroll
            for (int mp = 0; mp < 2; ++mp) {
                pg8::u32x4 xw[2][2]; pg8::f32x4 ga[2][2], gb[2][2];
#pragma unroll
                for (int mm = 0; mm < 2; ++mm) { const int tok = toks[ai][2 * mp + mm], tk = tok < 0 ? 0 : tok;
                    const float* gp = WSP(float, WS_MOD) + ((size_t)l * NB + tk / NS) * 6144 + 5120 + col0; const size_t ro = (size_t)tk * D + col0;
#pragma unroll
                    for (int bj = 0; bj < 2; ++bj) { xw[mm][bj] = *(const pg8::u32x4*)(xin + ro + bj * 128); ga[mm][bj] = *(const pg8::f32x4*)(gp + bj * 128); gb[mm][bj] = *(const pg8::f32x4*)(gp + bj * 128 + 4); } }
#pragma unroll
                for (int mm = 0; mm < 2; ++mm) { const int m = 2 * mp + mm, tok = toks[ai][m]; if (tok < 0) continue; const size_t ro = (size_t)tok * D + col0;
#pragma unroll
                    for (int bj = 0; bj < 2; ++bj) { const pg8::u32x4 w = xw[mm][bj];
                        pg8::f32x4 x0 = {__builtin_bit_cast(float, w.x << 16), __builtin_bit_cast(float, w.x & 0xffff0000u), __builtin_bit_cast(float, w.y << 16), __builtin_bit_cast(float, w.y & 0xffff0000u)};
                        pg8::f32x4 x1 = {__builtin_bit_cast(float, w.z << 16), __builtin_bit_cast(float, w.z & 0xffff0000u), __builtin_bit_cast(float, w.w << 16), __builtin_bit_cast(float, w.w & 0xffff0000u)};
                        x0 += ga[mm][bj] * acc[ai][bj][m][0]; x1 += gb[mm][bj] * acc[ai][bj][m][1];
                        if (obf) { pg8::u32x4 o; o.x = pk_bf16(x0[0], x0[1]); o.y = pk_bf16(x0[2], x0[3]); o.z = pk_bf16(x1[0], x1[1]); o.w = pk_bf16(x1[2], x1[3]); *(pg8::u32x4*)((bf16*)xout + ro + bj * 128) = o; }
                        else { *(pg8::f32x4*)((float*)xout + ro + bj * 128) = x0; *(pg8::f32x4*)((float*)xout + ro + bj * 128 + 4) = x1; } } } } }
    }
};
__device__ __forceinline__ void moe_a_phase(const P& p, LAS unsigned char* lds, int l) {
    moe_table(p, lds, l);
    MoeSchedA S; S.pp = &p; S.tab = LDSP(int, MOE_TAB); S.l = l; S.G = grid_fresh(); S.c = bid_fresh();
    EpiMoeA E{&p, LDSP(int, MOE_TAB)}; pg8::gemm_phase(lds, S, E);
}
__device__ __forceinline__ void moe_b_phase(const P& p, LAS unsigned char* lds, int l, bool dry = false, void* xout = nullptr, int obf = -1) {
    if (!xout) xout = p.out;
    if (obf < 0) obf = (l + 1 < NL);
    moe_table(p, lds, l);
    MoeSchedB S; S.pp = &p; S.tab = LDSP(int, MOE_TAB); S.l = l; S.G = grid_fresh(); S.c = bid_fresh();
    EpiMoeB E{&p, LDSP(int, MOE_TAB), l, dry, WSP(bf16, WS_XB), xout, obf != 0}; pg8::gemm_phase(lds, S, E);
}
constexpr int LDS_BYTES = 147456;
struct Args { P p; };
typedef const __attribute__((address_space(4))) P* KargP;
__device__ __forceinline__ KargP p_fresh() { KargP k = (KargP)__builtin_amdgcn_kernarg_segment_ptr(); asm volatile("" : "+s"(k)); return k; }
__device__ __forceinline__ P load_p() { KargP k = p_fresh(); P q; const void* const __attribute__((address_space(4)))* src = (const void* const __attribute__((address_space(4)))*)k; const void** dst = (const void**)&q;
#pragma unroll
    for (int i = 0; i < (int)(sizeof(P) / sizeof(void*)); ++i) dst[i] = src[i];
    return q; }
#define LAYER_BODY(l) do { \
        { const P p = load_p(); norm_phase(p, lds, l ? (const void*)p.out : (const void*)p.x, l != 0, l, 0); } \
        GRID_BAR(); \
        { const P p = load_p(); pg8::StaticSched S; S.init(WSP(bf16, WS_H), WSP(bf16, WS_WIN_T) + (size_t)l * ZW * D, M, ZW, D, grid_fresh(), bid_fresh()); EpiZ E{&p, l}; pg8::gemm_phase(lds, S, E); gl_tail(p, l); } \
        GRID_BAR(); \
        { const P p = load_p(); premix_phase(p, lds, l); } \
        GRID_BAR(); \
        { const P p = load_p(); nsa_units(p, lds, l, bid_fresh(), grid_fresh()); } \
        { const P p = load_p(); for (int u = bid_fresh(); u < NB * 4 * NCH; u += grid_fresh()) ret_out_unit(p, lds, l, u); } \
        GRID_BAR(); \
        { const P p = load_p(); pg8::StaticSched S; S.init(WSP(bf16, WS_MIX), WSP(bf16, WS_WOUT_T) + (size_t)l * D * D, M, D, D, grid_fresh(), bid_fresh()); \
          pg8::EpiResidual E{l ? (const void*)p.out : (const void*)p.x, l != 0, WSP(bf16, WS_XB), WSP(float, WS_MOD) + (size_t)l * NB * 6144 + 2048}; pg8::gemm_phase(lds, S, E); } \
        GRID_BAR(); \
        { const P p = load_p(); norm_phase(p, lds, WSP(bf16, WS_XB), true, l, 1); } \
        GRID_BAR(); \
        { const P p = load_p(); moe_a_phase(p, lds, l); } \
        GRID_BAR(); \
        { const P p = load_p(); moe_b_phase(p, lds, l); } \
} while (0)
__global__ void __launch_bounds__(NTH, 2) fwd_kernel(Args a) {
    extern __shared__ __attribute__((aligned(16))) unsigned char lds_raw[];
    LAS unsigned char* lds = (LAS unsigned char*)lds_raw;
    volatile LAS unsigned* MISC = (volatile LAS unsigned*)(lds + LDS_BYTES - 64);
    if (threadIdx.x < 16) MISC[threadIdx.x] = 0u;
    __syncthreads();
    (void)xcd_barrier_post((unsigned*)(a.p.ws + WS_CTL) + CW_BAR, MISC);
#define GRID_BAR() do { XcdBarrier bar_; bar_.bar = (unsigned*)(load_p().ws + WS_CTL) + CW_BAR; bar_.x = xb_xcc_id(); bar_.st = (volatile LAS unsigned*)(lds + LDS_BYTES - 64); xcd_barrier(bar_); } while (0)
    { const P p = load_p(); p0_prologue(p, lds); }
    GRID_BAR();
    LAYER_BODY(0);
    GRID_BAR();
    LAYER_BODY(1);
}
extern "C" void kernel_launch(void* const* d_in, const int* in_sizes, int n_in, void* d_out, int out_size, void* d_ws, size_t ws_size, hipStream_t stream) {
    static int grid = 0;
    if (grid == 0) {
        int dev = 0, cus = 0, per_cu = 0;
        if (n_in != 26 || out_size != M * D || ws_size < WS_END) { fprintf(stderr, "kernel_launch: unexpected shapes (n_in %d out %d ws %zu need %zu)\n", n_in, out_size, ws_size, (size_t)WS_END); grid = -1; return; }
        if (hipGetDevice(&dev) != hipSuccess || hipDeviceGetAttribute(&cus, hipDeviceAttributeMultiprocessorCount, dev) != hipSuccess) { grid = -1; return; }
        if (hipFuncSetAttribute((const void*)fwd_kernel, hipFuncAttributeMaxDynamicSharedMemorySize, LDS_BYTES) != hipSuccess) { fprintf(stderr, "kernel_launch: hipFuncSetAttribute failed\n"); grid = -1; return; }
        if (hipOccupancyMaxActiveBlocksPerMultiprocessor(&per_cu, (const void*)fwd_kernel, NTH, LDS_BYTES) != hipSuccess || per_cu < 1) { fprintf(stderr, "kernel_launch: occupancy query reports %d workgroups per CU\n", per_cu); per_cu = 1; }
        (void)hipGetLastError();
        grid = cus;
    }
    if (grid < 0) return;
    (void)hipMemsetAsync((char*)d_ws + WS_CTL, 0, 1u << 20, stream);
    Args a{};
    const void** pp = (const void**)&a.p;
    for (int i = 0; i < 26; ++i) pp[i] = d_in[i];
    a.p.out = (float*)d_out; a.p.ws = (unsigned char*)d_ws;
    hipLaunchKernelGGL(fwd_kernel, dim3(grid), dim3(NTH), LDS_BYTES, stream, a);
}
```

```cpp
#include <hip/hip_runtime.h>
#include <cstdio>
#include <cstdint>
#define HD __device__ __attribute__((always_inline))
__device__ __forceinline__ int tid_fresh() { int t = threadIdx.x; asm volatile("" : "+v"(t)); return t; }
__device__ __forceinline__ int bid_fresh() { int t = blockIdx.x; asm volatile("" : "+s"(t)); return t; }
__device__ __forceinline__ int grid_fresh() { int t = gridDim.x; asm volatile("" : "+s"(t)); return t; }
#ifndef CFG_B
#define CFG_B 16
#endif
#ifndef CFG_S
#define CFG_S 2048
#endif
constexpr int NB = CFG_B, NS = CFG_S, M = NB * NS, D = 1024, NIN = 2840, ZW = 2816, NL = 2;
constexpr int C_RQ = 0, C_RK = 256, C_RV = 512, C_RG = 768, C_GU = 1024, C_GV = 1280, C_NQ = 1536, C_KC = 2048, C_VC = 2176,
              C_KS = 2304, C_VS = 2432, C_KW = 2560, C_VW = 2688;
constexpr int NCMP = NS / 16 - 1, NSEL = NS / 64, NCH = NS / 128;
constexpr float EPS = 1e-6f;

typedef unsigned short bf16;
HD inline bf16 f2bf(float f) { unsigned u = __builtin_bit_cast(unsigned, f); u += 0x7FFFu + ((u >> 16) & 1u); return (bf16)(u >> 16); }
HD inline float bf2f(bf16 b) { return __builtin_bit_cast(float, ((unsigned)b) << 16); }
HD inline float silu_f(float x) { return x / (1.f + expf(-x)); }
HD inline float sigm_f(float x) { return 1.f / (1.f + expf(-x)); }
HD inline float gelu_f(float x) { return 0.5f * x * (1.f + tanhf(0.7978845608028654f * (x + 0.044715f * x * x * x))); }
#ifndef HOST_EMU
__device__ __forceinline__ float gelu_fast(float x) { const float u = 1.5957691216057308f * (x + 0.044715f * x * x * x); return x * __builtin_amdgcn_rcpf(1.f + __expf(-u)); }
__device__ __forceinline__ float silu_fast(float x) { return x * __builtin_amdgcn_rcpf(1.f + __expf(-x)); }
#endif
HD inline float invfreq(int i) { return exp2f(-(float)i * (13.287712379549449f / 32.f)); }

constexpr size_t MiB = 1u << 20;
constexpr size_t al(size_t x) { return (x + 255) & ~(size_t)255; }
constexpr size_t WS_CTL = 0;
constexpr int CW_BAR = 4096, CW_CNT = 16384;
constexpr size_t WS_MOD = 1 * MiB;
constexpr size_t WS_RS = WS_MOD + al((size_t)NL * NB * 6144 * 4);
constexpr size_t WS_GL = WS_RS + al((size_t)M * 4);
constexpr size_t WS_LOG = WS_GL + al((size_t)M * 24 * 4);
constexpr size_t WS_ROUT = WS_LOG + al((size_t)M * 16 * 4);
constexpr size_t WS_KC = WS_ROUT + al((size_t)M * 16);
constexpr size_t WS_VC = WS_KC + al((size_t)NB * 2 * (NCMP + 1) * 64 * 2);
constexpr size_t WS_HID = WS_VC + al((size_t)NB * 2 * (NCMP + 1) * 64 * 2);
constexpr size_t WS_CRAW = WS_HID + al((size_t)NB * NCMP * 4 * 128 * 4);
constexpr size_t WS_SEL = WS_CRAW + al((size_t)NB * NCMP * 4 * 64 * 4);
constexpr size_t WS_CS = WS_SEL + al((size_t)M * 16 * 4);
constexpr size_t WS_CSB = WS_CS + al((size_t)M * 64 * 4);
constexpr size_t WS_PEB = WS_CSB + al((size_t)M * 64 * 2);
constexpr size_t WS_BND = WS_PEB + 4096;
constexpr size_t WS_KVS = WS_BND + 256;
constexpr size_t WS_CTOK = WS_KVS + al((size_t)NB * 4 * NCH * 4096 * 4);
constexpr size_t WS_CWT = WS_CTOK + al((size_t)24 * M * 4);
constexpr size_t WS_WIN_T = WS_CWT + al((size_t)24 * M * 8);
constexpr size_t WS_WGL_T = WS_WIN_T + al((size_t)NL * ZW * D * 2);
constexpr size_t WS_WOUT_T = WS_WGL_T + al((size_t)NL * 32 * D * 2);
constexpr size_t WS_WGU_T = WS_WOUT_T + al((size_t)NL * D * D * 2);
constexpr size_t WS_WD_T = WS_WGU_T + al((size_t)NL * 16 * 1024 * D * 2);
constexpr size_t WS_CW1_T = WS_WD_T + al((size_t)NL * 16 * D * 512 * 2);
constexpr size_t WS_CW2_T = WS_CW1_T + al((size_t)NL * 2 * 256 * 1024 * 2);
constexpr size_t WS_GWS = WS_CW2_T + al((size_t)NL * 2 * 64 * 128 * 2);
constexpr size_t WS_H = al(WS_GWS + (size_t)NL * 4 * 128 * 128 * 2);
constexpr size_t WS_Z = WS_H + al((size_t)M * D * 2);
constexpr size_t WS_XB = WS_Z + 88 * MiB;
constexpr size_t WS_MIX = WS_Z + al((size_t)M * ZW * 2);
constexpr size_t WS_END = WS_MIX + al((size_t)M * D * 2);
constexpr size_t WS_PB = WS_END;
constexpr size_t WS_END_NAIVE = WS_PB + al((size_t)M * 2 * 128 * 4);
constexpr size_t WS_YN = WS_H;
constexpr size_t WS_ACTN = WS_Z;
static_assert(WS_XB + (size_t)M * D * 2 <= WS_Z + (size_t)M * ZW * 2, "XB must fit in Z above ACT");
static_assert(CFG_B != 16 || CFG_S != 2048 || WS_END <= 512 * MiB, "workspace map exceeds 512 MiB");

struct P {
    const float *x, *c; const int* pos;
    const float *ada_w, *ada_b, *norm_mix_g, *norm_ffn_g, *w_in, *w_out, *ret_norm_g, *gmlp_ln_g, *gmlp_ws, *gmlp_b, *nsa_q_norm_g, *nsa_k_norm_g,
        *cmp_pe_k, *cmp_pe_v, *cmp_w1_k, *cmp_w2_k, *cmp_w1_v, *cmp_w2_v, *router_w, *router_b, *moe_w_gate, *moe_w_up, *moe_w_down;
    float* out; unsigned char* ws;
};
struct Rout { int e0, e1; float w0, w1; };

#define WSP(T, off) ((T*)(p.ws + (off)))

#define XB_TMO      128
#define XB_XCNT(j)  (256  + 64 * (j))
#define XB_XSUB(j)  (1280 + 64 * (j))
#define XB_XGEN(j)  (2304 + 64 * (j))
#define XB_TOP      3328
#define XB_TOPGEN   3392
#define XCD_BAR_WORDS 3456
#ifndef XB_SPIN_CAP
#define XB_SPIN_CAP (1u << 15)
#endif
#define LAS __attribute__((address_space(3)))
__device__ __forceinline__ unsigned xb_ld(unsigned* p)              { return __hip_atomic_load(p, __ATOMIC_RELAXED, __HIP_MEMORY_SCOPE_AGENT); }
__device__ __forceinline__ unsigned xb_add(unsigned* p, unsigned v) { return __hip_atomic_fetch_add(p, v, __ATOMIC_RELAXED, __HIP_MEMORY_SCOPE_AGENT); }
__device__ __forceinline__ unsigned xb_xcc_id() { return (unsigned)__builtin_amdgcn_s_getreg((3 << 11) | 20) & 0xFu; }
#define XB_SPIN(cond, bar) do { unsigned _sp = 0; while (cond) { __builtin_amdgcn_s_sleep(1); \
    if ((++_sp & 255u) == 0u) { if (xb_ld(&(bar)[XB_TMO])) break; if (_sp > XB_SPIN_CAP) { atomicAdd(&(bar)[XB_TMO], 1u); break; } } } } while (0)
struct XcdBarrier { unsigned* bar; unsigned x; volatile LAS unsigned* st; };
__device__ __forceinline__ XcdBarrier xcd_barrier_post(unsigned* bar, volatile LAS unsigned* st) {
    XcdBarrier b; b.bar = bar; b.x = xb_xcc_id(); b.st = st;
    if (threadIdx.x == 0) (void)xb_add(&bar[XB_XCNT(b.x)], 1u);
    return b;
}
__device__ __forceinline__ void xcd_barrier_complete(unsigned* bar, unsigned x, unsigned& nloc, unsigned& nx) {
    const unsigned G = gridDim.x * gridDim.y * gridDim.z;
    unsigned sum, cnt, mine, sp = 0u;
    for (;;) {
        sum = 0u; cnt = 0u; mine = 0u;
#pragma unroll
        for (unsigned j = 0; j < 16; ++j) { const unsigned c = xb_ld(&bar[XB_XCNT(j)]); sum += c; cnt += (c > 0u) ? 1u : 0u; mine = (j == x) ? c : mine; }
        if (sum == G) break;
        __builtin_amdgcn_s_sleep(1);
        if ((++sp & 255u) == 0u) { if (xb_ld(&bar[XB_TMO])) break; if (sp > XB_SPIN_CAP) { atomicAdd(&bar[XB_TMO], 1u); break; } }
    }
    nloc = mine > 0u ? mine : 1u; nx = cnt > 0u ? cnt : 1u;
}
__device__ __forceinline__ void xcd_barrier(const XcdBarrier& b) {
    asm volatile("s_waitcnt vmcnt(0)" ::: "memory");
    __syncthreads();
    if (threadIdx.x == 0) {
        unsigned* bar = b.bar;
        __builtin_amdgcn_s_waitcnt(0);
        unsigned nloc = b.st[0], nx = b.st[1];
        if (nloc == 0u) { xcd_barrier_complete(bar, b.x, nloc, nx); b.st[0] = nloc; b.st[1] = nx; }
        const unsigned old = xb_add(&bar[XB_XSUB(b.x)], 1u);
        const unsigned gen = old / nloc;
        if (old + 1u == (gen + 1u) * nloc) {
            __builtin_amdgcn_fence(__ATOMIC_RELEASE, "agent");
            asm volatile("s_waitcnt vmcnt(0)" ::: "memory");
            const unsigned og = xb_add(&bar[XB_TOP], 1u);
            const unsigned tg = og / nx;
            if (og + 1u == (tg + 1u) * nx) xb_add(&bar[XB_TOPGEN], 1u);
            else XB_SPIN(xb_ld(&bar[XB_TOPGEN]) == tg, bar);
            __builtin_amdgcn_fence(__ATOMIC_ACQUIRE, "agent");
            xb_add(&bar[XB_XGEN(b.x)], 1u);
            asm volatile("s_waitcnt vmcnt(0)" ::: "memory");
        } else {
            XB_SPIN(xb_ld(&bar[XB_XGEN(b.x)]) == gen, bar);
            __builtin_amdgcn_fence(__ATOMIC_ACQUIRE, "agent");
            asm volatile("s_waitcnt vmcnt(0)" ::: "memory");
        }
    }
    __syncthreads();
}
namespace pg8 {
#define PG8_LAS __attribute__((address_space(3)))
typedef short bf16x8 __attribute__((ext_vector_type(8)));
typedef float f32x4 __attribute__((ext_vector_type(4)));
typedef float f32x2 __attribute__((ext_vector_type(2)));
typedef unsigned u32x4 __attribute__((ext_vector_type(4)));
typedef unsigned u32x2 __attribute__((ext_vector_type(2)));
constexpr int BM = 256, BK = 64, HALF = 128, HTB = HALF * BK * 2, STAGE_BYTES = 8 * HTB, NXCD = 8, WGM = 8;
__device__ __forceinline__ int lds_byte(int r, int c) { const int st = (r >> 4) * 2 + (c >> 5), rr = r & 15, cc = c & 31, ob = rr * 64 + cc * 2; return st * 1024 + (ob ^ (((ob >> 9) & 1) << 5)); }
__device__ __forceinline__ void stage_rc(int b, int& R, int& C) { const int st = b / 1024, sb = b % 1024, swz = sb ^ (((sb >> 9) & 1) << 5); R = (st >> 1) * 16 + swz / 64; C = (st & 1) * 32 + (swz % 64) / 2; }
__device__ __forceinline__ int perm32(int rho) { const int n = rho >> 4, i = rho & 15; return 8 * (i >> 2) + 4 * n + (i & 3); }
__device__ __forceinline__ unsigned cvt_pk_bf16(float lo, float hi) { unsigned r; asm volatile("v_cvt_pk_bf16_f32 %0, %1, %2" : "=v"(r) : "v"(lo), "v"(hi)); return r; }

struct Unit { int pm, pn, aux, half; };
__device__ __forceinline__ bool deal_unit(int i, int G, int c, int U, int& L, int& half) {
    const int F = (U / G) * G, R = U - F; const long Li = (long)i * G + c; half = 0;
    if (Li < F) { L = (int)Li; return true; }
    if (R == 0 || i > U / G) return false;
    if (2 * R <= G) { if (c >= 2 * R) return false; L = F + (c >> 1); half = 1 + (c & 1); return true; }
    if (Li >= U) return false; L = (int)Li; return true; }
struct StaticSched {
    static constexpr bool GATHER = false; static constexpr int GOFF_LDS = 0;
    const char* A; const char* Bt; int K, nM, nN, nwg, G, c;
    __device__ void init(const void* A_, const void* Bt_, int M_, int N_, int K_, int G_, int c_) { A = (const char*)A_; Bt = (const char*)Bt_; K = K_; nM = M_ / BM; nN = N_ / BM; nwg = nM * nN; G = G_; c = c_; }
    __device__ __forceinline__ bool next(int i, Unit& u) const {
        int L, hf; if (!deal_unit(i, G, c, nwg, L, hf)) return false; u.half = hf;
        int wgid = L; { const int q = nwg / NXCD, r = nwg % NXCD, xcd = wgid % NXCD, off = wgid / NXCD; wgid = (xcd < r ? xcd * (q + 1) : r * (q + 1) + (xcd - r) * q) + off; }
        const int nig = WGM * nN, gid = wgid / nig, fm = gid * WGM, gsz = (nM - fm) < WGM ? (nM - fm) : WGM;
        u.pm = fm + ((wgid % nig) % gsz); u.pn = (wgid % nig) / gsz; u.aux = 0; return true;
    }
    __device__ __forceinline__ int ktiles() const { return K / BK; }
    __device__ __forceinline__ const char* a_base() const { return A; }
    __device__ __forceinline__ size_t a_kstep() const { return BK * 2; }
    __device__ __forceinline__ unsigned a_off(const Unit& u, int row, int C) const { return (unsigned)((u.pm * BM + row) * K + C) * 2u; }
    __device__ __forceinline__ unsigned b_ld() const { return (unsigned)K * 2u; }
    __device__ __forceinline__ const char* b_tile(const Unit& u, int t) const { return Bt + (size_t)u.pn * BM * K * 2 + (size_t)t * (BK * 2); }
};

#ifndef PG8_SP2
#define PG8_SP2 true
#endif
#ifndef PG8_ALIGN
#define PG8_ALIGN true
#endif
template <class Epi, class Sched, bool SP2 = PG8_SP2, bool ALIGN_EPI = PG8_ALIGN>
__device__ __forceinline__ void gemm_phase(PG8_LAS unsigned char* lds, const Sched& S, const Epi& E) {
    const int tid = tid_fresh(), wid = __builtin_amdgcn_readfirstlane(tid >> 6), lane = tid & 63, wr = wid >> 2, wc = wid & 3, fr = lane & 15, fq = lane >> 4;
    const int nt = S.ktiles();
    unsigned voffB[2];
    const unsigned ldb = S.b_ld();
#pragma unroll
    for (int i = 0; i < 2; ++i) { int R, C; stage_rc(tid * 16 + i * 8192, R, C); const int Rb = Epi::PERM ? ((R & ~31) + perm32(R & 31)) : R; voffB[i] = (unsigned)Rb * ldb + (unsigned)C * 2u; }
    const unsigned hstepB = (unsigned)HALF * ldb;
    const unsigned ldsw = (unsigned)wid * 1024u;
    const int aoff = lds_byte(wr * 64 + fr, fq * 8), boff = lds_byte(wc * 32 + fr, fq * 8);
    const char* gA = S.a_base(); const size_t akst = S.a_kstep();
#define PG8_SA(b, h) (((b) * 2 + (h)) * HTB)
#define PG8_SB(b, h) ((4 + (b) * 2 + (h)) * HTB)
#define PG8_STAGE_A(bufoff, offarr, h, tt) do { _Pragma("unroll") for (int _i = 0; _i < 2; ++_i) \
        __builtin_amdgcn_global_load_lds((const unsigned*)(gA + (size_t)(tt) * akst + (offarr)[h][_i]), (PG8_LAS unsigned*)(lds + (bufoff) + ldsw + _i * 8192), 16, 0, 0); } while (0)
#define PG8_STAGE_B(bufoff, bptr, h) do { _Pragma("unroll") for (int _i = 0; _i < 2; ++_i) \
        __builtin_amdgcn_global_load_lds((const unsigned*)((bptr) + (h) * hstepB + voffB[_i]), (PG8_LAS unsigned*)(lds + (bufoff) + ldsw + _i * 8192), 16, 0, 0); } while (0)
#define PG8_LDA(dst, b, h) do { _Pragma("unroll") for (int m = 0; m < 4; ++m) _Pragma("unroll") for (int k = 0; k < 2; ++k) dst[m][k] = *(const PG8_LAS bf16x8*)(lds + PG8_SA(b, h) + aoff + m * 2048 + k * 1024); } while (0)
#define PG8_LDB(dst, b, h) do { _Pragma("unroll") for (int n = 0; n < 2; ++n) _Pragma("unroll") for (int k = 0; k < 2; ++k) dst[n][k] = *(const PG8_LAS bf16x8*)(lds + PG8_SB(b, h) + boff + n * 2048 + k * 1024); } while (0)
#define PG8_MMA(ai, bj, At, Bt) do { __builtin_amdgcn_s_setprio(1); _Pragma("unroll") for (int m = 0; m < 4; ++m) _Pragma("unroll") for (int n = 0; n < 2; ++n) _Pragma("unroll") for (int k = 0; k < 2; ++k) \
        acc[ai][bj][m][n] = __builtin_amdgcn_mfma_f32_16x16x32_bf16(Bt[n][k], At[m][k], acc[ai][bj][m][n], 0, 0, 0); __builtin_amdgcn_s_setprio(0); } while (0)
#define PG8_WAIT_V(n) asm volatile("s_waitcnt vmcnt(" #n ")" ::: "memory")
#define PG8_WAIT_L(n) asm volatile("s_waitcnt lgkmcnt(" #n ")" ::: "memory")
#define PG8_BAR __builtin_amdgcn_s_barrier()
#define PG8_SCHED __builtin_amdgcn_sched_barrier(0)
#define PG8_AOFFS(dst, u) do { _Pragma("unroll") for (int _i = 0; _i < 2; ++_i) { int _R, _C; stage_rc(tid * 16 + _i * 8192, _R, _C); _Pragma("unroll") for (int _h = 0; _h < 2; ++_h) dst[_h][_i] = S.a_off(u, ((u).half ? ((u).half == 2 ? HALF : 0) : _h * HALF) + _R, _C); } } while (0)
#define PG8_NOFF_PUT() do { *(PG8_LAS u32x4*)(lds + Sched::GOFF_LDS + tid * 16) = (u32x4){noff[0][0], noff[0][1], noff[1][0], noff[1][1]}; } while (0)
#define PG8_NOFF_GET(dst) do { const u32x4 _v = *(const PG8_LAS u32x4*)(lds + Sched::GOFF_LDS + tid * 16); dst[0][0] = _v.x; dst[0][1] = _v.y; dst[1][0] = _v.z; dst[1][1] = _v.w; } while (0)
    Unit cur, nxt; int ui = 0;
    if (!S.next(0, cur)) return;
    f32x4 acc[2][2][4][2];
#pragma unroll
    for (int a = 0; a < 2; ++a)
#pragma unroll
        for (int b = 0; b < 2; ++b)
#pragma unroll
            for (int m = 0; m < 4; ++m)
#pragma unroll
                for (int n = 0; n < 2; ++n) acc[a][b][m][n] = (f32x4){0.f, 0.f, 0.f, 0.f};
    bf16x8 At[4][2], B0[2][2], B1[2][2];
    constexpr bool GATHER = Sched::GATHER;
    unsigned coff[2][2], noff[2][2];
    PG8_AOFFS(coff, cur);
    { const char* b0 = S.b_tile(cur, 0); const char* b1 = S.b_tile(cur, 1);
      if constexpr (SP2) {
      PG8_STAGE_B(PG8_SB(0, 0), b0, 0); PG8_STAGE_B(PG8_SB(0, 1), b0, 1); PG8_STAGE_A(PG8_SA(0, 0), coff, 0, 0); PG8_STAGE_A(PG8_SA(0, 1), coff, 1, 0);
      if (wr == 1) PG8_BAR;
      PG8_WAIT_V(2); PG8_BAR;
      PG8_STAGE_B(PG8_SB(1, 0), b1, 0); PG8_STAGE_A(PG8_SA(1, 0), coff, 0, 1); PG8_STAGE_B(PG8_SB(1, 1), b1, 1);
      PG8_WAIT_V(6); PG8_BAR;
      } else {
      PG8_STAGE_B(PG8_SB(0, 0), b0, 0); PG8_STAGE_A(PG8_SA(0, 0), coff, 0, 0); PG8_STAGE_B(PG8_SB(0, 1), b0, 1); PG8_STAGE_A(PG8_SA(0, 1), coff, 1, 0);
      if (wr == 1) PG8_BAR;
      PG8_WAIT_V(4); PG8_BAR;
      PG8_STAGE_B(PG8_SB(1, 0), b1, 0); PG8_STAGE_A(PG8_SA(1, 0), coff, 0, 1); PG8_STAGE_B(PG8_SB(1, 1), b1, 1);
      PG8_WAIT_V(6); PG8_BAR; } }
    for (;;) {
        const bool has_next = S.next(ui + 1, nxt);
        if (has_next) { if constexpr (GATHER) { PG8_AOFFS(noff, nxt); PG8_NOFF_PUT(); } }
        else { nxt = cur;
#pragma unroll
            for (int _h = 0; _h < 2; ++_h)
#pragma unroll
                for (int _i = 0; _i < 2; ++_i) if constexpr (GATHER) noff[_h][_i] = coff[_h][_i]; if constexpr (GATHER) PG8_NOFF_PUT(); }
        for (int t = 0; t < nt; t += 2) {
            const bool last = (t == nt - 2);
            const int t2 = last ? 0 : t + 2, t3 = t2 + 1;
            const char* b2 = last ? S.b_tile(nxt, 0) : S.b_tile(cur, t + 2);
            const char* b3 = last ? S.b_tile(nxt, 1) : S.b_tile(cur, t + 3);
            unsigned o2[2][2];
            if constexpr (GATHER) {
#pragma unroll
                for (int _h = 0; _h < 2; ++_h)
#pragma unroll
                    for (int _i = 0; _i < 2; ++_i) o2[_h][_i] = coff[_h][_i];
                if (last) PG8_NOFF_GET(o2); }
            else { if (last) PG8_AOFFS(o2, nxt); else PG8_AOFFS(o2, cur); PG8_AOFFS(coff, cur); }
            if constexpr (SP2) {
            PG8_LDB(B0, 0, 0); PG8_LDB(B1, 0, 1); PG8_SCHED; PG8_LDA(At, 0, 0); PG8_STAGE_A(PG8_SA(1, 1), coff, 1, t + 1);
            PG8_WAIT_V(8); PG8_WAIT_L(0); PG8_BAR; PG8_MMA(0, 0, At, B0); PG8_MMA(0, 1, At, B1); PG8_BAR; PG8_SCHED;
            PG8_LDA(At, 0, 1); PG8_STAGE_B(PG8_SB(0, 0), b2, 0); PG8_STAGE_B(PG8_SB(0, 1), b2, 1); PG8_STAGE_A(PG8_SA(0, 0), o2, 0, t2);
            PG8_WAIT_V(8); PG8_WAIT_L(0); PG8_BAR; if (!cur.half) { PG8_MMA(1, 0, At, B0); PG8_MMA(1, 1, At, B1); } PG8_BAR; PG8_SCHED;
            PG8_LDB(B0, 1, 0); PG8_LDB(B1, 1, 1); PG8_SCHED; PG8_LDA(At, 1, 0); PG8_STAGE_A(PG8_SA(0, 1), o2, 1, t2);
            PG8_WAIT_V(8); PG8_WAIT_L(0); PG8_BAR; PG8_MMA(0, 0, At, B0); PG8_MMA(0, 1, At, B1); PG8_BAR; PG8_SCHED;
            PG8_LDA(At, 1, 1); PG8_STAGE_B(PG8_SB(1, 0), b3, 0); PG8_STAGE_B(PG8_SB(1, 1), b3, 1); PG8_STAGE_A(PG8_SA(1, 0), o2, 0, t3);
            PG8_WAIT_V(8); PG8_WAIT_L(0); PG8_BAR; if (!cur.half) { PG8_MMA(1, 0, At, B0); PG8_MMA(1, 1, At, B1); } PG8_BAR; PG8_SCHED;
            } else {
            PG8_LDB(B0, 0, 0); PG8_SCHED; PG8_LDA(At, 0, 0); PG8_STAGE_A(PG8_SA(1, 1), coff, 1, t + 1);
            PG8_WAIT_L(8); PG8_BAR; PG8_WAIT_L(0); PG8_MMA(0, 0, At, B0); PG8_BAR; PG8_SCHED;
            PG8_LDB(B1, 0, 1); PG8_STAGE_B(PG8_SB(0, 0), b2, 0);
            PG8_BAR; PG8_WAIT_L(0); PG8_MMA(0, 1, At, B1); PG8_BAR;
            PG8_LDA(At, 0, 1); PG8_STAGE_A(PG8_SA(0, 0), o2, 0, t2);
            PG8_BAR; PG8_WAIT_L(0); PG8_MMA(1, 0, At, B0); PG8_BAR; PG8_SCHED;
            PG8_STAGE_B(PG8_SB(0, 1), b2, 1);
            PG8_WAIT_V(6); PG8_BAR; PG8_MMA(1, 1, At, B1); PG8_BAR;
            PG8_LDB(B0, 1, 0); PG8_SCHED; PG8_LDA(At, 1, 0); PG8_STAGE_A(PG8_SA(0, 1), o2, 1, t2);
            PG8_WAIT_L(8); PG8_BAR; PG8_WAIT_L(0); PG8_MMA(0, 0, At, B0); PG8_BAR; PG8_SCHED;
            PG8_LDB(B1, 1, 1); PG8_STAGE_B(PG8_SB(1, 0), b3, 0);
            PG8_BAR; PG8_WAIT_L(0); PG8_MMA(0, 1, At, B1); PG8_BAR;
            PG8_LDA(At, 1, 1); PG8_STAGE_A(PG8_SA(1, 0), o2, 0, t3);
            PG8_BAR; PG8_WAIT_L(0); PG8_MMA(1, 0, At, B0); PG8_BAR; PG8_SCHED;
            PG8_STAGE_B(PG8_SB(1, 1), b3, 1);
            PG8_WAIT_V(6); PG8_BAR; PG8_MMA(1, 1, At, B1); PG8_BAR;
            }
        }
        if constexpr (ALIGN_EPI) { if (wr == 0) PG8_BAR; }
        if constexpr (!Epi::AFTER_DRAIN) E(acc, cur, wr, wc, fr, fq);
        if (!has_next) break;
#pragma unroll
        for (int a = 0; a < 2; ++a)
#pragma unroll
            for (int b = 0; b < 2; ++b)
#pragma unroll
                for (int m = 0; m < 4; ++m)
#pragma unroll
                    for (int n = 0; n < 2; ++n) acc[a][b][m][n] = (f32x4){0.f, 0.f, 0.f, 0.f};
        cur = nxt; ++ui;
        if constexpr (ALIGN_EPI) { if (wr == 1) PG8_BAR; }
#pragma unroll
        for (int _h = 0; _h < 2; ++_h)
#pragma unroll
            for (int _i = 0; _i < 2; ++_i) if constexpr (GATHER) coff[_h][_i] = 0u;
        if constexpr (GATHER) PG8_NOFF_GET(coff);
    }
    PG8_WAIT_V(0);
    if constexpr (!ALIGN_EPI) { if (wr == 0) PG8_BAR; }
    PG8_BAR;
    if constexpr (Epi::AFTER_DRAIN) E.fused(acc, cur, wr, wc, fr, fq, lds);
#undef PG8_SA
#undef PG8_SB
#undef PG8_STAGE_A
#undef PG8_STAGE_B
#undef PG8_LDA
#undef PG8_LDB
#undef PG8_MMA
#undef PG8_WAIT_V
#undef PG8_WAIT_L
#undef PG8_BAR
#undef PG8_SCHED
#undef PG8_AOFFS
#undef PG8_NOFF_PUT
#undef PG8_NOFF_GET
}

struct EpiBf16Store {
    static constexpr bool PERM = true, AFTER_DRAIN = false;
    bf16* O; int ldc;
    __device__ __forceinline__ void operator()(const f32x4 (&acc)[2][2][4][2], const Unit& u, int wr, int wc, int fr, int fq) const {
        const int row0 = u.pm * BM + wr * 64 + fr + (u.half == 2 ? HALF : 0), col0 = u.pn * BM + wc * 32 + 8 * fq;
#pragma unroll
        for (int ai = 0; ai < 2; ++ai)
#pragma unroll
            for (int m = 0; m < 4; ++m) { if (ai == 1 && u.half) continue; bf16* rowp = O + (size_t)(row0 + ai * HALF + m * 16) * ldc + col0;
#pragma unroll
                for (int bj = 0; bj < 2; ++bj) { const f32x4 v0 = acc[ai][bj][m][0], v1 = acc[ai][bj][m][1];
                    u32x4 w; w.x = cvt_pk_bf16(v0[0], v0[1]); w.y = cvt_pk_bf16(v0[2], v0[3]); w.z = cvt_pk_bf16(v1[0], v1[1]); w.w = cvt_pk_bf16(v1[2], v1[3]);
                    *(u32x4*)(rowp + bj * HALF) = w; } }
    }
};
struct EpiResidual {
    static constexpr bool PERM = true, AFTER_DRAIN = false;
    const void* xs; bool xbf; bf16* out; const float* gate;
    __device__ __forceinline__ void operator()(const f32x4 (&acc)[2][2][4][2], const Unit& u, int wr, int wc, int fr, int fq) const {
        const int row0 = u.pm * BM + wr * 64 + fr + (u.half == 2 ? HALF : 0), col0 = u.pn * BM + wc * 32 + 8 * fq;
        const float* gp = gate + (size_t)((u.pm * BM) / NS) * 6144 + col0;
        f32x4 gv[2][2];
#pragma unroll
        for (int bj = 0; bj < 2; ++bj)
#pragma unroll
            for (int n = 0; n < 2; ++n) gv[bj][n] = *(const f32x4*)(gp + bj * HALF + n * 4);
#pragma unroll
        for (int ai = 0; ai < 2; ++ai) { if (ai == 1 && u.half) continue;
#pragma unroll
          for (int mp = 0; mp < 2; ++mp) {
            f32x4 x0[2][2], x1[2][2];
#pragma unroll
            for (int mm = 0; mm < 2; ++mm) { const size_t ro = (size_t)(row0 + ai * HALF + (2 * mp + mm) * 16) * D + col0;
#pragma unroll
                for (int bj = 0; bj < 2; ++bj) {
                    if (xbf) { const u32x4 w = *(const u32x4*)((const bf16*)xs + ro + bj * HALF);
                        x0[mm][bj] = (f32x4){__builtin_bit_cast(float, w.x << 16), __builtin_bit_cast(float, w.x & 0xffff0000u), __builtin_bit_cast(float, w.y << 16), __builtin_bit_cast(float, w.y & 0xffff0000u)};
                        x1[mm][bj] = (f32x4){__builtin_bit_cast(float, w.z << 16), __builtin_bit_cast(float, w.z & 0xffff0000u), __builtin_bit_cast(float, w.w << 16), __builtin_bit_cast(float, w.w & 0xffff0000u)}; }
                    else { x0[mm][bj] = *(const f32x4*)((const float*)xs + ro + bj * HALF); x1[mm][bj] = *(const f32x4*)((const float*)xs + ro + bj * HALF + 4); } } }
#pragma unroll
            for (int mm = 0; mm < 2; ++mm) { const int m = 2 * mp + mm; const size_t ro = (size_t)(row0 + ai * HALF + m * 16) * D + col0;
#pragma unroll
                for (int bj = 0; bj < 2; ++bj) { const f32x4 y0 = x0[mm][bj] + gv[bj][0] * acc[ai][bj][m][0], y1 = x1[mm][bj] + gv[bj][1] * acc[ai][bj][m][1];
                    u32x4 o; o.x = cvt_pk_bf16(y0[0], y0[1]); o.y = cvt_pk_bf16(y0[2], y0[3]); o.z = cvt_pk_bf16(y1[0], y1[1]); o.w = cvt_pk_bf16(y1[2], y1[3]);
                    *(u32x4*)(out + ro + bj * HALF) = o; } } } }
    }
};
}
constexpr int NTH = 512;
typedef float f32x4_t __attribute__((ext_vector_type(4)));
typedef unsigned u32x4_t __attribute__((ext_vector_type(4)));
typedef unsigned u32x2_t __attribute__((ext_vector_type(2)));
typedef short s16x8_t __attribute__((ext_vector_type(8)));
#define LDSP(T, off) ((LAS T*)(lds + (off)))
__device__ __forceinline__ float wave_sum(float v) {
#pragma unroll
    for (int o = 1; o < 64; o <<= 1) v += __shfl_xor(v, o);
    return v;
}
__device__ __forceinline__ unsigned pk_bf16(float lo, float hi) { return pg8::cvt_pk_bf16(lo, hi); }

constexpr int CVT_WIN = 2 * 16 * 44, CVT_WOUT = 2 * 16 * 16, CVT_G = 32 * 16 * 8, CVT_U = CVT_G, CVT_D = 32 * 8 * 16, CVT_C1 = 4 * 32 * 2, CVT_C2 = 4 * 2;
constexpr int CVT_TOTAL = CVT_WIN + CVT_WOUT + CVT_G + CVT_U + CVT_D + CVT_C1 + CVT_C2;
__device__ __forceinline__ void cvt_job(const P& p, int T, const float*& src, size_t& lds_, bf16*& dst, size_t& ldd, bool& perm) {
    perm = false;
    if (T < CVT_WIN) { const int l = T / 704, r = T % 704, kt = r / 44, nt = r % 44;
        src = p.w_in + (size_t)l * D * NIN + (size_t)kt * 64 * NIN + nt * 64; lds_ = NIN; dst = WSP(bf16, WS_WIN_T) + (size_t)l * ZW * D + (size_t)((nt / 4) * 256 + (nt % 4) * 32) * D + kt * 64; ldd = D; perm = true; return; }
    T -= CVT_WIN;
    if (T < CVT_WOUT) { const int l = T / 256, r = T % 256, kt = r / 16, nt = r % 16;
        src = p.w_out + (size_t)l * D * D + (size_t)kt * 64 * D + nt * 64; lds_ = D; dst = WSP(bf16, WS_WOUT_T) + (size_t)l * D * D + (size_t)nt * 64 * D + kt * 64; ldd = D; return; }
    T -= CVT_WOUT;
    if (T < CVT_G + CVT_U) { const int up = T >= CVT_G; if (up) T -= CVT_G; const int le = T / 128, r = T % 128, kt = r / 8, nt = r % 8;
        src = (up ? p.moe_w_up : p.moe_w_gate) + (size_t)le * D * 512 + (size_t)kt * 64 * 512 + nt * 64; lds_ = 512;
        const int row0 = 256 * (nt / 2) + 64 * (nt % 2) + (up ? 128 : 0);
        dst = WSP(bf16, WS_WGU_T) + (size_t)le * 1024 * D + (size_t)row0 * D + kt * 64; ldd = D; return; }
    T -= CVT_G + CVT_U;
    if (T < CVT_D) { const int le = T / 128, r = T % 128, kt = r / 16, nt = r % 16;
        src = p.moe_w_down + (size_t)le * 512 * D + (size_t)kt * 64 * D + nt * 64; lds_ = D; dst = WSP(bf16, WS_WD_T) + (size_t)le * D * 512 + (size_t)nt * 64 * 512 + kt * 64; ldd = 512; return; }
    T -= CVT_D;
    if (T < CVT_C1) { const int lk = T / 64, l = lk / 2, kv = lk % 2, r = T % 64, kt = r / 2, nt = r % 2;
        src = (kv ? p.cmp_w1_v : p.cmp_w1_k) + (size_t)l * 2048 * 128 + (size_t)kt * 64 * 128 + nt * 64; lds_ = 128; dst = WSP(bf16, WS_CW1_T) + (size_t)lk * 256 * 1024 + (size_t)((kt >= 16 ? 128 : 0) + nt * 64) * 1024 + (kt & 15) * 64; ldd = 1024; return; }
    T -= CVT_C1;
    { const int lk = T / 2, l = lk / 2, kv = lk % 2, kt = T % 2;
        src = (kv ? p.cmp_w2_v : p.cmp_w2_k) + (size_t)l * 128 * 64 + (size_t)kt * 64 * 64; lds_ = 64; dst = WSP(bf16, WS_CW2_T) + (size_t)lk * 64 * 128 + kt * 64; ldd = 128; }
}
__device__ __forceinline__ void p0_prologue(const P& p, LAS unsigned char* lds) {
    const int tid = tid_fresh();
    if (bid_fresh() < 192) {
        LAS float* sc = LDSP(float, 0);
        LAS float* red = LDSP(float, 65536);
        for (int i = tid; i < NB * D; i += NTH) sc[i] = silu_f(p.c[i]);
        __syncthreads();
        const int lane = tid & 63, wv_ = tid >> 6, col = bid_fresh() * 64 + lane, l = col / 6144, n = col % 6144;
        float acc[NB];
#pragma unroll
        for (int b = 0; b < NB; ++b) acc[b] = 0.f;
        const float* w = p.ada_w + (size_t)l * D * 6144 + n;
        for (int k = wv_ * 128; k < wv_ * 128 + 128; k += 16) { float wv[16];
#pragma unroll
            for (int u = 0; u < 16; ++u) wv[u] = w[(size_t)(k + u) * 6144];
#pragma unroll
            for (int u = 0; u < 16; ++u)
#pragma unroll
                for (int b = 0; b < NB; ++b) acc[b] += sc[b * D + k + u] * wv[u]; }
#pragma unroll
        for (int b = 0; b < NB; ++b) red[(wv_ * NB + b) * 64 + lane] = acc[b];
        __syncthreads();
        for (int i = tid; i < NB * 64; i += NTH) { const int b = i >> 6, c = i & 63, cc = bid_fresh() * 64 + c, ll = cc / 6144, nn = cc % 6144; float s = p.ada_b[ll * 6144 + nn];
#pragma unroll
            for (int q = 0; q < 8; ++q) s += red[(q * NB + b) * 64 + c];
            WSP(float, WS_MOD)[((size_t)ll * NB + b) * 6144 + nn] = s; }
        __syncthreads();
    }
    { constexpr int TP = 8; const int G = grid_fresh(), bx = bid_fresh();
      for (int T0 = bx * TP; T0 < CVT_TOTAL; T0 += G * TP) {
        f32x4_t va[TP], vb[TP]; bf16* dst[TP]; size_t ld[TP]; bool perm[TP];
        const int k = tid >> 3, ns = (tid & 7) * 8;
#pragma unroll
        for (int q = 0; q < TP; ++q) { const int T = T0 + q < CVT_TOTAL ? T0 + q : CVT_TOTAL - 1; const float* src; size_t ls; cvt_job(p, T, src, ls, dst[q], ld[q], perm[q]);
            va[q] = *(const f32x4_t*)(src + (size_t)k * ls + ns); vb[q] = *(const f32x4_t*)(src + (size_t)k * ls + ns + 4); }
#pragma unroll
        for (int q = 0; q < TP; ++q) { LAS float* tile = LDSP(float, q * 64 * 65 * 4);
#pragma unroll
            for (int j = 0; j < 4; ++j) { tile[k * 65 + ns + j] = va[q][j]; tile[k * 65 + ns + 4 + j] = vb[q][j]; } }
        __syncthreads();
#pragma unroll
        for (int q = 0; q < TP; ++q) { if (T0 + q < CVT_TOTAL) { LAS float* tile = LDSP(float, q * 64 * 65 * 4); const int n = tid >> 3, ks = (tid & 7) * 8; u32x4_t w;
            w.x = pk_bf16(tile[(ks + 0) * 65 + n], tile[(ks + 1) * 65 + n]); w.y = pk_bf16(tile[(ks + 2) * 65 + n], tile[(ks + 3) * 65 + n]);
            w.z = pk_bf16(tile[(ks + 4) * 65 + n], tile[(ks + 5) * 65 + n]); w.w = pk_bf16(tile[(ks + 6) * 65 + n], tile[(ks + 7) * 65 + n]);
            const int nrow = perm[q] ? 128 * (n >> 5) + (n & 31) : n;
            *(u32x4_t*)(dst[q] + (size_t)nrow * ld[q] + ks) = w; } }
        __syncthreads();
      } }
    const long gid = (long)bid_fresh() * NTH + tid, gsz = (long)grid_fresh() * NTH;
    for (long i = gid; i < 2L * 32 * D; i += gsz) { const int k = (int)(i % D), j = (int)((i / D) % 32), l = (int)(i / (32 * D));
        WSP(bf16, WS_WGL_T)[i] = j < 24 ? f2bf(p.w_in[(size_t)l * D * NIN + (size_t)k * NIN + ZW + j]) : (bf16)0; }
    { const int lane = tid & 63, gw = (int)(gid >> 6), nw = (int)(gsz >> 6);
      for (int o = gw; o < 2 * 2 * 128; o += nw) { const int j = o % 128, kv = (o / 128) % 2, l = o / 256;
        const float* pe = (kv ? p.cmp_pe_v : p.cmp_pe_k) + (size_t)l * 2048; const float* w1 = (kv ? p.cmp_w1_v : p.cmp_w1_k) + (size_t)l * 2048 * 128 + j; float sacc = 0.f;
#pragma unroll 8
        for (int k = lane; k < 2048; k += 64) sacc += pe[k] * w1[(size_t)k * 128];
        sacc = wave_sum(sacc); if (lane == 0) WSP(float, WS_PEB)[o] = sacc; } }
    if (gid < 6) { const int l = (int)gid / 3, br = (int)gid % 3; float mq = 0.f, mk = 0.f;
        for (int e = 0; e < 64; ++e) { mq = fmaxf(mq, fabsf(p.nsa_q_norm_g[l * 64 + e])); mk = fmaxf(mk, fabsf(p.nsa_k_norm_g[(l * 3 + br) * 64 + e])); }
        WSP(float, WS_BND)[gid] = 8.f * mq * mk * 1.4426950408889634f; }
    for (long i = gid; i < 2L * 4 * 128 * 128; i += gsz) { const int s = (int)(i % 128), t = (int)((i / 128) % 128); WSP(bf16, WS_GWS)[i] = s <= t ? f2bf(p.gmlp_ws[i]) : (bf16)0; }
    for (long i = gid; i < (long)M * 32; i += gsz) { const long m = i / 32; const int j = (int)(i % 32); const float ang = (float)p.pos[m] * invfreq(j);
        const float cv = cosf(ang), sv = sinf(ang); WSP(float, WS_CS)[m * 64 + j] = cv; WSP(float, WS_CS)[m * 64 + 32 + j] = sv; WSP(bf16, WS_CSB)[m * 64 + j] = f2bf(cv); WSP(bf16, WS_CSB)[m * 64 + 32 + j] = f2bf(sv); }
}

__device__ __forceinline__ f32x4_t ld4x(const void* base, size_t idx, bool isbf) {
    if (isbf) { const u32x2_t w = *(const u32x2_t*)((const bf16*)base + idx); return (f32x4_t){__builtin_bit_cast(float, w.x << 16), __builtin_bit_cast(float, w.x & 0xffff0000u), __builtin_bit_cast(float, w.y << 16), __builtin_bit_cast(float, w.y & 0xffff0000u)}; }
    return *(const f32x4_t*)((const float*)base + idx); }
__device__ __forceinline__ void norm_phase(const P& p, LAS unsigned char* lds, const void* xs, bool xbf, int l, int which, int cbank = -1) {
    if (cbank < 0) cbank = l;
    const int tid = tid_fresh(), lane = tid & 63, wave = tid >> 6;
    const float* g = (which ? p.norm_ffn_g : p.norm_mix_g) + l * D;
    bf16* H = WSP(bf16, WS_H);
    LAS float* wr_l = LDSP(float, 0);
    LAS float* lg_l = LDSP(float, 65536);
    LAS int* lcnt = LDSP(int, 65536 + 8192);
    LAS float* red_l = LDSP(float, 65536 + 8192 + 256);
    LAS float* rs_l = LDSP(float, 65536 + 8192 + 256 + 2048);
    for (int rb = bid_fresh(); rb < M / 128; rb += grid_fresh()) {
        const int b = (rb * 128) / NS; const float* mod = WSP(float, WS_MOD) + ((size_t)l * NB + b) * 6144 + which * 3072;
        if (which) {
            __syncthreads();
            if (tid < 48) lcnt[tid] = 0;
            for (int i = tid; i < D * 16; i += NTH) { const int k = i >> 4, e = i & 15; wr_l[(k >> 4) * 256 + ((k >> 2) & 3) * 64 + e * 4 + (k & 3)] = g[k] * (1.f + mod[1024 + k]) * p.router_w[i]; }
            if (tid < 256) { const int e = tid & 15, part = tid >> 4; float s = 0.f; for (int k = part * 64; k < part * 64 + 64; ++k) s += mod[k] * p.router_w[k * 16 + e]; red_l[part * 16 + e] = s; }
            __syncthreads();
            if (tid < 16) { float s = 0.f;
#pragma unroll
                for (int q = 0; q < 16; ++q) s += red_l[q * 16 + tid]; red_l[256 + tid] = s; }
            __syncthreads();
            const int r = lane & 15, kq = lane >> 4; const size_t xr = (size_t)((long)rb * 128 + wave * 16 + r) * D + 4 * kq;
            f32x4_t acc = {0.f, 0.f, 0.f, 0.f}; float ss = 0.f;
#pragma unroll 8
            for (int t = 0; t < 64; ++t) { const f32x4_t xv = ld4x(xs, xr + 16 * t, xbf); const f32x4_t av = *(const LAS f32x4_t*)(wr_l + t * 256 + kq * 64 + r * 4);
                ss += xv[0] * xv[0] + xv[1] * xv[1] + xv[2] * xv[2] + xv[3] * xv[3];
                acc = __builtin_amdgcn_mfma_f32_16x16x4f32(av[0], xv[0], acc, 0, 0, 0); acc = __builtin_amdgcn_mfma_f32_16x16x4f32(av[1], xv[1], acc, 0, 0, 0);
                acc = __builtin_amdgcn_mfma_f32_16x16x4f32(av[2], xv[2], acc, 0, 0, 0); acc = __builtin_amdgcn_mfma_f32_16x16x4f32(av[3], xv[3], acc, 0, 0, 0); }
            ss += __shfl_xor(ss, 16); ss += __shfl_xor(ss, 32);
            const float rs = 1.0f / sqrtf(ss * (1.f / D) + EPS);
            if (kq == 0) rs_l[wave * 16 + r] = rs;
#pragma unroll
            for (int reg = 0; reg < 4; ++reg) lg_l[(wave * 16 + r) * 16 + 4 * kq + reg] = rs * acc[reg] + red_l[256 + 4 * kq + reg];
        }
#pragma unroll 1
        for (int grp = 0; grp < 4; ++grp) {
            const long row0 = (long)rb * 128 + wave * 16 + grp * 4;
            f32x4_t hv[4][4]; float ss[4];
#pragma unroll
            for (int r = 0; r < 4; ++r) { ss[r] = 0.f;
#pragma unroll
                for (int i = 0; i < 4; ++i) { hv[r][i] = ld4x(xs, (size_t)(row0 + r) * D + 256 * i + 4 * lane, xbf); if (!which) ss[r] += hv[r][i][0] * hv[r][i][0] + hv[r][i][1] * hv[r][i][1] + hv[r][i][2] * hv[r][i][2] + hv[r][i][3] * hv[r][i][3]; } }
#pragma unroll
            for (int r = 0; r < 4; ++r) ss[r] = which ? rs_l[wave * 16 + grp * 4 + r] : 1.0f / sqrtf(wave_sum(ss[r]) * (1.f / D) + EPS);
#pragma unroll
            for (int i = 0; i < 4; ++i) { const int k0 = 256 * i + 4 * lane;
                const f32x4_t gv = *(const f32x4_t*)(g + k0), sh = *(const f32x4_t*)(mod + k0), sc = *(const f32x4_t*)(mod + 1024 + k0);
                f32x4_t gm;
#pragma unroll
                for (int j = 0; j < 4; ++j) gm[j] = gv[j] * (1.f + sc[j]);
#pragma unroll
                for (int r = 0; r < 4; ++r) { hv[r][i] = hv[r][i] * ss[r] * gm + sh;
                    u32x2_t w; w.x = pk_bf16(hv[r][i][0], hv[r][i][1]); w.y = pk_bf16(hv[r][i][2], hv[r][i][3]); *(u32x2_t*)(H + (row0 + r) * D + k0) = w; } }
        }
        if (which) {
            int cls = -1, rank = 0; float wa = 0.f, wb = 0.f; const long row = (long)rb * 128 + wave * 16 + lane;
            __builtin_amdgcn_s_waitcnt(0);
            if (lane < 16) {
                const LAS float* q = lg_l + (wave * 16 + lane) * 16;
                float mx = q[0];
#pragma unroll
                for (int e = 1; e < 16; ++e) mx = fmaxf(mx, q[e]);
                float den = 0.f;
#pragma unroll
                for (int e = 0; e < 16; ++e) den += expf(q[e] - mx);
                float bestg = -3e38f; int bg = 0;
#pragma unroll
                for (int gI = 0; gI < 4; ++gI) { float a = -3e38f, b2 = -3e38f;
#pragma unroll
                    for (int j = 0; j < 4; ++j) { const float s = expf(q[gI * 4 + j] - mx) / den + p.router_b[gI * 4 + j]; if (s > a) { b2 = a; a = s; } else if (s > b2) b2 = s; }
                    if (a + b2 > bestg) { bestg = a + b2; bg = gI; } }
                float a = -3e38f, b2 = -3e38f; int ia = 0, ib = 0;
#pragma unroll
                for (int j = 0; j < 4; ++j) { const float s = expf(q[bg * 4 + j] - mx) / den + p.router_b[bg * 4 + j];
                    if (s > a) { b2 = a; ib = ia; a = s; ia = j; } else if (s > b2) { b2 = s; ib = j; } }
                const float p0 = expf(q[bg * 4 + ia] - mx) / den, p1 = expf(q[bg * 4 + ib] - mx) / den;
                const float w0 = p0 / (p0 + p1), w1 = p1 / (p0 + p1);
                const int lo = ia < ib ? ia : ib, hi = ia < ib ? ib : ia;
                wa = ia < ib ? w0 : w1; wb = ia < ib ? w1 : w0;
                const int pairidx = lo == 0 ? hi - 1 : (lo == 1 ? hi + 1 : 5);
                cls = bg * 6 + pairidx;
                rank = atomicAdd((int*)&lcnt[cls], 1);
                Rout r; r.e0 = bg * 4 + ia; r.e1 = bg * 4 + ib; r.w0 = w0; r.w1 = w1; WSP(Rout, WS_ROUT)[row] = r;
            }
            __syncthreads();
            if (tid < 24) { const int c = lcnt[tid]; lcnt[24 + tid] = c ? atomicAdd(WSP(int, WS_CTL) + CW_CNT + cbank * 64 + tid, c) : 0; }
            __syncthreads();
            if (lane < 16) { const int slot = lcnt[24 + cls] + rank; WSP(int, WS_CTOK)[(size_t)cls * M + slot] = (int)row; float* wp = WSP(float, WS_CWT) + ((size_t)cls * M + slot) * 2; wp[0] = wa; wp[1] = wb; }
            __syncthreads();
            if (tid < 24) lcnt[tid] = 0;
            __syncthreads();
        }
    }
}

__device__ __forceinline__ void gl_tail(const P& p, int l) {
    const int tid = tid_fresh(), lane = tid & 63, wave = tid >> 6, fr = lane & 15, fq = lane >> 4;
    const bf16* H = WSP(bf16, WS_H); const bf16* W = WSP(bf16, WS_WGL_T) + (size_t)l * 32 * D; float* GL = WSP(float, WS_GL);
    for (int rt = bid_fresh() * 8 + wave; rt < M / 16; rt += grid_fresh() * 8) {
        pg8::f32x4 acc0 = {0.f, 0.f, 0.f, 0.f}, acc1 = {0.f, 0.f, 0.f, 0.f};
        const bf16* ap = H + (size_t)(rt * 16 + fr) * D + fq * 8; const bf16* bp0 = W + (size_t)fr * D + fq * 8; const bf16* bp1 = W + (size_t)(16 + fr) * D + fq * 8;
#pragma unroll 8
        for (int s = 0; s < 32; ++s) { const s16x8_t a = *(const s16x8_t*)(ap + s * 32), b0 = *(const s16x8_t*)(bp0 + s * 32), b1 = *(const s16x8_t*)(bp1 + s * 32);
            acc0 = __builtin_amdgcn_mfma_f32_16x16x32_bf16(a, b0, acc0, 0, 0, 0); acc1 = __builtin_amdgcn_mfma_f32_16x16x32_bf16(a, b1, acc1, 0, 0, 0); }
#pragma unroll
        for (int r = 0; r < 4; ++r) { const long m = (long)rt * 16 + 4 * fq + r; GL[m * 24 + fr] = acc0[r]; if (fr < 8) GL[m * 24 + 16 + fr] = acc1[r]; }
    }
}

struct EpiZ {
    static constexpr bool PERM = true, AFTER_DRAIN = false;
    const P* pp; int l;
    __device__ __forceinline__ void operator()(const pg8::f32x4 (&acc)[2][2][4][2], const pg8::Unit& u, int wr, int wc, int fr, int fq) const {
        const P& p = *pp; bf16* Z = WSP(bf16, WS_Z); const bf16* CSB = WSP(bf16, WS_CSB);
        const int pn = u.pn;
        int mode = 0; float scale = 1.f; const float* gain = nullptr;
        if (pn == 0) mode = 1; else if (pn == 1) { mode = 1; scale = 0.125f; } else if (pn == 3) mode = 3; else if (pn == 4 || pn == 5) mode = 4;
        else if (pn == 6 || pn == 7) { mode = 2; scale = 0.125f; gain = p.nsa_q_norm_g + l * 64; }
        else if (pn == 9 && wc < 2) { mode = 2; gain = p.nsa_k_norm_g + (l * 3 + 1) * 64; }
        else if (pn == 10 && wc < 2) { mode = 2; gain = p.nsa_k_norm_g + (l * 3 + 2) * 64; }
        float g0[8], g1[8];
        if (mode == 2) {
#pragma unroll
            for (int j = 0; j < 8; ++j) { g0[j] = gain[8 * fq + j] * scale; g1[j] = gain[32 + 8 * fq + j] * scale; } }
        else {
#pragma unroll
            for (int j = 0; j < 8; ++j) { g0[j] = scale; g1[j] = scale; } }
        const int row0 = u.pm * 256 + wr * 64 + fr + (u.half == 2 ? 128 : 0), col0 = pn * 256 + wc * 64 + 8 * fq;
#pragma unroll
        for (int ai = 0; ai < 2; ++ai) { if (ai == 1 && u.half) continue;
#pragma unroll
         for (int mp = 0; mp < 2; ++mp) {
          pg8::u32x4 cwa[2], swa[2];
          if (mode == 1 || mode == 2) {
#pragma unroll
            for (int mm = 0; mm < 2; ++mm) { const long row = row0 + ai * 128 + (2 * mp + mm) * 16; cwa[mm] = *(const pg8::u32x4*)(CSB + row * 64 + 8 * fq); swa[mm] = *(const pg8::u32x4*)(CSB + row * 64 + 32 + 8 * fq); } }
#pragma unroll
            for (int mm = 0; mm < 2; ++mm) { const int m = 2 * mp + mm; const long row = row0 + ai * 128 + m * 16;
                float a[8], b[8];
#pragma unroll
                for (int j = 0; j < 4; ++j) { a[j] = acc[ai][0][m][0][j]; a[4 + j] = acc[ai][0][m][1][j]; b[j] = acc[ai][1][m][0][j]; b[4 + j] = acc[ai][1][m][1][j]; }
                if (mode == 1 || mode == 2) {
                    float r = 1.f;
                    if (mode == 2) { float ss = 0.f;
#pragma unroll
                        for (int j = 0; j < 8; ++j) ss += a[j] * a[j] + b[j] * b[j];
                        ss += __shfl_xor(ss, 16); ss += __shfl_xor(ss, 32); r = __builtin_amdgcn_rsqf(ss * (1.f / 64.f) + EPS); }
                    const pg8::u32x4 cw = cwa[mm], sw = swa[mm];
#pragma unroll
                    for (int j = 0; j < 8; ++j) { const unsigned cu = cw[j >> 1], su = sw[j >> 1];
                        const float cs = __builtin_bit_cast(float, (j & 1) ? (cu & 0xffff0000u) : (cu << 16)), sn = __builtin_bit_cast(float, (j & 1) ? (su & 0xffff0000u) : (su << 16));
                        const float x1 = a[j] * r * g0[j], x2 = b[j] * r * g1[j];
                        a[j] = x1 * cs - x2 * sn; b[j] = x1 * sn + x2 * cs; } }
                else if (mode == 3) {
#pragma unroll
                    for (int j = 0; j < 8; ++j) { a[j] = silu_fast(a[j]); b[j] = silu_fast(b[j]); } }
                else if (mode == 4) {
#pragma unroll
                    for (int j = 0; j < 8; ++j) { a[j] = gelu_fast(a[j]); b[j] = gelu_fast(b[j]); } }
                pg8::u32x4 wa, wb;
                wa.x = pk_bf16(a[0], a[1]); wa.y = pk_bf16(a[2], a[3]); wa.z = pk_bf16(a[4], a[5]); wa.w = pk_bf16(a[6], a[7]);
                wb.x = pk_bf16(b[0], b[1]); wb.y = pk_bf16(b[2], b[3]); wb.z = pk_bf16(b[4], b[5]); wb.w = pk_bf16(b[6], b[7]);
                *(pg8::u32x4*)(Z + row * ZW + col0) = wa; *(pg8::u32x4*)(Z + row * ZW + col0 + 32) = wb; } } }
    }
};
typedef short s16x4_t __attribute__((ext_vector_type(4)));
typedef float f32x4m __attribute__((ext_vector_type(4)));
#define MFMA16(a, b, c) __builtin_amdgcn_mfma_f32_16x16x32_bf16((a), (b), (c), 0, 0, 0)
constexpr int LP = 144;
__device__ __forceinline__ s16x4_t lds_tr4(LAS const unsigned char* p) { return __builtin_bit_cast(s16x4_t, __builtin_amdgcn_ds_read_tr16_b64_v4i16((LAS s16x4_t*)p)); }
__device__ __forceinline__ s16x8_t tr_frag(LAS const unsigned char* X, int P, int k0, int c0, int lane) {
    const int fq = lane >> 4, q = (lane & 15) >> 2, pp = lane & 3;
    LAS const unsigned char* a = X + (k0 + 8 * fq + q) * P + (c0 + 4 * pp) * 2;
    const s16x4_t lo = lds_tr4(a), hi = lds_tr4(a + 4 * P);
    return (s16x8_t){lo[0], lo[1], lo[2], lo[3], hi[0], hi[1], hi[2], hi[3]};
}
__device__ __forceinline__ s16x8_t tr_frag_perm(LAS const unsigned char* X, int P, int k0, int c0, int lane) {
    const int fq = lane >> 4, q = (lane & 15) >> 2, pp = lane & 3;
    LAS const unsigned char* a = X + (k0 + 4 * fq + q) * P + (c0 + 4 * pp) * 2;
    const s16x4_t lo = lds_tr4(a), hi = lds_tr4(a + 16 * P);
    return (s16x8_t){lo[0], lo[1], lo[2], lo[3], hi[0], hi[1], hi[2], hi[3]};
}
__device__ __forceinline__ s16x8_t pack8(const f32x4m& a, const f32x4m& b) {
    const unsigned w0 = pk_bf16(a[0], a[1]), w1 = pk_bf16(a[2], a[3]), w2 = pk_bf16(b[0], b[1]), w3 = pk_bf16(b[2], b[3]);
    return __builtin_bit_cast(s16x8_t, (u32x4_t){w0, w1, w2, w3});
}
__device__ __forceinline__ float bflo(unsigned u) { return __builtin_bit_cast(float, u << 16); }
__device__ __forceinline__ float bfhi(unsigned u) { return __builtin_bit_cast(float, u & 0xffff0000u); }

struct CmpSched {
    static constexpr bool GATHER = false; static constexpr int GOFF_LDS = 0;
    const P* pp; int l, c;
    __device__ __forceinline__ bool next(int i, pg8::Unit& u) const { if (i > 0 || c >= 32) return false; u.pm = c & 7; u.pn = 0; u.aux = c >> 3; u.half = 0; return true; }
    __device__ __forceinline__ int ktiles() const { return 16; }
    __device__ __forceinline__ const char* a_base() const { return (const char*)(pp->ws + WS_Z); }
    __device__ __forceinline__ size_t a_kstep() const { return (size_t)ZW * 2; }
    __device__ __forceinline__ unsigned a_off(const pg8::Unit& u, int row, int C) const {
        const int R = u.pm * 256 + row, kv = u.aux & 1, g = u.aux >> 1;
        return (unsigned)(((size_t)R * 16 * ZW + (kv ? C_VC : C_KC) + g * 64 + C) * 2); }
    __device__ __forceinline__ unsigned b_ld() const { return 1024 * 2u; }
    __device__ __forceinline__ const char* b_tile(const pg8::Unit& u, int t) const { return (const char*)(pp->ws + WS_CW1_T) + (size_t)(l * 2 + (u.aux & 1)) * 256 * 1024 * 2 + (size_t)t * 128; }
};
struct EpiCmp {
    static constexpr bool PERM = false, AFTER_DRAIN = true;
    const P* pp; int l;
    __device__ __forceinline__ void operator()(const pg8::f32x4 (&)[2][2][4][2], const pg8::Unit&, int, int, int, int) const {}
    __device__ __forceinline__ void fused(const pg8::f32x4 (&acc)[2][2][4][2], const pg8::Unit& u, int wr, int wc, int fr, int fq, LAS unsigned char* lds) const {
        const P& p = *pp; const int kv = u.aux & 1, g = u.aux >> 1, lane = tid_fresh() & 63, w = tid_fresh() >> 6;
        constexpr int HP = 272;
        constexpr int HOFF = 257 * HP;
        const float* bias = WSP(float, WS_PEB) + (l * 2 + kv) * 128;
#pragma unroll
        for (int n = 0; n < 2; ++n) { const int c = 32 * wc + 16 * n + 4 * fq;
#pragma unroll
            for (int ai = 0; ai < 2; ++ai)
#pragma unroll
                for (int m = 0; m < 4; ++m) { const int r = 128 * ai + 64 * wr + 16 * m + fr; const f32x4m v = acc[ai][1][m][n];
                    u32x2_t o; o.x = pk_bf16(v[0], v[1]); o.y = pk_bf16(v[2], v[3]); *(LAS u32x2_t*)(lds + r * HP + c * 2) = o; } }
        if (tid_fresh() < 32) { unsigned zz = 0u; asm volatile("" : "+v"(zz)); *(LAS u32x2_t*)(lds + 256 * HP + tid_fresh() * 8) = (u32x2_t){zz, zz}; }
        __syncthreads();
#pragma unroll
        for (int n = 0; n < 2; ++n) { const int c = 32 * wc + 16 * n + 4 * fq; const f32x4m bv = *(const f32x4m*)(bias + c);
#pragma unroll
            for (int ai = 0; ai < 2; ++ai)
#pragma unroll
                for (int m = 0; m < 4; ++m) { const int r = 128 * ai + 64 * wr + 16 * m + fr; const u32x2_t u1 = *(const LAS u32x2_t*)(lds + (r + 1) * HP + c * 2);
                    const f32x4m v = acc[ai][0][m][n] + bv + (f32x4m){bflo(u1.x), bfhi(u1.x), bflo(u1.y), bfhi(u1.y)};
                    u32x2_t o; o.x = pk_bf16(gelu_fast(v[0]), gelu_fast(v[1])); o.y = pk_bf16(gelu_fast(v[2]), gelu_fast(v[3])); *(LAS u32x2_t*)(lds + HOFF + r * HP + c * 2) = o; } }
        __syncthreads();
        const bf16* W2 = WSP(bf16, WS_CW2_T) + (size_t)(l * 2 + kv) * 64 * 128;
        const float* gk = p.nsa_k_norm_g + (l * 3 + 0) * 64;
#pragma unroll
        for (int rt = 0; rt < 2; ++rt) {
            f32x4m o[4];
#pragma unroll
            for (int ct = 0; ct < 4; ++ct) o[ct] = (f32x4m){0.f, 0.f, 0.f, 0.f};
#pragma unroll
            for (int s = 0; s < 4; ++s) { const s16x8_t a = *(const LAS s16x8_t*)(lds + HOFF + (32 * w + 16 * rt + fr) * HP + (32 * s + 8 * fq) * 2);
#pragma unroll
                for (int ct = 0; ct < 4; ++ct) { const s16x8_t b = *(const s16x8_t*)(W2 + (16 * ct + fr) * 128 + 32 * s + 8 * fq); o[ct] = MFMA16(a, b, o[ct]); } }
#pragma unroll
            for (int reg = 0; reg < 4; ++reg) { const int R = u.pm * 256 + 32 * w + 16 * rt + 4 * fq + reg, b = R >> 7, n = R & 127;
                float v0 = o[0][reg], v1 = o[1][reg], v2 = o[2][reg], v3 = o[3][reg];
                if (kv == 0) { float ss = v0 * v0 + v1 * v1 + v2 * v2 + v3 * v3;
                    ss += __shfl_xor(ss, 1); ss += __shfl_xor(ss, 2); ss += __shfl_xor(ss, 4); ss += __shfl_xor(ss, 8);
                    const float r = 1.0f / sqrtf(ss * (1.f / 64.f) + EPS);
                    v0 *= r * gk[fr]; v1 *= r * gk[16 + fr]; v2 *= r * gk[32 + fr]; v3 *= r * gk[48 + fr];
                    const int nn = n < NCMP ? n : NCMP - 1; const float* cs = WSP(float, WS_CS) + ((size_t)b * NS + 16 * nn + 31) * 64;
                    const float c0 = cs[fr], s0 = cs[32 + fr], c1 = cs[16 + fr], s1 = cs[48 + fr];
                    const float a0 = v0 * c0 - v2 * s0, a2 = v0 * s0 + v2 * c0, a1 = v1 * c1 - v3 * s1, a3 = v1 * s1 + v3 * c1; v0 = a0; v1 = a1; v2 = a2; v3 = a3; }
                { if (n >= NCMP) { v0 = 0.f; v1 = 0.f; v2 = 0.f; v3 = 0.f; }
                    bf16* dst = (kv ? WSP(bf16, WS_VC) : WSP(bf16, WS_KC)) + ((size_t)(b * 2 + g) * (NCMP + 1) + n) * 64;
                    dst[fr] = f2bf(v0); dst[16 + fr] = f2bf(v1); dst[32 + fr] = f2bf(v2); dst[48 + fr] = f2bf(v3); } }
        }
        __syncthreads();
    }
};
__device__ __forceinline__ void ret_kv_unit(const P& p, LAS unsigned char* lds, int l, int unit) {
    const int tid = tid_fresh(), lane = tid & 63, w = tid >> 6, fr = lane & 15, fq = lane >> 4;
    const int c = unit % NCH, h = (unit / NCH) % 4, b = unit / (NCH * 4);
    const bf16* Z = WSP(bf16, WS_Z); const size_t m0 = (size_t)b * NS + (size_t)c * 128;
    const float lg2 = log2f(1.f - exp2f(-5.f - (float)h));
    LAS unsigned char* KL = lds; LAS unsigned char* VL = lds + 128 * LP;
#pragma unroll
    for (int i = 0; i < 2; ++i) { const int pc = tid + i * NTH, r = pc >> 3, q = pc & 7;
        const u32x4_t kw = *(const u32x4_t*)(Z + (m0 + r) * ZW + C_RK + 64 * h + q * 8), vw = *(const u32x4_t*)(Z + (m0 + r) * ZW + C_RV + 64 * h + q * 8);
        const float dk = exp2f((float)(127 - r) * lg2); u32x4_t ko;
#pragma unroll
        for (int j = 0; j < 4; ++j) ko[j] = pk_bf16(bflo(kw[j]) * dk, bfhi(kw[j]) * dk);
        *(LAS u32x4_t*)(KL + r * LP + q * 16) = ko; *(LAS u32x4_t*)(VL + r * LP + q * 16) = vw; }
    __syncthreads();
    const int et = w >> 1, d0 = 2 * (w & 1);
    f32x4m a0 = {0.f, 0.f, 0.f, 0.f}, a1 = {0.f, 0.f, 0.f, 0.f};
#pragma unroll
    for (int ks = 0; ks < 4; ++ks) { const s16x8_t va = tr_frag(VL, LP, 32 * ks, 16 * et, lane);
        a0 = MFMA16(va, tr_frag(KL, LP, 32 * ks, 16 * d0, lane), a0); a1 = MFMA16(va, tr_frag(KL, LP, 32 * ks, 16 * (d0 + 1), lane), a1); }
    float* KV = WSP(float, WS_KVS) + (size_t)unit * 4096;
#pragma unroll
    for (int reg = 0; reg < 4; ++reg) { const int e = 16 * et + 4 * fq + reg; KV[e * 64 + 16 * d0 + fr] = a0[reg]; KV[e * 64 + 16 * (d0 + 1) + fr] = a1[reg]; }
    __syncthreads();
}

__device__ __forceinline__ void ret_out_unit(const P& p, LAS unsigned char* lds, int l, int unit) {
    const int tid = tid_fresh(), lane = tid & 63, w = tid >> 6, fr = lane & 15, fq = lane >> 4;
    const int c = unit % NCH, h = (unit / NCH) % 4, b = unit / (NCH * 4);
    const bf16* Z = WSP(bf16, WS_Z); bf16* MIX = WSP(bf16, WS_MIX); const size_t m0 = (size_t)b * NS + (size_t)c * 128;
    const float lg2 = log2f(1.f - exp2f(-5.f - (float)h));
    LAS unsigned char* KL = lds; LAS unsigned char* VL = lds + 128 * LP; LAS unsigned char* ST = lds + 256 * LP;
#pragma unroll
    for (int i = 0; i < 2; ++i) { const int pc = tid + i * NTH, r = pc >> 3, q = pc & 7;
        *(LAS u32x4_t*)(KL + r * LP + q * 16) = *(const u32x4_t*)(Z + (m0 + r) * ZW + C_RK + 64 * h + q * 8);
        *(LAS u32x4_t*)(VL + r * LP + q * 16) = *(const u32x4_t*)(Z + (m0 + r) * ZW + C_RV + 64 * h + q * 8); }
    {
        const float lgc = 128.f * lg2; const float* KV = WSP(float, WS_KVS) + (size_t)(unit - c) * 4096 + tid * 8;
        f32x4m s0 = {0.f, 0.f, 0.f, 0.f}, s1 = {0.f, 0.f, 0.f, 0.f};
        f32x4m ld0[NCH - 1], ld1[NCH - 1];
#pragma unroll
        for (int cc = 0; cc < NCH - 1; ++cc) { ld0[cc] = *(const f32x4m*)(KV + (size_t)cc * 4096); ld1[cc] = *(const f32x4m*)(KV + (size_t)cc * 4096 + 4); }
#pragma unroll
        for (int cc = 0; cc < NCH - 1; ++cc) { const float wgt = cc < c ? __builtin_amdgcn_exp2f((float)(c - 1 - cc) * lgc) : 0.f; s0 += ld0[cc] * wgt; s1 += ld1[cc] * wgt; }
        const int e = tid >> 3, d = (tid & 7) * 8; u32x4_t o; o.x = pk_bf16(s0[0], s0[1]); o.y = pk_bf16(s0[2], s0[3]); o.z = pk_bf16(s1[0], s1[1]); o.w = pk_bf16(s1[2], s1[3]);
        *(LAS u32x4_t*)(ST + e * LP + d * 2) = o; }
    __syncthreads();
    const size_t mq = m0 + 16 * w + fr; const int nq = 16 * w + fr;
    s16x8_t qf[2];
#pragma unroll
    for (int s = 0; s < 2; ++s) qf[s] = *(const s16x8_t*)(Z + mq * ZW + C_RQ + 64 * h + 32 * s + 8 * fq);
    f32x4m O[4];
#pragma unroll
    for (int dt = 0; dt < 4; ++dt) O[dt] = (f32x4m){0.f, 0.f, 0.f, 0.f};
    for (int ks = 0; ks <= (w >> 1); ++ks) {
        f32x4m S2[2];
#pragma unroll
        for (int t = 0; t < 2; ++t) { const int kt = 2 * ks + t; f32x4m sacc = {0.f, 0.f, 0.f, 0.f};
#pragma unroll
            for (int s = 0; s < 2; ++s) sacc = MFMA16(*(const LAS s16x8_t*)(KL + (16 * kt + fr) * LP + (32 * s + 8 * fq) * 2), qf[s], sacc);
#pragma unroll
            for (int reg = 0; reg < 4; ++reg) { const int kk = 16 * kt + 4 * fq + reg; sacc[reg] = kk <= nq ? sacc[reg] * __builtin_amdgcn_exp2f((float)(nq - kk) * lg2) : 0.f; }
            S2[t] = sacc; }
        const s16x8_t pf = pack8(S2[0], S2[1]);
#pragma unroll
        for (int dt = 0; dt < 4; ++dt) O[dt] = MFMA16(tr_frag_perm(VL, LP, 32 * ks, 16 * dt, lane), pf, O[dt]);
    }
    { const float dq = exp2f((float)(nq + 1) * lg2);
#pragma unroll
      for (int dt = 0; dt < 4; ++dt) { f32x4m t = {0.f, 0.f, 0.f, 0.f};
#pragma unroll
          for (int s = 0; s < 2; ++s) t = MFMA16(*(const LAS s16x8_t*)(ST + (16 * dt + fr) * LP + (32 * s + 8 * fq) * 2), qf[s], t);
          O[dt] += t * dq; } }
    float ss = 0.f;
#pragma unroll
    for (int dt = 0; dt < 4; ++dt) ss += O[dt][0] * O[dt][0] + O[dt][1] * O[dt][1] + O[dt][2] * O[dt][2] + O[dt][3] * O[dt][3];
    ss += __shfl_xor(ss, 16); ss += __shfl_xor(ss, 32);
    const float r = 1.0f / sqrtf(ss * (1.f / 64.f) + EPS);
#pragma unroll
    for (int dt = 0; dt < 4; ++dt) { const int e = 16 * dt + 4 * fq; const f32x4m gn = *(const f32x4m*)(p.ret_norm_g + (l * 4 + h) * 64 + e);
        const u32x2_t rg = *(const u32x2_t*)(Z + mq * ZW + C_RG + 64 * h + e);
        u32x2_t o; o.x = pk_bf16(O[dt][0] * r * gn[0] * bflo(rg.x), O[dt][1] * r * gn[1] * bfhi(rg.x)); o.y = pk_bf16(O[dt][2] * r * gn[2] * bflo(rg.y), O[dt][3] * r * gn[3] * bfhi(rg.y));
        *(u32x2_t*)(MIX + mq * D + 64 * h + e) = o; }
    __syncthreads();
}
__device__ __forceinline__ void gmlp_unit(const P& p, LAS unsigned char* lds, int l, int unit) {
    const int tid = tid_fresh(), lane = tid & 63, w = tid >> 6, fr = lane & 15, fq = lane >> 4;
    const bf16* Z = WSP(bf16, WS_Z); bf16* MIX = WSP(bf16, WS_MIX); const size_t m0 = (size_t)unit * 128;
    constexpr int VP = 528;
    { const int r = tid >> 2, q = tid & 3; const bf16* src = Z + (m0 + r) * ZW + C_GV + q * 64;
      u32x4_t v[8]; float s = 0.f;
#pragma unroll
      for (int i = 0; i < 8; ++i) { v[i] = *(const u32x4_t*)(src + i * 8);
#pragma unroll
          for (int j = 0; j < 4; ++j) s += bflo(v[i][j]) + bfhi(v[i][j]); }
      s += __shfl_xor(s, 1); s += __shfl_xor(s, 2); const float mu = s * (1.f / 256.f); float s2 = 0.f;
#pragma unroll
      for (int i = 0; i < 8; ++i)
#pragma unroll
          for (int j = 0; j < 4; ++j) { const float a = bflo(v[i][j]) - mu, b2 = bfhi(v[i][j]) - mu; s2 += a * a + b2 * b2; }
      s2 += __shfl_xor(s2, 1); s2 += __shfl_xor(s2, 2); const float rstd = 1.0f / sqrtf(s2 * (1.f / 256.f) + EPS);
      const float* gl = p.gmlp_ln_g + l * 256 + q * 64;
#pragma unroll
      for (int i = 0; i < 8; ++i) { u32x4_t o;
#pragma unroll
          for (int j = 0; j < 4; ++j) o[j] = pk_bf16((bflo(v[i][j]) - mu) * rstd * gl[i * 8 + 2 * j], (bfhi(v[i][j]) - mu) * rstd * gl[i * 8 + 2 * j + 1]);
          *(LAS u32x4_t*)(lds + r * VP + (q * 64 + i * 8) * 2) = o; } }
    __syncthreads();
    const int t0 = 16 * w;
#pragma unroll 1
    for (int g = 0; g < 4; ++g) {
        const bf16* W = WSP(bf16, WS_GWS) + (size_t)(l * 4 + g) * 128 * 128;
        f32x4m acc[4];
#pragma unroll
        for (int ct = 0; ct < 4; ++ct) acc[ct] = (f32x4m){0.f, 0.f, 0.f, 0.f};
        for (int ks = 0; ks <= (w >> 1); ++ks) { const s16x8_t a = *(const s16x8_t*)(W + (t0 + fr) * 128 + 32 * ks + 8 * fq);
#pragma unroll
            for (int ct = 0; ct < 4; ++ct) acc[ct] = MFMA16(a, tr_frag(lds, VP, 32 * ks, 64 * g + 16 * ct, lane), acc[ct]); }
#pragma unroll
        for (int reg = 0; reg < 4; ++reg) { const int t = t0 + 4 * fq + reg; const float bs = p.gmlp_b[(l * 4 + g) * 128 + t];
#pragma unroll
            for (int ct = 0; ct < 4; ++ct) { const int col = 64 * g + 16 * ct + fr; MIX[(m0 + t) * D + 256 + col] = f2bf(bf2f(Z[(m0 + t) * ZW + C_GU + col]) * (acc[ct][reg] + bs)); } }
    }
    __syncthreads();
}
__device__ __forceinline__ void premix_phase(const P& p, LAS unsigned char* lds, int l) {
    { CmpSched S; S.pp = &p; S.l = l; S.c = bid_fresh(); EpiCmp E{&p, l}; pg8::gemm_phase(lds, S, E); }
    const int G = grid_fresh(), bx = bid_fresh();
    if (G > 64) { if (bx >= 32) { for (int u = bx - 32; u < NB * 4 * NCH; u += G - 32) ret_kv_unit(p, lds, l, u); for (int u = bx - 32; u < NB * NCH; u += G - 32) gmlp_unit(p, lds, l, u); } }
    else { for (int u = bx; u < NB * 4 * NCH; u += G) ret_kv_unit(p, lds, l, u); for (int u = bx; u < NB * NCH; u += G) gmlp_unit(p, lds, l, u); }
}

__device__ __forceinline__ s16x8_t tr_frag_perm_swz(LAS const unsigned char* X, int k0, int c0, int lane) {
    const int fq = lane >> 4, q = (lane & 15) >> 2, pp = lane & 3, row = k0 + 4 * fq + q, col = c0 + 4 * pp;
    LAS const unsigned char* a = X + row * 128 + ((((col >> 3) ^ (row & 7))) << 4) + (col & 7) * 2;
    const s16x4_t lo = lds_tr4(a), hi = lds_tr4(a + 16 * 128);
    return (s16x8_t){lo[0], lo[1], lo[2], lo[3], hi[0], hi[1], hi[2], hi[3]};
}
constexpr int NSA_KV = 2 * 64 * 128;
constexpr int NSA_IMP = 3 * NSA_KV, NSA_INVL = NSA_IMP + 8 * 8192, NSA_SELM = NSA_INVL + 64 * 4 * 4;
static_assert(NSA_SELM + 256 <= 147456 - 64, "NSA LDS map");
__device__ __forceinline__ void nsa_unit(const P& p, LAS unsigned char* lds, int l, int b, int g, int i) {
    const int tid = tid_fresh(), lane = tid & 63, w = tid >> 6, fr = lane & 15, fq = lane >> 4;
    const bf16* Z = WSP(bf16, WS_Z); bf16* MIX = WSP(bf16, WS_MIX); const float* GL = WSP(float, WS_GL);
    const size_t mb = (size_t)b * NS;
    const int nc = (i >= 16) ? 2 : 1, wlo = i > 8 ? i - 8 : 0, nblk = nc + (i + 1) + (i - wlo + 1);
    LAS float* IMPH = (LAS float*)(lds + NSA_IMP + w * 8192); LAS float* INVL = (LAS float*)(lds + NSA_INVL); LAS unsigned* SELM = (LAS unsigned*)(lds + NSA_SELM);
    LAS f32x4m* OFL = (LAS f32x4m*)(lds + NSA_IMP + w * 8192 + lane * 16);
    int tok[2]; s16x8_t qf[2][2];
#pragma unroll
    for (int qt = 0; qt < 2; ++qt) { tok[qt] = 8 * w + 4 * qt + (fr >> 2);
#pragma unroll
        for (int s = 0; s < 2; ++s) qf[qt][s] = *(const s16x8_t*)(Z + (mb + 64 * i + tok[qt]) * ZW + C_NQ + 64 * (4 * g + (fr & 3)) + 32 * s + 8 * fq); }
    f32x4m O[2][4]; float lsum[2] = {0.f, 0.f}; float carry[2] = {0.f, 0.f}; unsigned selm[2] = {0u, 0u};
#pragma unroll
    for (int qt = 0; qt < 2; ++qt)
#pragma unroll
        for (int dt = 0; dt < 4; ++dt) O[qt][dt] = (f32x4m){0.f, 0.f, 0.f, 0.f};
    const int skey = tid >> 3, spx = (tid & 7) ^ (skey & 7);
    auto kv_ptrs = [&](int it, const bf16*& kp, const bf16*& vp) {
        if (it < nc) { const size_t o = ((size_t)(b * 2 + g) * (NCMP + 1) + 64 * it + skey) * 64 + spx * 8; kp = WSP(bf16, WS_KC) + o; vp = WSP(bf16, WS_VC) + o; }
        else if (it < nc + i + 1) { const size_t o = (mb + 64 * (it - nc) + skey) * ZW + 64 * g + spx * 8; kp = Z + o + C_KS; vp = Z + o + C_VS; }
        else { const size_t o = (mb + 64 * (wlo + it - nc - i - 1) + skey) * ZW + 64 * g + spx * 8; kp = Z + o + C_KW; vp = Z + o + C_VW; } };
    asm volatile("" : "+v"(qf[0][0]), "+v"(qf[0][1]), "+v"(qf[1][0]), "+v"(qf[1][1]));
    float bnd_c = WSP(float, WS_BND)[l * 3 + 0], bnd_s = WSP(float, WS_BND)[l * 3 + 1], bnd_w = WSP(float, WS_BND)[l * 3 + 2];
    asm volatile("" : "+v"(bnd_c), "+v"(bnd_s), "+v"(bnd_w));
#define NSA_DMA(IT, BUF) do { const bf16 *kp_, *vp_; kv_ptrs((IT), kp_, vp_); \
        const unsigned lb_ = (unsigned)__builtin_amdgcn_readfirstlane((int)((unsigned)(size_t)lds + (unsigned)((BUF) * NSA_KV) + (unsigned)w * 1024u)); unsigned sv_; \
        asm volatile("s_mov_b32 %0, m0\n\ts_mov_b32 m0, %3\n\ts_nop 0\n\tglobal_load_lds_dwordx4 %1, off\n\ts_add_u32 m0, m0, 0x2000\n\ts_nop 0\n\tglobal_load_lds_dwordx4 %2, off\n\ts_mov_b32 m0, %0" \
                     : "=&s"(sv_) : "v"(kp_), "v"(vp_), "s"(lb_) : "memory"); } while (0)
    __syncthreads();
    NSA_DMA(0, 0);
    if (nblk > 1) { NSA_DMA(1, 1); asm volatile("s_waitcnt vmcnt(2)" ::: "memory"); } else asm volatile("s_waitcnt vmcnt(0)" ::: "memory");
    __builtin_amdgcn_s_barrier(); asm volatile("" ::: "memory");
    int bufc = 0;
#pragma unroll 1
    for (int it = 0; it < nblk; ++it) {
        const bool dma_now = it + 2 < nblk;
        if (dma_now) { const int bn = bufc == 0 ? 2 : bufc - 1; NSA_DMA(it + 2, bn); }
        LAS const unsigned char* Kb = lds + bufc * NSA_KV; LAS const unsigned char* Vb = Kb + 8192;
        const int br = it < nc ? 0 : (it < nc + i + 1 ? 1 : 2);
        const int j = br == 0 ? it : (br == 1 ? it - nc : wlo + it - nc - i - 1);
        const float bnd = br == 0 ? bnd_c : (br == 1 ? bnd_s : bnd_w);
        const bool needmask = (br == 0) || (j == i) || (br == 2 && j == i - 8);
        const bool lower = (br == 2 && j == i - 8);
        bool rowok[2]; int thr[2]; float oa[2], ob[2];
#pragma unroll
        for (int qt = 0; qt < 2; ++qt) {
            rowok[qt] = (br == 1) ? (((selm[qt] >> j) & 1u) != 0u) : true;
            thr[qt] = (br == 0) ? ((64 * i + tok[qt] - 31) >> 4) - 64 * j : tok[qt];
            const float on = rowok[qt] ? bnd : 1e30f;
            oa[qt] = lower ? 1e30f : on; ob[qt] = lower ? on : 1e30f; }
        const bool act0 = __ballot(rowok[0]) != 0ull, act1 = __ballot(rowok[1]) != 0ull;
        if (act0 || act1) {
            f32x4m pv[2][4];
#pragma unroll
            for (int qt = 0; qt < 2; ++qt)
#pragma unroll
                for (int kt = 0; kt < 4; ++kt) pv[qt][kt] = (f32x4m){0.f, 0.f, 0.f, 0.f};
#pragma unroll
            for (int sI = 0; sI < 2; ++sI) { s16x8_t kf[4];
#pragma unroll
                for (int kt = 0; kt < 4; ++kt) kf[kt] = *(const LAS s16x8_t*)(Kb + (16 * kt + fr) * 128 + (((4 * sI + fq) ^ (fr & 7)) << 4));
#pragma unroll
                for (int kt = 0; kt < 4; ++kt)
#pragma unroll
                    for (int qt = 0; qt < 2; ++qt) pv[qt][kt] = MFMA16(kf[kt], qf[qt][sI], pv[qt][kt]); }
            s16x8_t vf[2][4];
#pragma unroll
            for (int ks = 0; ks < 2; ++ks)
#pragma unroll
                for (int dt = 0; dt < 4; ++dt) vf[ks][dt] = tr_frag_perm_swz(Vb, 32 * ks, 16 * dt, lane);
#pragma unroll
            for (int qt = 0; qt < 2; ++qt) {
                if (needmask) {
#pragma unroll
                    for (int kt = 0; kt < 4; ++kt)
#pragma unroll
                        for (int reg = 0; reg < 4; ++reg) { const int kk = 16 * kt + 4 * fq + reg; const float off = kk <= thr[qt] ? oa[qt] : ob[qt];
                            pv[qt][kt][reg] = __builtin_amdgcn_exp2f(pv[qt][kt][reg] * 1.4426950408889634f - off); lsum[qt] += pv[qt][kt][reg]; } }
                else {
#pragma unroll
                    for (int kt = 0; kt < 4; ++kt)
#pragma unroll
                        for (int reg = 0; reg < 4; ++reg) { pv[qt][kt][reg] = __builtin_amdgcn_exp2f(pv[qt][kt][reg] * 1.4426950408889634f - oa[qt]); lsum[qt] += pv[qt][kt][reg]; } }
                if (br == 0) {
                    const int src = (lane + 48) & 63;
#pragma unroll
                    for (int kt = 0; kt < 4; ++kt) { const float a4 = pv[qt][kt][0] + pv[qt][kt][1] + pv[qt][kt][2] + pv[qt][kt][3];
                        const float xs = __shfl(pv[qt][kt][3], src), xp = __shfl(kt == 0 ? carry[qt] : pv[qt][kt > 0 ? kt - 1 : 0][3], src);
                        IMPH[((4 * qt + (fr >> 2)) * 4 + (fr & 3)) * 32 + 16 * j + 4 * kt + fq] = a4 + (fq == 0 ? xp : xs); }
                    carry[qt] = pv[qt][3][3]; }
                const s16x8_t pfa = pack8(pv[qt][0], pv[qt][1]), pfb = pack8(pv[qt][2], pv[qt][3]);
#pragma unroll
                for (int dt = 0; dt < 4; ++dt) O[qt][dt] = MFMA16(vf[0][dt], pfa, O[qt][dt]);
#pragma unroll
                for (int dt = 0; dt < 4; ++dt) O[qt][dt] = MFMA16(vf[1][dt], pfb, O[qt][dt]);
                __builtin_amdgcn_sched_barrier(0);
            }
        }
        const bool bend = (it == nc - 1) || (it == nc + i) || (it == nblk - 1);
        if (bend) {
            float scl[2];
#pragma unroll
            for (int qt = 0; qt < 2; ++qt) { float ls = lsum[qt]; ls += __shfl_xor(ls, 16); ls += __shfl_xor(ls, 32);
                const float inv = ls > 0.f ? 1.0f / ls : 0.f;
                const float gate = 1.0f / (1.0f + __expf(-GL[(mb + 64 * i + tok[qt]) * 24 + (4 * g + (fr & 3)) * 3 + br]));
                scl[qt] = gate * inv; lsum[qt] = 0.f;
                if (br == 0 && fq == 0) INVL[tok[qt] * 4 + (fr & 3)] = inv; }
            if (br == 0) {
#pragma unroll 1
                for (int rnd = 0; rnd < 4; ++rnd) { const int tk = 8 * w + 2 * rnd + (lane >> 5), jj = lane & 31;
                    const bool forced = (jj == 0) || (jj == i) || (jj == i - 1);
                    float sc = -1.f;
                    if (jj <= i) { sc = 0.f;
#pragma unroll
                        for (int r = 0; r < 4; ++r) sc += IMPH[((2 * rnd + (lane >> 5)) * 4 + r) * 32 + jj] * INVL[tk * 4 + r]; }
                    if (forced) sc = 1e4f;
                    int rank = 0;
#pragma unroll
                    for (int d = 1; d < 32; ++d) { const int oj = (jj + d) & 31; const float o = __shfl(sc, (lane & 32) | oj); rank += (o > sc || (o == sc && oj < jj)) ? 1 : 0; }
                    const unsigned long long bal = __ballot(rank < 8);
                    if (lane == 0) { SELM[8 * w + 2 * rnd] = (unsigned)bal; SELM[8 * w + 2 * rnd + 1] = (unsigned)(bal >> 32); } }
                selm[0] = SELM[tok[0]]; selm[1] = SELM[tok[1]];
            }
#pragma unroll
            for (int qt = 0; qt < 2; ++qt)
#pragma unroll
                for (int dt = 0; dt < 4; ++dt) { const f32x4m prev = br == 0 ? (f32x4m){0.f, 0.f, 0.f, 0.f} : OFL[(qt * 4 + dt) * 64]; OFL[(qt * 4 + dt) * 64] = prev + O[qt][dt] * scl[qt]; O[qt][dt] = (f32x4m){0.f, 0.f, 0.f, 0.f}; }
        }
        if (dma_now) asm volatile("s_waitcnt vmcnt(2)" ::: "memory"); else asm volatile("s_waitcnt vmcnt(0)" ::: "memory");
        asm volatile("s_waitcnt lgkmcnt(0)" ::: "memory");
        __builtin_amdgcn_s_barrier(); asm volatile("" ::: "memory");
        bufc = bufc == 2 ? 0 : bufc + 1;
    }
#undef NSA_DMA
#pragma unroll
    for (int qt = 0; qt < 2; ++qt)
#pragma unroll
        for (int dt = 0; dt < 4; ++dt) { const f32x4m of = OFL[(qt * 4 + dt) * 64]; u32x2_t o; o.x = pk_bf16(of[0], of[1]); o.y = pk_bf16(of[2], of[3]);
            *(u32x2_t*)(MIX + (mb + 64 * i + tok[qt]) * D + 512 + 64 * (4 * g + (fr & 3)) + 16 * dt + 4 * fq) = o; }
}
__device__ __forceinline__ void nsa_units(const P& p, LAS unsigned char* lds, int l, int vcu, int G) {
    for (int u = vcu; u < NB * 2 * NSEL; u += G) { const int k = u >> 8, v = u & 255, bg = v >> 3, r8 = v & 7;
        const int i = k == 0 ? 31 - r8 : (k == 1 ? 16 + r8 : (k == 2 ? 15 - r8 : r8));
        nsa_unit(p, lds, l, bg >> 1, bg & 1, i); }
}
constexpr int MOE_TAB = 131072;
constexpr size_t WS_ACT = WS_Z;
static_assert((size_t)(M + 24 * 256) * 1024 * 2 <= (size_t)M * ZW * 2, "ACT must fit inside Z");
__device__ __forceinline__ void moe_table(const P& p, LAS unsigned char* lds, int l) {
    LAS int* tab = LDSP(int, MOE_TAB);
    if (tid_fresh() == 0) { int acc = 0; for (int c = 0; c < 24; ++c) { const int n = WSP(int, WS_CTL)[CW_CNT + l * 64 + c]; tab[c] = acc; tab[25 + c] = n; acc += (n + 255) >> 8; } tab[24] = acc; }
    __syncthreads();
}
__device__ __forceinline__ void pair_experts(int cls, int& ea, int& eb) { const int g = cls / 6, pr = cls % 6; const int lo = pr < 3 ? 0 : (pr < 5 ? 1 : 2), hi = pr < 3 ? pr + 1 : (pr < 5 ? pr - 1 : 3); ea = g * 4 + lo; eb = g * 4 + hi; }
template <int NPN> struct MoeSchedBase {
    const P* pp; LAS int* tab; int l, G, c;
    __device__ __forceinline__ bool next(int i, pg8::Unit& u) const {
        int L, hf; if (!pg8::deal_unit(i, G, c, tab[24] * NPN, L, hf)) return false; u.half = hf;
        const int rt = L / NPN; int cls = 0;
        for (int k = 1; k < 24; ++k) cls = (tab[k] <= rt) ? k : cls;
        while (tab[25 + cls] == 0 && cls > 0) --cls;
        u.pm = rt; u.pn = L % NPN; u.aux = cls | ((rt - tab[cls]) << 8); return true;
    }
};
struct MoeSchedA : MoeSchedBase<8> {
    static constexpr bool GATHER = true; static constexpr int GOFF_LDS = MOE_TAB + 1024;
    __device__ __forceinline__ int ktiles() const { return D / 64; }
    __device__ __forceinline__ size_t a_kstep() const { return 128; }
    __device__ __forceinline__ const char* a_base() const { return (const char*)(pp->ws + WS_H); }
    __device__ __forceinline__ unsigned a_off(const pg8::Unit& u, int row, int C) const {
        const P& p = *pp; const int cls = u.aux & 255, slot = (u.aux >> 8) * 256 + row, n = tab[25 + cls];
        const int tok = WSP(int, WS_CTOK)[(size_t)cls * M + (slot < n ? slot : 0)];
        return (unsigned)(tok * D + C) * 2u; }
    __device__ __forceinline__ unsigned b_ld() const { return D * 2u; }
    __device__ __forceinline__ const char* b_tile(const pg8::Unit& u, int t) const {
        int ea, eb; pair_experts(u.aux & 255, ea, eb); const int e = u.pn < 4 ? ea : eb;
        return (const char*)(pp->ws + WS_WGU_T) + ((size_t)(l * 16 + e) * 1024 + (size_t)(u.pn & 3) * 256) * D * 2 + (size_t)t * 128; }
};
struct MoeSchedB : MoeSchedBase<4> {
    static constexpr bool GATHER = false; static constexpr int GOFF_LDS = 0;
    __device__ __forceinline__ int ktiles() const { return 16; }
    __device__ __forceinline__ size_t a_kstep() const { return 128; }
    __device__ __forceinline__ const char* a_base() const { return (const char*)(pp->ws + WS_ACT); }
    __device__ __forceinline__ unsigned a_off(const pg8::Unit& u, int row, int C) const { return (unsigned)((u.pm * 256 + row) * 1024 + C) * 2u; }
    __device__ __forceinline__ unsigned b_ld() const { return 512 * 2u; }
    __device__ __forceinline__ const char* b_tile(const pg8::Unit& u, int t) const {
        int ea, eb; pair_experts(u.aux & 255, ea, eb); const int e = t < 8 ? ea : eb;
        return (const char*)(pp->ws + WS_WD_T) + ((size_t)(l * 16 + e) * D + (size_t)u.pn * 256) * 512 * 2 + (size_t)(t & 7) * 128; }
};
struct EpiMoeA {
    static constexpr bool PERM = true, AFTER_DRAIN = false;
    const P* pp; LAS int* tab;
    __device__ __forceinline__ void operator()(const pg8::f32x4 (&acc)[2][2][4][2], const pg8::Unit& u, int wr, int wc, int fr, int fq) const {
        const P& p = *pp; const int cls = u.aux & 255, s0 = (u.aux >> 8) * 256, n = tab[25 + cls], which = u.pn >> 2;
        bf16* O = WSP(bf16, WS_ACT);
        float wts[2][4];
#pragma unroll
        for (int ai = 0; ai < 2; ++ai)
#pragma unroll
            for (int m = 0; m < 4; ++m) { const int slot = s0 + (u.half ? 0 : ai * 128) + wr * 64 + m * 16 + fr + (u.half == 2 ? 128 : 0); wts[ai][m] = slot < n ? WSP(float, WS_CWT)[((size_t)cls * M + slot) * 2 + which] : 0.f; }
#pragma unroll
        for (int ai = 0; ai < 2; ++ai)
#pragma unroll
            for (int m = 0; m < 4; ++m) { if (ai == 1 && u.half) continue; const int r = ai * 128 + wr * 64 + m * 16 + fr + (u.half == 2 ? 128 : 0);
                const float w = wts[ai][m];
                const pg8::f32x4 g0 = acc[ai][0][m][0], g1 = acc[ai][0][m][1], u0 = acc[ai][1][m][0], u1 = acc[ai][1][m][1];
                float v[8];
#pragma unroll
                for (int j = 0; j < 4; ++j) { v[j] = w * silu_fast(g0[j]) * u0[j]; v[4 + j] = w * silu_fast(g1[j]) * u1[j]; }
                pg8::u32x4 o; o.x = pk_bf16(v[0], v[1]); o.y = pk_bf16(v[2], v[3]); o.z = pk_bf16(v[4], v[5]); o.w = pk_bf16(v[6], v[7]);
                *(pg8::u32x4*)(O + (size_t)(u.pm * 256 + r) * 1024 + u.pn * 128 + wc * 32 + 8 * fq) = o; }
    }
};
struct EpiMoeB {
    static constexpr bool PERM = true, AFTER_DRAIN = false;
    const P* pp; LAS int* tab; int l; bool dry; const bf16* xin; void* xout; bool obf;
    __device__ __forceinline__ void operator()(const pg8::f32x4 (&acc)[2][2][4][2], const pg8::Unit& u, int wr, int wc, int fr, int fq) const {
        const P& p = *pp; const int cls = u.aux & 255, s0 = (u.aux >> 8) * 256, n = dry ? 0 : tab[25 + cls], col0 = u.pn * 256 + wc * 32 + 8 * fq;
        int toks[2][4];
#pragma unroll
        for (int ai = 0; ai < 2; ++ai)
#pragma unroll
            for (int m = 0; m < 4; ++m) { const int slot = s0 + (u.half ? 0 : ai * 128) + wr * 64 + m * 16 + fr + (u.half == 2 ? 128 : 0); toks[ai][m] = slot < n ? WSP(int, WS_CTOK)[(size_t)cls * M + slot] : -1; }
#pragma unroll
        for (int ai = 0; ai < 2; ++ai) { if (ai == 1 && u.half) continue;
#pragma unroll
            for (int mp = 0; mp < 2; ++mp) {
                pg8::u32x4 xw[2][2]; pg8::f32x4 ga[2][2], gb[2][2];
#pragma unroll
                for (int mm = 0; mm < 2; ++mm) { const int tok = toks[ai][2 * mp + mm], tk = tok < 0 ? 0 : tok;
                    const float* gp = WSP(float, WS_MOD) + ((size_t)l * NB + tk / NS) * 6144 + 5120 + col0; const size_t ro = (size_t)tk * D + col0;
#pragma unroll
                    for (int bj = 0; bj < 2; ++bj) { xw[mm][bj] = *(const pg8::u32x4*)(xin + ro + bj * 128); ga[mm][bj] = *(const pg8::f32x4*)(gp + bj * 128); gb[mm][bj] = *(const pg8::f32x4*)(gp + bj * 128 + 4); } }
#pragma unroll
                for (int mm = 0; mm < 2; ++mm) { const int m = 2 * mp + mm, tok = toks[ai][m]; if (tok < 0) continue; const size_t ro = (size_t)tok * D + col0;
#pragma unroll
                    for (int bj = 0; bj < 2; ++bj) { const pg8::u32x4 w = xw[mm][bj];
                        pg8::f32x4 x0 = {__builtin_bit_cast(float, w.x << 16), __builtin_bit_cast(float, w.x & 0xffff0000u), __builtin_bit_cast(float, w.y << 16), __builtin_bit_cast(float, w.y & 0xffff0000u)};
                        pg8::f32x4 x1 = {__builtin_bit_cast(float, w.z << 16), __builtin_bit_cast(float, w.z & 0xffff0000u), __builtin_bit_cast(float, w.w << 16), __builtin_bit_cast(float, w.w & 0xffff0000u)};
                        x0 += ga[mm][bj] * acc[ai][bj][m][0]; x1 += gb[mm][bj] * acc[ai][bj][m][1];
                        if (obf) { pg8::u32x4 o; o.x = pk_bf16(x0[0], x0[1]); o.y = pk_bf16(x0[2], x0[3]); o.z = pk_bf16(x1[0], x1[1]); o.w = pk_bf16(x1[2], x1[3]); *(pg8::u32x4*)((bf16*)xout + ro + bj * 128) = o; }
                        else { *(pg8::f32x4*)((float*)xout + ro + bj * 128) = x0; *(pg8::f32x4*)((float*)xout + ro + bj * 128 + 4) = x1; } } } } }
    }
};
__device__ __forceinline__ void moe_a_phase(const P& p, LAS unsigned char* lds, int l) {
    moe_table(p, lds, l);
    MoeSchedA S; S.pp = &p; S.tab = LDSP(int, MOE_TAB); S.l = l; S.G = grid_fresh(); S.c = bid_fresh();
    EpiMoeA E{&p, LDSP(int, MOE_TAB)}; pg8::gemm_phase(lds, S, E);
}
__device__ __forceinline__ void moe_b_phase(const P& p, LAS unsigned char* lds, int l, bool dry = false, void* xout = nullptr, int obf = -1) {
    if (!xout) xout = p.out;
    if (obf < 0) obf = (l + 1 < NL);
    moe_table(p, lds, l);
    MoeSchedB S; S.pp = &p; S.tab = LDSP(int, MOE_TAB); S.l = l; S.G = grid_fresh(); S.c = bid_fresh();
    EpiMoeB E{&p, LDSP(int, MOE_TAB), l, dry, WSP(bf16, WS_XB), xout, obf != 0}; pg8::gemm_phase(lds, S, E);
}
constexpr int LDS_BYTES = 147456;
struct Args { P p; };
typedef const __attribute__((address_space(4))) P* KargP;
__device__ __forceinline__ KargP p_fresh() { KargP k = (KargP)__builtin_amdgcn_kernarg_segment_ptr(); asm volatile("" : "+s"(k)); return k; }
__device__ __forceinline__ P load_p() { KargP k = p_fresh(); P q; const void* const __attribute__((address_space(4)))* src = (const void* const __attribute__((address_space(4)))*)k; const void** dst = (const void**)&q;
#pragma unroll
    for (int i = 0; i < (int)(sizeof(P) / sizeof(void*)); ++i) dst[i] = src[i];
    return q; }
#define LAYER_BODY(l) do { \
        { const P p = load_p(); norm_phase(p, lds, l ? (const void*)p.out : (const void*)p.x, l != 0, l, 0); } \
        GRID_BAR(); \
        { const P p = load_p(); pg8::StaticSched S; S.init(WSP(bf16, WS_H), WSP(bf16, WS_WIN_T) + (size_t)l * ZW * D, M, ZW, D, grid_fresh(), bid_fresh()); EpiZ E{&p, l}; pg8::gemm_phase(lds, S, E); gl_tail(p, l); } \
        GRID_BAR(); \
        { const P p = load_p(); premix_phase(p, lds, l); } \
        GRID_BAR(); \
        { const P p = load_p(); nsa_units(p, lds, l, bid_fresh(), grid_fresh()); } \
        { const P p = load_p(); for (int u = bid_fresh(); u < NB * 4 * NCH; u += grid_fresh()) ret_out_unit(p, lds, l, u); } \
        GRID_BAR(); \
        { const P p = load_p(); pg8::StaticSched S; S.init(WSP(bf16, WS_MIX), WSP(bf16, WS_WOUT_T) + (size_t)l * D * D, M, D, D, grid_fresh(), bid_fresh()); \
          pg8::EpiResidual E{l ? (const void*)p.out : (const void*)p.x, l != 0, WSP(bf16, WS_XB), WSP(float, WS_MOD) + (size_t)l * NB * 6144 + 2048}; pg8::gemm_phase(lds, S, E); } \
        GRID_BAR(); \
        { const P p = load_p(); norm_phase(p, lds, WSP(bf16, WS_XB), true, l, 1); } \
        GRID_BAR(); \
        { const P p = load_p(); moe_a_phase(p, lds, l); } \
        GRID_BAR(); \
        { const P p = load_p(); moe_b_phase(p, lds, l); } \
} while (0)
__global__ void __launch_bounds__(NTH, 2) fwd_kernel(Args a) {
    extern __shared__ __attribute__((aligned(16))) unsigned char lds_raw[];
    LAS unsigned char* lds = (LAS unsigned char*)lds_raw;
    volatile LAS unsigned* MISC = (volatile LAS unsigned*)(lds + LDS_BYTES - 64);
    if (threadIdx.x < 16) MISC[threadIdx.x] = 0u;
    __syncthreads();
    (void)xcd_barrier_post((unsigned*)(a.p.ws + WS_CTL) + CW_BAR, MISC);
#define GRID_BAR() do { XcdBarrier bar_; bar_.bar = (unsigned*)(load_p().ws + WS_CTL) + CW_BAR; bar_.x = xb_xcc_id(); bar_.st = (volatile LAS unsigned*)(lds + LDS_BYTES - 64); xcd_barrier(bar_); } while (0)
    { const P p = load_p(); p0_prologue(p, lds); }
    GRID_BAR();
    LAYER_BODY(0);
    GRID_BAR();
    LAYER_BODY(1);
}
extern "C" void kernel_launch(void* const* d_in, const int* in_sizes, int n_in, void* d_out, int out_size, void* d_ws, size_t ws_size, hipStream_t stream) {
    static int grid = 0;
    if (grid == 0) {
        int dev = 0, cus = 0, per_cu = 0;
        if (n_in != 26 || out_size != M * D || ws_size < WS_END) { fprintf(stderr, "kernel_launch: unexpected shapes (n_in %d out %d ws %zu need %zu)\n", n_in, out_size, ws_size, (size_t)WS_END); grid = -1; return; }
        if (hipGetDevice(&dev) != hipSuccess || hipDeviceGetAttribute(&cus, hipDeviceAttributeMultiprocessorCount, dev) != hipSuccess) { grid = -1; return; }
        if (hipFuncSetAttribute((const void*)fwd_kernel, hipFuncAttributeMaxDynamicSharedMemorySize, LDS_BYTES) != hipSuccess) { fprintf(stderr, "kernel_launch: hipFuncSetAttribute failed\n"); grid = -1; return; }
        if (hipOccupancyMaxActiveBlocksPerMultiprocessor(&per_cu, (const void*)fwd_kernel, NTH, LDS_BYTES) != hipSuccess || per_cu < 1) { fprintf(stderr, "kernel_launch: occupancy query reports %d workgroups per CU\n", per_cu); per_cu = 1; }
        (void)hipGetLastError();
        grid = cus;
    }
    if (grid < 0) return;
    (void)hipMemsetAsync((char*)d_ws + WS_CTL, 0, 1u << 20, stream);
    Args a{};
    const void** pp = (const void**)&a.p;
    for (int i = 0; i < 26; ++i) pp[i] = d_in[i];
    a.p.out = (float*)d_out; a.p.ws = (unsigned char*)d_ws;
    hipLaunchKernelGGL(fwd_kernel, dim3(grid), dim3(NTH), LDS_BYTES, stream, a);
}
```

```cpp
#include <hip/hip_runtime.h>
#include <cstdio>
#include <cstdint>
#define HD __device__ __attribute__((always_inline))
__device__ __forceinline__ int tid_fresh() { int t = threadIdx.x; asm volatile("" : "+v"(t)); return t; }
__device__ __forceinline__ int bid_fresh() { int t = blockIdx.x; asm volatile("" : "+s"(t)); return t; }
__device__ __forceinline__ int grid_fresh() { int t = gridDim.x; asm volatile("" : "+s"(t)); return t; }
#ifndef CFG_B
#define CFG_B 16
#endif
#ifndef CFG_S
#define CFG_S 2048
#endif
constexpr int NB = CFG_B, NS = CFG_S, M = NB * NS, D = 1024, NIN = 2840, ZW = 2816, NL = 2;
constexpr int C_RQ = 0, C_RK = 256, C_RV = 512, C_RG = 768, C_GU = 1024, C_GV = 1280, C_NQ = 1536, C_KC = 2048, C_VC = 2176,
              C_KS = 2304, C_VS = 2432, C_KW = 2560, C_VW = 2688;
constexpr int NCMP = NS / 16 - 1, NSEL = NS / 64, NCH = NS / 128;
constexpr float EPS = 1e-6f;

typedef unsigned short bf16;
HD inline bf16 f2bf(float f) { unsigned u = __builtin_bit_cast(unsigned, f); u += 0x7FFFu + ((u >> 16) & 1u); return (bf16)(u >> 16); }
HD inline float bf2f(bf16 b) { return __builtin_bit_cast(float, ((unsigned)b) << 16); }
HD inline float silu_f(float x) { return x / (1.f + expf(-x)); }
HD inline float sigm_f(float x) { return 1.f / (1.f + expf(-x)); }
HD inline float gelu_f(float x) { return 0.5f * x * (1.f + tanhf(0.7978845608028654f * (x + 0.044715f * x * x * x))); }
#ifndef HOST_EMU
__device__ __forceinline__ float gelu_fast(float x) { const float u = 1.5957691216057308f * (x + 0.044715f * x * x * x); return x * __builtin_amdgcn_rcpf(1.f + __expf(-u)); }
__device__ __forceinline__ float silu_fast(float x) { return x * __builtin_amdgcn_rcpf(1.f + __expf(-x)); }
#endif
HD inline float invfreq(int i) { return exp2f(-(float)i * (13.287712379549449f / 32.f)); }

constexpr size_t MiB = 1u << 20;
constexpr size_t al(size_t x) { return (x + 255) & ~(size_t)255; }
constexpr size_t WS_CTL = 0;
constexpr int CW_BAR = 4096, CW_CNT = 16384;
constexpr size_t WS_MOD = 1 * MiB;
constexpr size_t WS_RS = WS_MOD + al((size_t)NL * NB * 6144 * 4);
constexpr size_t WS_GL = WS_RS + al((size_t)M * 4);
constexpr size_t WS_LOG = WS_GL + al((size_t)M * 24 * 4);
constexpr size_t WS_ROUT = WS_LOG + al((size_t)M * 16 * 4);
constexpr size_t WS_KC = WS_ROUT + al((size_t)M * 16);
constexpr size_t WS_VC = WS_KC + al((size_t)NB * 2 * (NCMP + 1) * 64 * 2);
constexpr size_t WS_HID = WS_VC + al((size_t)NB * 2 * (NCMP + 1) * 64 * 2);
constexpr size_t WS_CRAW = WS_HID + al((size_t)NB * NCMP * 4 * 128 * 4);
constexpr size_t WS_SEL = WS_CRAW + al((size_t)NB * NCMP * 4 * 64 * 4);
constexpr size_t WS_CS = WS_SEL + al((size_t)M * 16 * 4);
constexpr size_t WS_CSB = WS_CS + al((size_t)M * 64 * 4);
constexpr size_t WS_PEB = WS_CSB + al((size_t)M * 64 * 2);
constexpr size_t WS_BND = WS_PEB + 4096;
constexpr size_t WS_KVS = WS_BND + 256;
constexpr size_t WS_CTOK = WS_KVS + al((size_t)NB * 4 * NCH * 4096 * 4);
constexpr size_t WS_CWT = WS_CTOK + al((size_t)24 * M * 4);
constexpr size_t WS_WIN_T = WS_CWT + al((size_t)24 * M * 8);
constexpr size_t WS_WGL_T = WS_WIN_T + al((size_t)NL * ZW * D * 2);
constexpr size_t WS_WOUT_T = WS_WGL_T + al((size_t)NL * 32 * D * 2);
constexpr size_t WS_WGU_T = WS_WOUT_T + al((size_t)NL * D * D * 2);
constexpr size_t WS_WD_T = WS_WGU_T + al((size_t)NL * 16 * 1024 * D * 2);
constexpr size_t WS_CW1_T = WS_WD_T + al((size_t)NL * 16 * D * 512 * 2);
constexpr size_t WS_CW2_T = WS_CW1_T + al((size_t)NL * 2 * 256 * 1024 * 2);
constexpr size_t WS_GWS = WS_CW2_T + al((size_t)NL * 2 * 64 * 128 * 2);
constexpr size_t WS_H = al(WS_GWS + (size_t)NL * 4 * 128 * 128 * 2);
constexpr size_t WS_Z = WS_H + al((size_t)M * D * 2);
constexpr size_t WS_XB = WS_Z + 88 * MiB;
constexpr size_t WS_MIX = WS_Z + al((size_t)M * ZW * 2);
constexpr size_t WS_END = WS_MIX + al((size_t)M * D * 2);
constexpr size_t WS_PB = WS_END;
constexpr size_t WS_END_NAIVE = WS_PB + al((size_t)M * 2 * 128 * 4);
constexpr size_t WS_YN = WS_H;
constexpr size_t WS_ACTN = WS_Z;
static_assert(WS_XB + (size_t)M * D * 2 <= WS_Z + (size_t)M * ZW * 2, "XB must fit in Z above ACT");
static_assert(CFG_B != 16 || CFG_S != 2048 || WS_END <= 512 * MiB, "workspace map exceeds 512 MiB");

struct P {
    const float *x, *c; const int* pos;
    const float *ada_w, *ada_b, *norm_mix_g, *norm_ffn_g, *w_in, *w_out, *ret_norm_g, *gmlp_ln_g, *gmlp_ws, *gmlp_b, *nsa_q_norm_g, *nsa_k_norm_g,
        *cmp_pe_k, *cmp_pe_v, *cmp_w1_k, *cmp_w2_k, *cmp_w1_v, *cmp_w2_v, *router_w, *router_b, *moe_w_gate, *moe_w_up, *moe_w_down;
    float* out; unsigned char* ws;
};
struct Rout { int e0, e1; float w0, w1; };

#define WSP(T, off) ((T*)(p.ws + (off)))

#define XB_TMO      128
#define XB_XCNT(j)  (256  + 64 * (j))
#define XB_XSUB(j)  (1280 + 64 * (j))
#define XB_XGEN(j)  (2304 + 64 * (j))
#define XB_TOP      3328
#define XB_TOPGEN   3392
#define XCD_BAR_WORDS 3456
#ifndef XB_SPIN_CAP
#define XB_SPIN_CAP (1u << 15)
#endif
#define LAS __attribute__((address_space(3)))
__device__ __forceinline__ unsigned xb_ld(unsigned* p)              { return __hip_atomic_load(p, __ATOMIC_RELAXED, __HIP_MEMORY_SCOPE_AGENT); }
__device__ __forceinline__ unsigned xb_add(unsigned* p, unsigned v) { return __hip_atomic_fetch_add(p, v, __ATOMIC_RELAXED, __HIP_MEMORY_SCOPE_AGENT); }
__device__ __forceinline__ unsigned xb_xcc_id() { return (unsigned)__builtin_amdgcn_s_getreg((3 << 11) | 20) & 0xFu; }
#define XB_SPIN(cond, bar) do { unsigned _sp = 0; while (cond) { __builtin_amdgcn_s_sleep(1); \
    if ((++_sp & 255u) == 0u) { if (xb_ld(&(bar)[XB_TMO])) break; if (_sp > XB_SPIN_CAP) { atomicAdd(&(bar)[XB_TMO], 1u); break; } } } } while (0)
struct XcdBarrier { unsigned* bar; unsigned x; volatile LAS unsigned* st; };
__device__ __forceinline__ XcdBarrier xcd_barrier_post(unsigned* bar, volatile LAS unsigned* st) {
    XcdBarrier b; b.bar = bar; b.x = xb_xcc_id(); b.st = st;
    if (threadIdx.x == 0) (void)xb_add(&bar[XB_XCNT(b.x)], 1u);
    return b;
}
__device__ __forceinline__ void xcd_barrier_complete(unsigned* bar, unsigned x, unsigned& nloc, unsigned& nx) {
    const unsigned G = gridDim.x * gridDim.y * gridDim.z;
    unsigned sum, cnt, mine, sp = 0u;
    for (;;) {
        sum = 0u; cnt = 0u; mine = 0u;
#pragma unroll
        for (unsigned j = 0; j < 16; ++j) { const unsigned c = xb_ld(&bar[XB_XCNT(j)]); sum += c; cnt += (c > 0u) ? 1u : 0u; mine = (j == x) ? c : mine; }
        if (sum == G) break;
        __builtin_amdgcn_s_sleep(1);
        if ((++sp & 255u) == 0u) { if (xb_ld(&bar[XB_TMO])) break; if (sp > XB_SPIN_CAP) { atomicAdd(&bar[XB_TMO], 1u); break; } }
    }
    nloc = mine > 0u ? mine : 1u; nx = cnt > 0u ? cnt : 1u;
}
__device__ __forceinline__ void xcd_barrier(const XcdBarrier& b) {
    asm volatile("s_waitcnt vmcnt(0)" ::: "memory");
    __syncthreads();
    if (threadIdx.x == 0) {
        unsigned* bar = b.bar;
        __builtin_amdgcn_s_waitcnt(0);
        unsigned nloc = b.st[0], nx = b.st[1];
        if (nloc == 0u) { xcd_barrier_complete(bar, b.x, nloc, nx); b.st[0] = nloc; b.st[1] = nx; }
        const unsigned old = xb_add(&bar[XB_XSUB(b.x)], 1u);
        const unsigned gen = old / nloc;
        if (old + 1u == (gen + 1u) * nloc) {
            __builtin_amdgcn_fence(__ATOMIC_RELEASE, "agent");
            asm volatile("s_waitcnt vmcnt(0)" ::: "memory");
            const unsigned og = xb_add(&bar[XB_TOP], 1u);
            const unsigned tg = og / nx;
            if (og + 1u == (tg + 1u) * nx) xb_add(&bar[XB_TOPGEN], 1u);
            else XB_SPIN(xb_ld(&bar[XB_TOPGEN]) == tg, bar);
            __builtin_amdgcn_fence(__ATOMIC_ACQUIRE, "agent");
            xb_add(&bar[XB_XGEN(b.x)], 1u);
            asm volatile("s_waitcnt vmcnt(0)" ::: "memory");
        } else {
            XB_SPIN(xb_ld(&bar[XB_XGEN(b.x)]) == gen, bar);
            __builtin_amdgcn_fence(__ATOMIC_ACQUIRE, "agent");
            asm volatile("s_waitcnt vmcnt(0)" ::: "memory");
        }
    }
    __syncthreads();
}
namespace pg8 {
#define PG8_LAS __attribute__((address_space(3)))
typedef short bf16x8 __attribute__((ext_vector_type(8)));
typedef float f32x4 __attribute__((ext_vector_type(4)));
typedef float f32x2 __attribute__((ext_vector_type(2)));
typedef unsigned u32x4 __attribute__((ext_vector_type(4)));
typedef unsigned u32x2 __attribute__((ext_vector_type(2)));
constexpr int BM = 256, BK = 64, HALF = 128, HTB = HALF * BK * 2, STAGE_BYTES = 8 * HTB, NXCD = 8, WGM = 8;
__device__ __forceinline__ int lds_byte(int r, int c) { const int st = (r >> 4) * 2 + (c >> 5), rr = r & 15, cc = c & 31, ob = rr * 64 + cc * 2; return st * 1024 + (ob ^ (((ob >> 9) & 1) << 5)); }
__device__ __forceinline__ void stage_rc(int b, int& R, int& C) { const int st = b / 1024, sb = b % 1024, swz = sb ^ (((sb >> 9) & 1) << 5); R = (st >> 1) * 16 + swz / 64; C = (st & 1) * 32 + (swz % 64) / 2; }
__device__ __forceinline__ int perm32(int rho) { const int n = rho >> 4, i = rho & 15; return 8 * (i >> 2) + 4 * n + (i & 3); }
__device__ __forceinline__ unsigned cvt_pk_bf16(float lo, float hi) { unsigned r; asm volatile("v_cvt_pk_bf16_f32 %0, %1, %2" : "=v"(r) : "v"(lo), "v"(hi)); return r; }

struct Unit { int pm, pn, aux, half; };
__device__ __forceinline__ bool deal_unit(int i, int G, int c, int U, int& L, int& half) {
    const int F = (U / G) * G, R = U - F; const long Li = (long)i * G + c; half = 0;
    if (Li < F) { L = (int)Li; return true; }
    if (R == 0 || i > U / G) return false;
    if (2 * R <= G) { if (c >= 2 * R) return false; L = F + (c >> 1); half = 1 + (c & 1); return true; }
    if (Li >= U) return false; L = (int)Li; return true; }
struct StaticSched {
    static constexpr bool GATHER = false; static constexpr int GOFF_LDS = 0;
    const char* A; const char* Bt; int K, nM, nN, nwg, G, c;
    __device__ void init(const void* A_, const void* Bt_, int M_, int N_, int K_, int G_, int c_) { A = (const char*)A_; Bt = (const char*)Bt_; K = K_; nM = M_ / BM; nN = N_ / BM; nwg = nM * nN; G = G_; c = c_; }
    __device__ __forceinline__ bool next(int i, Unit& u) const {
        int L, hf; if (!deal_unit(i, G, c, nwg, L, hf)) return false; u.half = hf;
        int wgid = L; { const int q = nwg / NXCD, r = nwg % NXCD, xcd = wgid % NXCD, off = wgid / NXCD; wgid = (xcd < r ? xcd * (q + 1) : r * (q + 1) + (xcd - r) * q) + off; }
        const int nig = WGM * nN, gid = wgid / nig, fm = gid * WGM, gsz = (nM - fm) < WGM ? (nM - fm) : WGM;
        u.pm = fm + ((wgid % nig) % gsz); u.pn = (wgid % nig) / gsz; u.aux = 0; return true;
    }
    __device__ __forceinline__ int ktiles() const { return K / BK; }
    __device__ __forceinline__ const char* a_base() const { return A; }
    __device__ __forceinline__ size_t a_kstep() const { return BK * 2; }
    __device__ __forceinline__ unsigned a_off(const Unit& u, int row, int C) const { return (unsigned)((u.pm * BM + row) * K + C) * 2u; }
    __device__ __forceinline__ unsigned b_ld() const { return (unsigned)K * 2u; }
    __device__ __forceinline__ const char* b_tile(const Unit& u, int t) const { return Bt + (size_t)u.pn * BM * K * 2 + (size_t)t * (BK * 2); }
};

#ifndef PG8_SP2
#define PG8_SP2 true
#endif
#ifndef PG8_ALIGN
#define PG8_ALIGN true
#endif
template <class Epi, class Sched, bool SP2 = PG8_SP2, bool ALIGN_EPI = PG8_ALIGN>
__device__ __forceinline__ void gemm_phase(PG8_LAS unsigned char* lds, const Sched& S, const Epi& E) {
    const int tid = tid_fresh(), wid = __builtin_amdgcn_readfirstlane(tid >> 6), lane = tid & 63, wr = wid >> 2, wc = wid & 3, fr = lane & 15, fq = lane >> 4;
    const int nt = S.ktiles();
    unsigned voffB[2];
    const unsigned ldb = S.b_ld();
#pragma unroll
    for (int i = 0; i < 2; ++i) { int R, C; stage_rc(tid * 16 + i * 8192, R, C); const int Rb = Epi::PERM ? ((R & ~31) + perm32(R & 31)) : R; voffB[i] = (unsigned)Rb * ldb + (unsigned)C * 2u; }
    const unsigned hstepB = (unsigned)HALF * ldb;
    const unsigned ldsw = (unsigned)wid * 1024u;
    const int aoff = lds_byte(wr * 64 + fr, fq * 8), boff = lds_byte(wc * 32 + fr, fq * 8);
    const char* gA = S.a_base(); const size_t akst = S.a_kstep();
#define PG8_SA(b, h) (((b) * 2 + (h)) * HTB)
#define PG8_SB(b, h) ((4 + (b) * 2 + (h)) * HTB)
#define PG8_STAGE_A(bufoff, offarr, h, tt) do { _Pragma("unroll") for (int _i = 0; _i < 2; ++_i) \
        __builtin_amdgcn_global_load_lds((const unsigned*)(gA + (size_t)(tt) * akst + (offarr)[h][_i]), (PG8_LAS unsigned*)(lds + (bufoff) + ldsw + _i * 8192), 16, 0, 0); } while (0)
#define PG8_STAGE_B(bufoff, bptr, h) do { _Pragma("unroll") for (int _i = 0; _i < 2; ++_i) \
        __builtin_amdgcn_global_load_lds((const unsigned*)((bptr) + (h) * hstepB + voffB[_i]), (PG8_LAS unsigned*)(lds + (bufoff) + ldsw + _i * 8192), 16, 0, 0); } while (0)
#define PG8_LDA(dst, b, h) do { _Pragma("unroll") for (int m = 0; m < 4; ++m) _Pragma("unroll") for (int k = 0; k < 2; ++k) dst[m][k] = *(const PG8_LAS bf16x8*)(lds + PG8_SA(b, h) + aoff + m * 2048 + k * 1024); } while (0)
#define PG8_LDB(dst, b, h) do { _Pragma("unroll") for (int n = 0; n < 2; ++n) _Pragma("unroll") for (int k = 0; k < 2; ++k) dst[n][k] = *(const PG8_LAS bf16x8*)(lds + PG8_SB(b, h) + boff + n * 2048 + k * 1024); } while (0)
#define PG8_MMA(ai, bj, At, Bt) do { __builtin_amdgcn_s_setprio(1); _Pragma("unroll") for (int m = 0; m < 4; ++m) _Pragma("unroll") for (int n = 0; n < 2; ++n) _Pragma("unroll") for (int k = 0; k < 2; ++k) \
        acc[ai][bj][m][n] = __builtin_amdgcn_mfma_f32_16x16x32_bf16(Bt[n][k], At[m][k], acc[ai][bj][m][n], 0, 0, 0); __builtin_amdgcn_s_setprio(0); } while (0)
#define PG8_WAIT_V(n) asm volatile("s_waitcnt vmcnt(" #n ")" ::: "memory")
#define PG8_WAIT_L(n) asm volatile("s_waitcnt lgkmcnt(" #n ")" ::: "memory")
#define PG8_BAR __builtin_amdgcn_s_barrier()
#define PG8_SCHED __builtin_amdgcn_sched_barrier(0)
#define PG8_AOFFS(dst, u) do { _Pragma("unroll") for (int _i = 0; _i < 2; ++_i) { int _R, _C; stage_rc(tid * 16 + _i * 8192, _R, _C); _Pragma("unroll") for (int _h = 0; _h < 2; ++_h) dst[_h][_i] = S.a_off(u, ((u).half ? ((u).half == 2 ? HALF : 0) : _h * HALF) + _R, _C); } } while (0)
#define PG8_NOFF_PUT() do { *(PG8_LAS u32x4*)(lds + Sched::GOFF_LDS + tid * 16) = (u32x4){noff[0][0], noff[0][1], noff[1][0], noff[1][1]}; } while (0)
#define PG8_NOFF_GET(dst) do { const u32x4 _v = *(const PG8_LAS u32x4*)(lds + Sched::GOFF_LDS + tid * 16); dst[0][0] = _v.x; dst[0][1] = _v.y; dst[1][0] = _v.z; dst[1][1] = _v.w; } while (0)
    Unit cur, nxt; int ui = 0;
    if (!S.next(0, cur)) return;
    f32x4 acc[2][2][4][2];
#pragma unroll
    for (int a = 0; a < 2; ++a)
#pragma unroll
        for (int b = 0; b < 2; ++b)
#pragma unroll
            for (int m = 0; m < 4; ++m)
#pragma unroll
                for (int n = 0; n < 2; ++n) acc[a][b][m][n] = (f32x4){0.f, 0.f, 0.f, 0.f};
    bf16x8 At[4][2], B0[2][2], B1[2][2];
    constexpr bool GATHER = Sched::GATHER;
    unsigned coff[2][2], noff[2][2];
    PG8_AOFFS(coff, cur);
    { const char* b0 = S.b_tile(cur, 0); const char* b1 = S.b_tile(cur, 1);
      if constexpr (SP2) {
      PG8_STAGE_B(PG8_SB(0, 0), b0, 0); PG8_STAGE_B(PG8_SB(0, 1), b0, 1); PG8_STAGE_A(PG8_SA(0, 0), coff, 0, 0); PG8_STAGE_A(PG8_SA(0, 1), coff, 1, 0);
      if (wr == 1) PG8_BAR;
      PG8_WAIT_V(2); PG8_BAR;
      PG8_STAGE_B(PG8_SB(1, 0), b1, 0); PG8_STAGE_A(PG8_SA(1, 0), coff, 0, 1); PG8_STAGE_B(PG8_SB(1, 1), b1, 1);
      PG8_WAIT_V(6); PG8_BAR;
      } else {
      PG8_STAGE_B(PG8_SB(0, 0), b0, 0); PG8_STAGE_A(PG8_SA(0, 0), coff, 0, 0); PG8_STAGE_B(PG8_SB(0, 1), b0, 1); PG8_STAGE_A(PG8_SA(0, 1), coff, 1, 0);
      if (wr == 1) PG8_BAR;
      PG8_WAIT_V(4); PG8_BAR;
      PG8_STAGE_B(PG8_SB(1, 0), b1, 0); PG8_STAGE_A(PG8_SA(1, 0), coff, 0, 1); PG8_STAGE_B(PG8_SB(1, 1), b1, 1);
      PG8_WAIT_V(6); PG8_BAR; } }
    for (;;) {
        const bool has_next = S.next(ui + 1, nxt);
        if (has_next) { if constexpr (GATHER) { PG8_AOFFS(noff, nxt); PG8_NOFF_PUT(); } }
        else { nxt = cur;
#pragma unroll
            for (int _h = 0; _h < 2; ++_h)
#pragma unroll
                for (int _i = 0; _i < 2; ++_i) if constexpr (GATHER) noff[_h][_i] = coff[_h][_i]; if constexpr (GATHER) PG8_NOFF_PUT(); }
        for (int t = 0; t < nt; t += 2) {
            const bool last = (t == nt - 2);
            const int t2 = last ? 0 : t + 2, t3 = t2 + 1;
            const char* b2 = last ? S.b_tile(nxt, 0) : S.b_tile(cur, t + 2);
            const char* b3 = last ? S.b_tile(nxt, 1) : S.b_tile(cur, t + 3);
            unsigned o2[2][2];
            if constexpr (GATHER) {
#pragma unroll
                for (int _h = 0; _h < 2; ++_h)
#pragma unroll
                    for (int _i = 0; _i < 2; ++_i) o2[_h][_i] = coff[_h][_i];
                if (last) PG8_NOFF_GET(o2); }
            else { if (last) PG8_AOFFS(o2, nxt); else PG8_AOFFS(o2, cur); PG8_AOFFS(coff, cur); }
            if constexpr (SP2) {
            PG8_LDB(B0, 0, 0); PG8_LDB(B1, 0, 1); PG8_SCHED; PG8_LDA(At, 0, 0); PG8_STAGE_A(PG8_SA(1, 1), coff, 1, t + 1);
            PG8_WAIT_V(8); PG8_WAIT_L(0); PG8_BAR; PG8_MMA(0, 0, At, B0); PG8_MMA(0, 1, At, B1); PG8_BAR; PG8_SCHED;
            PG8_LDA(At, 0, 1); PG8_STAGE_B(PG8_SB(0, 0), b2, 0); PG8_STAGE_B(PG8_SB(0, 1), b2, 1); PG8_STAGE_A(PG8_SA(0, 0), o2, 0, t2);
            PG8_WAIT_V(8); PG8_WAIT_L(0); PG8_BAR; if (!cur.half) { PG8_MMA(1, 0, At, B0); PG8_MMA(1, 1, At, B1); } PG8_BAR; PG8_SCHED;
            PG8_LDB(B0, 1, 0); PG8_LDB(B1, 1, 1); PG8_SCHED; PG8_LDA(At, 1, 0); PG8_STAGE_A(PG8_SA(0, 1), o2, 1, t2);
            PG8_WAIT_V(8); PG8_WAIT_L(0); PG8_BAR; PG8_MMA(0, 0, At, B0); PG8_MMA(0, 1, At, B1); PG8_BAR; PG8_SCHED;
            PG8_LDA(At, 1, 1); PG8_STAGE_B(PG8_SB(1, 0), b3, 0); PG8_STAGE_B(PG8_SB(1, 1), b3, 1); PG8_STAGE_A(PG8_SA(1, 0), o2, 0, t3);
            PG8_WAIT_V(8); PG8_WAIT_L(0); PG8_BAR; if (!cur.half) { PG8_MMA(1, 0, At, B0); PG8_MMA(1, 1, At, B1); } PG8_BAR; PG8_SCHED;
            } else {
            PG8_LDB(B0, 0, 0); PG8_SCHED; PG8_LDA(At, 0, 0); PG8_STAGE_A(PG8_SA(1, 1), coff, 1, t + 1);
            PG8_WAIT_L(8); PG8_BAR; PG8_WAIT_L(0); PG8_MMA(0, 0, At, B0); PG8_BAR; PG8_SCHED;
            PG8_LDB(B1, 0, 1); PG8_STAGE_B(PG8_SB(0, 0), b2, 0);
            PG8_BAR; PG8_WAIT_L(0); PG8_MMA(0, 1, At, B1); PG8_BAR;
            PG8_LDA(At, 0, 1); PG8_STAGE_A(PG8_SA(0, 0), o2, 0, t2);
            PG8_BAR; PG8_WAIT_L(0); PG8_MMA(1, 0, At, B0); PG8_BAR; PG8_SCHED;
            PG8_STAGE_B(PG8_SB(0, 1), b2, 1);
            PG8_WAIT_V(6); PG8_BAR; PG8_MMA(1, 1, At, B1); PG8_BAR;
            PG8_LDB(B0, 1, 0); PG8_SCHED; PG8_LDA(At, 1, 0); PG8_STAGE_A(PG8_SA(0, 1), o2, 1, t2);
            PG8_WAIT_L(8); PG8_BAR; PG8_WAIT_L(0); PG8_MMA(0, 0, At, B0); PG8_BAR; PG8_SCHED;
            PG8_LDB(B1, 1, 1); PG8_STAGE_B(PG8_SB(1, 0), b3, 0);
            PG8_BAR; PG8_WAIT_L(0); PG8_MMA(0, 1, At, B1); PG8_BAR;
            PG8_LDA(At, 1, 1); PG8_STAGE_A(PG8_SA(1, 0), o2, 0, t3);
            PG8_BAR; PG8_WAIT_L(0); PG8_MMA(1, 0, At, B0); PG8_BAR; PG8_SCHED;
            PG8_STAGE_B(PG8_SB(1, 1), b3, 1);
            PG8_WAIT_V(6); PG8_BAR; PG8_MMA(1, 1, At, B1); PG8_BAR;
            }
        }
        if constexpr (ALIGN_EPI) { if (wr == 0) PG8_BAR; }
        if constexpr (!Epi::AFTER_DRAIN) E(acc, cur, wr, wc, fr, fq);
        if (!has_next) break;
#pragma unroll
        for (int a = 0; a < 2; ++a)
#pragma unroll
            for (int b = 0; b < 2; ++b)
#pragma unroll
                for (int m = 0; m < 4; ++m)
#pragma unroll
                    for (int n = 0; n < 2; ++n) acc[a][b][m][n] = (f32x4){0.f, 0.f, 0.f, 0.f};
        cur = nxt; ++ui;
        if constexpr (ALIGN_EPI) { if (wr == 1) PG8_BAR; }
#pragma unroll
        for (int _h = 0; _h < 2; ++_h)
#pragma unroll
            for (int _i = 0; _i < 2; ++_i) if constexpr (GATHER) coff[_h][_i] = 0u;
        if constexpr (GATHER) PG8_NOFF_GET(coff);
    }
    PG8_WAIT_V(0);
    if constexpr (!ALIGN_EPI) { if (wr == 0) PG8_BAR; }
    PG8_BAR;
    if constexpr (Epi::AFTER_DRAIN) E.fused(acc, cur, wr, wc, fr, fq, lds);
#undef PG8_SA
#undef PG8_SB
#undef PG8_STAGE_A
#undef PG8_STAGE_B
#undef PG8_LDA
#undef PG8_LDB
#undef PG8_MMA
#undef PG8_WAIT_V
#undef PG8_WAIT_L
#undef PG8_BAR
#undef PG8_SCHED
#undef PG8_AOFFS
#undef PG8_NOFF_PUT
#undef PG8_NOFF_GET
}

struct EpiBf16Store {
    static constexpr bool PERM = true, AFTER_DRAIN = false;
    bf16* O; int ldc;
    __device__ __forceinline__ void operator()(const f32x4 (&acc)[2][2][4][2], const Unit& u, int wr, int wc, int fr, int fq) const {
        const int row0 = u.pm * BM + wr * 64 + fr + (u.half == 2 ? HALF : 0), col0 = u.pn * BM + wc * 32 + 8 * fq;
#pragma unroll
        for (int ai = 0; ai < 2; ++ai)
#pragma unroll
            for (int m = 0; m < 4; ++m) { if (ai == 1 && u.half) continue; bf16* rowp = O + (size_t)(row0 + ai * HALF + m * 16) * ldc + col0;
#pragma unroll
                for (int bj = 0; bj < 2; ++bj) { const f32x4 v0 = acc[ai][bj][m][0], v1 = acc[ai][bj][m][1];
                    u32x4 w; w.x = cvt_pk_bf16(v0[0], v0[1]); w.y = cvt_pk_bf16(v0[2], v0[3]); w.z = cvt_pk_bf16(v1[0], v1[1]); w.w = cvt_pk_bf16(v1[2], v1[3]);
                    *(u32x4*)(rowp + bj * HALF) = w; } }
    }
};
struct EpiResidual {
    static constexpr bool PERM = true, AFTER_DRAIN = false;
    const void* xs; bool xbf; bf16* out; const float* gate;
    __device__ __forceinline__ void operator()(const f32x4 (&acc)[2][2][4][2], const Unit& u, int wr, int wc, int fr, int fq) const {
        const int row0 = u.pm * BM + wr * 64 + fr + (u.half == 2 ? HALF : 0), col0 = u.pn * BM + wc * 32 + 8 * fq;
        const float* gp = gate + (size_t)((u.pm * BM) / NS) * 6144 + col0;
        f32x4 gv[2][2];
#pragma unroll
        for (int bj = 0; bj < 2; ++bj)
#pragma unroll
            for (int n = 0; n < 2; ++n) gv[bj][n] = *(const f32x4*)(gp + bj * HALF + n * 4);
#pragma unroll
        for (int ai = 0; ai < 2; ++ai) { if (ai == 1 && u.half) continue;
#pragma unroll
          for (int mp = 0; mp < 2; ++mp) {
            f32x4 x0[2][2], x1[2][2];
#pragma unroll
            for (int mm = 0; mm < 2; ++mm) { const size_t ro = (size_t)(row0 + ai * HALF + (2 * mp + mm) * 16) * D + col0;
#pragma unroll
                for (int bj = 0; bj < 2; ++bj) {
                    if (xbf) { const u32x4 w = *(const u32x4*)((const bf16*)xs + ro + bj * HALF);
                        x0[mm][bj] = (f32x4){__builtin_bit_cast(float, w.x << 16), __builtin_bit_cast(float, w.x & 0xffff0000u), __builtin_bit_cast(float, w.y << 16), __builtin_bit_cast(float, w.y & 0xffff0000u)};
                        x1[mm][bj] = (f32x4){__builtin_bit_cast(float, w.z << 16), __builtin_bit_cast(float, w.z & 0xffff0000u), __builtin_bit_cast(float, w.w << 16), __builtin_bit_cast(float, w.w & 0xffff0000u)}; }
                    else { x0[mm][bj] = *(const f32x4*)((const float*)xs + ro + bj * HALF); x1[mm][bj] = *(const f32x4*)((const float*)xs + ro + bj * HALF + 4); } } }
#pragma unroll
            for (int mm = 0; mm < 2; ++mm) { const int m = 2 * mp + mm; const size_t ro = (size_t)(row0 + ai * HALF + m * 16) * D + col0;
#pragma unroll
                for (int bj = 0; bj < 2; ++bj) { const f32x4 y0 = x0[mm][bj] + gv[bj][0] * acc[ai][bj][m][0], y1 = x1[mm][bj] + gv[bj][1] * acc[ai][bj][m][1];
                    u32x4 o; o.x = cvt_pk_bf16(y0[0], y0[1]); o.y = cvt_pk_bf16(y0[2], y0[3]); o.z = cvt_pk_bf16(y1[0], y1[1]); o.w = cvt_pk_bf16(y1[2], y1[3]);
                    *(u32x4*)(out + ro + bj * HALF) = o; } } } }
    }
};
}
constexpr int NTH = 512;
typedef float f32x4_t __attribute__((ext_vector_type(4)));
typedef unsigned u32x4_t __attribute__((ext_vector_type(4)));
typedef unsigned u32x2_t __attribute__((ext_vector_type(2)));
typedef short s16x8_t __attribute__((ext_vector_type(8)));
#define LDSP(T, off) ((LAS T*)(lds + (off)))
__device__ __forceinline__ float wave_sum(float v) {
#pragma unroll
    for (int o = 1; o < 64; o <<= 1) v += __shfl_xor(v, o);
    return v;
}
__device__ __forceinline__ unsigned pk_bf16(float lo, float hi) { return pg8::cvt_pk_bf16(lo, hi); }

constexpr int CVT_WIN = 2 * 16 * 44, CVT_WOUT = 2 * 16 * 16, CVT_G = 32 * 16 * 8, CVT_U = CVT_G, CVT_D = 32 * 8 * 16, CVT_C1 = 4 * 32 * 2, CVT_C2 = 4 * 2;
constexpr int CVT_TOTAL = CVT_WIN + CVT_WOUT + CVT_G + CVT_U + CVT_D + CVT_C1 + CVT_C2;
__device__ __forceinline__ void cvt_job(const P& p, int T, const float*& src, size_t& lds_, bf16*& dst, size_t& ldd, bool& perm) {
    perm = false;
    if (T < CVT_WIN) { const int l = T / 704, r = T % 704, kt = r / 44, nt = r % 44;
        src = p.w_in + (size_t)l * D * NIN + (size_t)kt * 64 * NIN + nt * 64; lds_ = NIN; dst = WSP(bf16, WS_WIN_T) + (size_t)l * ZW * D + (size_t)((nt / 4) * 256 + (nt % 4) * 32) * D + kt * 64; ldd = D; perm = true; return; }
    T -= CVT_WIN;
    if (T < CVT_WOUT) { const int l = T / 256, r = T % 256, kt = r / 16, nt = r % 16;
        src = p.w_out + (size_t)l * D * D + (size_t)kt * 64 * D + nt * 64; lds_ = D; dst = WSP(bf16, WS_WOUT_T) + (size_t)l * D * D + (size_t)nt * 64 * D + kt * 64; ldd = D; return; }
    T -= CVT_WOUT;
    if (T < CVT_G + CVT_U) { const int up = T >= CVT_G; if (up) T -= CVT_G; const int le = T / 128, r = T % 128, kt = r / 8, nt = r % 8;
        src = (up ? p.moe_w_up : p.moe_w_gate) + (size_t)le * D * 512 + (size_t)kt * 64 * 512 + nt * 64; lds_ = 512;
        const int row0 = 256 * (nt / 2) + 64 * (nt % 2) + (up ? 128 : 0);
        dst = WSP(bf16, WS_WGU_T) + (size_t)le * 1024 * D + (size_t)row0 * D + kt * 64; ldd = D; return; }
    T -= CVT_G + CVT_U;
    if (T < CVT_D) { const int le = T / 128, r = T % 128, kt = r / 16, nt = r % 16;
        src = p.moe_w_down + (size_t)le * 512 * D + (size_t)kt * 64 * D + nt * 64; lds_ = D; dst = WSP(bf16, WS_WD_T) + (size_t)le * D * 512 + (size_t)nt * 64 * 512 + kt * 64; ldd = 512; return; }
    T -= CVT_D;
    if (T < CVT_C1) { const int lk = T / 64, l = lk / 2, kv = lk % 2, r = T % 64, kt = r / 2, nt = r % 2;
        src = (kv ? p.cmp_w1_v : p.cmp_w1_k) + (size_t)l * 2048 * 128 + (size_t)kt * 64 * 128 + nt * 64; lds_ = 128; dst = WSP(bf16, WS_CW1_T) + (size_t)lk * 256 * 1024 + (size_t)((kt >= 16 ? 128 : 0) + nt * 64) * 1024 + (kt & 15) * 64; ldd = 1024; return; }
    T -= CVT_C1;
    { const int lk = T / 2, l = lk / 2, kv = lk % 2, kt = T % 2;
        src = (kv ? p.cmp_w2_v : p.cmp_w2_k) + (size_t)l * 128 * 64 + (size_t)kt * 64 * 64; lds_ = 64; dst = WSP(bf16, WS_CW2_T) + (size_t)lk * 64 * 128 + kt * 64; ldd = 128; }
}
__device__ __forceinline__ void p0_prologue(const P& p, LAS unsigned char* lds) {
    const int tid = tid_fresh();
    if (bid_fresh() < 192) {
        LAS float* sc = LDSP(float, 0);
        LAS float* red = LDSP(float, 65536);
        for (int i = tid; i < NB * D; i += NTH) sc[i] = silu_f(p.c[i]);
        __syncthreads();
        const int lane = tid & 63, wv_ = tid >> 6, col = bid_fresh() * 64 + lane, l = col / 6144, n = col % 6144;
        float acc[NB];
#pragma unroll
        for (int b = 0; b < NB; ++b) acc[b] = 0.f;
        const float* w = p.ada_w + (size_t)l * D * 6144 + n;
        for (int k = wv_ * 128; k < wv_ * 128 + 128; k += 16) { float wv[16];
#pragma unroll
            for (int u = 0; u < 16; ++u) wv[u] = w[(size_t)(k + u) * 6144];
#pragma unroll
            for (int u = 0; u < 16; ++u)
#pragma unroll
                for (int b = 0; b < NB; ++b) acc[b] += sc[b * D + k + u] * wv[u]; }
#pragma unroll
        for (int b = 0; b < NB; ++b) red[(wv_ * NB + b) * 64 + lane] = acc[b];
        __syncthreads();
        for (int i = tid; i < NB * 64; i += NTH) { const int b = i >> 6, c = i & 63, cc = bid_fresh() * 64 + c, ll = cc / 6144, nn = cc % 6144; float s = p.ada_b[ll * 6144 + nn];
#pragma unroll
            for (int q = 0; q < 8; ++q) s += red[(q * NB + b) * 64 + c];
            WSP(float, WS_MOD)[((size_t)ll * NB + b) * 6144 + nn] = s; }
        __syncthreads();
    }
    { constexpr int TP = 8; const int G = grid_fresh(), bx = bid_fresh();
      for (int T0 = bx * TP; T0 < CVT_TOTAL; T0 += G * TP) {
        f32x4_t va[TP], vb[TP]; bf16* dst[TP]; size_t ld[TP]; bool perm[TP];
        const int k = tid >> 3, ns = (tid & 7) * 8;
#pragma unroll
        for (int q = 0; q < TP; ++q) { const int T = T0 + q < CVT_TOTAL ? T0 + q : CVT_TOTAL - 1; const float* src; size_t ls; cvt_job(p, T, src, ls, dst[q], ld[q], perm[q]);
            va[q] = *(const f32x4_t*)(src + (size_t)k * ls + ns); vb[q] = *(const f32x4_t*)(src + (size_t)k * ls + ns + 4); }
#pragma unroll
        for (int q = 0; q < TP; ++q) { LAS float* tile = LDSP(float, q * 64 * 65 * 4);
#pragma unroll
            for (int j = 0; j < 4; ++j) { tile[k * 65 + ns + j] = va[q][j]; tile[k * 65 + ns + 4 + j] = vb[q][j]; } }
        __syncthreads();
#pragma unroll
        for (int q = 0; q < TP; ++q) { if (T0 + q < CVT_TOTAL) { LAS float* tile = LDSP(float, q * 64 * 65 * 4); const int n = tid >> 3, ks = (tid & 7) * 8; u32x4_t w;
            w.x = pk_bf16(tile[(ks + 0) * 65 + n], tile[(ks + 1) * 65 + n]); w.y = pk_bf16(tile[(ks + 2) * 65 + n], tile[(ks + 3) * 65 + n]);
            w.z = pk_bf16(tile[(ks + 4) * 65 + n], tile[(ks + 5) * 65 + n]); w.w = pk_bf16(tile[(ks + 6) * 65 + n], tile[(ks + 7) * 65 + n]);
            const int nrow = perm[q] ? 128 * (n >> 5) + (n & 31) : n;
            *(u32x4_t*)(dst[q] + (size_t)nrow * ld[q] + ks) = w; } }
        __syncthreads();
      } }
    const long gid = (long)bid_fresh() * NTH + tid, gsz = (long)grid_fresh() * NTH;
    for (long i = gid; i < 2L * 32 * D; i += gsz) { const int k = (int)(i % D), j = (int)((i / D) % 32), l = (int)(i / (32 * D));
        WSP(bf16, WS_WGL_T)[i] = j < 24 ? f2bf(p.w_in[(size_t)l * D * NIN + (size_t)k * NIN + ZW + j]) : (bf16)0; }
    { const int lane = tid & 63, gw = (int)(gid >> 6), nw = (int)(gsz >> 6);
      for (int o = gw; o < 2 * 2 * 128; o += nw) { const int j = o % 128, kv = (o / 128) % 2, l = o / 256;
        const float* pe = (kv ? p.cmp_pe_v : p.cmp_pe_k) + (size_t)l * 2048; const float* w1 = (kv ? p.cmp_w1_v : p.cmp_w1_k) + (size_t)l * 2048 * 128 + j; float sacc = 0.f;
#pragma unroll 8
        for (int k = lane; k < 2048; k += 64) sacc += pe[k] * w1[(size_t)k * 128];
        sacc = wave_sum(sacc); if (lane == 0) WSP(float, WS_PEB)[o] = sacc; } }
    if (gid < 6) { const int l = (int)gid / 3, br = (int)gid % 3; float mq = 0.f, mk = 0.f;
        for (int e = 0; e < 64; ++e) { mq = fmaxf(mq, fabsf(p.nsa_q_norm_g[l * 64 + e])); mk = fmaxf(mk, fabsf(p.nsa_k_norm_g[(l * 3 + br) * 64 + e])); }
        WSP(float, WS_BND)[gid] = 8.f * mq * mk * 1.4426950408889634f; }
    for (long i = gid; i < 2L * 4 * 128 * 128; i += gsz) { const int s = (int)(i % 128), t = (int)((i / 128) % 128); WSP(bf16, WS_GWS)[i] = s <= t ? f2bf(p.gmlp_ws[i]) : (bf16)0; }
    for (long i = gid; i < (long)M * 32; i += gsz) { const long m = i / 32; const int j = (int)(i % 32); const float ang = (float)p.pos[m] * invfreq(j);
        const float cv = cosf(ang), sv = sinf(ang); WSP(float, WS_CS)[m * 64 + j] = cv; WSP(float, WS_CS)[m * 64 + 32 + j] = sv; WSP(bf16, WS_CSB)[m * 64 + j] = f2bf(cv); WSP(bf16, WS_CSB)[m * 64 + 32 + j] = f2bf(sv); }
}

__device__ __forceinline__ f32x4_t ld4x(const void* base, size_t idx, bool isbf) {
    if (isbf) { const u32x2_t w = *(const u32x2_t*)((const bf16*)base + idx); return (f32x4_t){__builtin_bit_cast(float, w.x << 16), __builtin_bit_cast(float, w.x & 0xffff0000u), __builtin_bit_cast(float, w.y << 16), __builtin_bit_cast(float, w.y & 0xffff0000u)}; }
    return *(const f32x4_t*)((const float*)base + idx); }
__device__ __forceinline__ void norm_phase(const P& p, LAS unsigned char* lds, const void* xs, bool xbf, int l, int which, int cbank = -1) {
    if (cbank < 0) cbank = l;
    const int tid = tid_fresh(), lane = tid & 63, wave = tid >> 6;
    const float* g = (which ? p.norm_ffn_g : p.norm_mix_g) + l * D;
    bf16* H = WSP(bf16, WS_H);
    LAS float* wr_l = LDSP(float, 0);
    LAS float* lg_l = LDSP(float, 65536);
    LAS int* lcnt = LDSP(int, 65536 + 8192);
    LAS float* red_l = LDSP(float, 65536 + 8192 + 256);
    LAS float* rs_l = LDSP(float, 65536 + 8192 + 256 + 2048);
    for (int rb = bid_fresh(); rb < M / 128; rb += grid_fresh()) {
        const int b = (rb * 128) / NS; const float* mod = WSP(float, WS_MOD) + ((size_t)l * NB + b) * 6144 + which * 3072;
        if (which) {
            __syncthreads();
            if (tid < 48) lcnt[tid] = 0;
            for (int i = tid; i < D * 16; i += NTH) { const int k = i >> 4, e = i & 15; wr_l[(k >> 4) * 256 + ((k >> 2) & 3) * 64 + e * 4 + (k & 3)] = g[k] * (1.f + mod[1024 + k]) * p.router_w[i]; }
            if (tid < 256) { const int e = tid & 15, part = tid >> 4; float s = 0.f; for (int k = part * 64; k < part * 64 + 64; ++k) s += mod[k] * p.router_w[k * 16 + e]; red_l[part * 16 + e] = s; }
            __syncthreads();
            if (tid < 16) { float s = 0.f;
#pragma unroll
                for (int q = 0; q < 16; ++q) s += red_l[q * 16 + tid]; red_l[256 + tid] = s; }
            __syncthreads();
            const int r = lane & 15, kq = lane >> 4; const size_t xr = (size_t)((long)rb * 128 + wave * 16 + r) * D + 4 * kq;
            f32x4_t acc = {0.f, 0.f, 0.f, 0.f}; float ss = 0.f;
#pragma unroll 8
            for (int t = 0; t < 64; ++t) { const f32x4_t xv = ld4x(xs, xr + 16 * t, xbf); const f32x4_t av = *(const LAS f32x4_t*)(wr_l + t * 256 + kq * 64 + r * 4);
                ss += xv[0] * xv[0] + xv[1] * xv[1] + xv[2] * xv[2] + xv[3] * xv[3];
                acc = __builtin_amdgcn_mfma_f32_16x16x4f32(av[0], xv[0], acc, 0, 0, 0); acc = __builtin_amdgcn_mfma_f32_16x16x4f32(av[1], xv[1], acc, 0, 0, 0);
                acc = __builtin_amdgcn_mfma_f32_16x16x4f32(av[2], xv[2], acc, 0, 0, 0); acc = __builtin_amdgcn_mfma_f32_16x16x4f32(av[3], xv[3], acc, 0, 0, 0); }
            ss += __shfl_xor(ss, 16); ss += __shfl_xor(ss, 32);
            const float rs = 1.0f / sqrtf(ss * (1.f / D) + EPS);
            if (kq == 0) rs_l[wave * 16 + r] = rs;
#pragma unroll
            for (int reg = 0; reg < 4; ++reg) lg_l[(wave * 16 + r) * 16 + 4 * kq + reg] = rs * acc[reg] + red_l[256 + 4 * kq + reg];
        }
        f32x4_t gmv[4], shv[4];
#pragma unroll
        for (int i = 0; i < 4; ++i) { const int k0 = 256 * i + 4 * lane; const f32x4_t gv = *(const f32x4_t*)(g + k0), sc = *(const f32x4_t*)(mod + 1024 + k0); shv[i] = *(const f32x4_t*)(mod + k0);
#pragma unroll
            for (int j = 0; j < 4; ++j) gmv[i][j] = gv[j] * (1.f + sc[j]); }
        f32x4_t hn[4][4];
#pragma unroll
        for (int r = 0; r < 4; ++r)
#pragma unroll
            for (int i = 0; i < 4; ++i) hn[r][i] = ld4x(xs, (size_t)((long)rb * 128 + wave * 16 + r) * D + 256 * i + 4 * lane, xbf);
#pragma unroll
        for (int grp = 0; grp < 4; ++grp) {
            const long row0 = (long)rb * 128 + wave * 16 + grp * 4;
            f32x4_t hv[4][4]; float ss[4];
#pragma unroll
            for (int r = 0; r < 4; ++r) { ss[r] = 0.f;
#pragma unroll
                for (int i = 0; i < 4; ++i) { hv[r][i] = hn[r][i]; if (!which) ss[r] += hv[r][i][0] * hv[r][i][0] + hv[r][i][1] * hv[r][i][1] + hv[r][i][2] * hv[r][i][2] + hv[r][i][3] * hv[r][i][3]; } }
            if (grp < 3) {
#pragma unroll
                for (int r = 0; r < 4; ++r)
#pragma unroll
                    for (int i = 0; i < 4; ++i) hn[r][i] = ld4x(xs, (size_t)(row0 + 4 + r) * D + 256 * i + 4 * lane, xbf); }
#pragma unroll
            for (int r = 0; r < 4; ++r) ss[r] = which ? rs_l[wave * 16 + grp * 4 + r] : 1.0f / sqrtf(wave_sum(ss[r]) * (1.f / D) + EPS);
#pragma unroll
            for (int i = 0; i < 4; ++i) { const int k0 = 256 * i + 4 * lane;
#pragma unroll
                for (int r = 0; r < 4; ++r) { hv[r][i] = hv[r][i] * ss[r] * gmv[i] + shv[i];
                    u32x2_t w; w.x = pk_bf16(hv[r][i][0], hv[r][i][1]); w.y = pk_bf16(hv[r][i][2], hv[r][i][3]); *(u32x2_t*)(H + (row0 + r) * D + k0) = w; } }
        }
        if (which) {
            int cls = -1, rank = 0; float wa = 0.f, wb = 0.f; const long row = (long)rb * 128 + wave * 16 + lane;
            __builtin_amdgcn_s_waitcnt(0);
            if (lane < 16) {
                const LAS float* q = lg_l + (wave * 16 + lane) * 16;
                float mx = q[0];
#pragma unroll
                for (int e = 1; e < 16; ++e) mx = fmaxf(mx, q[e]);
                float den = 0.f;
#pragma unroll
                for (int e = 0; e < 16; ++e) den += expf(q[e] - mx);
                float bestg = -3e38f; int bg = 0;
#pragma unroll
                for (int gI = 0; gI < 4; ++gI) { float a = -3e38f, b2 = -3e38f;
#pragma unroll
                    for (int j = 0; j < 4; ++j) { const float s = expf(q[gI * 4 + j] - mx) / den + p.router_b[gI * 4 + j]; if (s > a) { b2 = a; a = s; } else if (s > b2) b2 = s; }
                    if (a + b2 > bestg) { bestg = a + b2; bg = gI; } }
                float a = -3e38f, b2 = -3e38f; int ia = 0, ib = 0;
#pragma unroll
                for (int j = 0; j < 4; ++j) { const float s = expf(q[bg * 4 + j] - mx) / den + p.router_b[bg * 4 + j];
                    if (s > a) { b2 = a; ib = ia; a = s; ia = j; } else if (s > b2) { b2 = s; ib = j; } }
                const float p0 = expf(q[bg * 4 + ia] - mx) / den, p1 = expf(q[bg * 4 + ib] - mx) / den;
                const float w0 = p0 / (p0 + p1), w1 = p1 / (p0 + p1);
                const int lo = ia < ib ? ia : ib, hi = ia < ib ? ib : ia;
                wa = ia < ib ? w0 : w1; wb = ia < ib ? w1 : w0;
                const int pairidx = lo == 0 ? hi - 1 : (lo == 1 ? hi + 1 : 5);
                cls = bg * 6 + pairidx;
                rank = atomicAdd((int*)&lcnt[cls], 1);
                Rout r; r.e0 = bg * 4 + ia; r.e1 = bg * 4 + ib; r.w0 = w0; r.w1 = w1; WSP(Rout, WS_ROUT)[row] = r;
            }
            __syncthreads();
            if (tid < 24) { const int c = lcnt[tid]; lcnt[24 + tid] = c ? atomicAdd(WSP(int, WS_CTL) + CW_CNT + cbank * 64 + tid, c) : 0; }
            __syncthreads();
            if (lane < 16) { const int slot = lcnt[24 + cls] + rank; WSP(int, WS_CTOK)[(size_t)cls * M + slot] = (int)row; float* wp = WSP(float, WS_CWT) + ((size_t)cls * M + slot) * 2; wp[0] = wa; wp[1] = wb; }
            __syncthreads();
            if (tid < 24) lcnt[tid] = 0;
            __syncthreads();
        }
    }
}

__device__ __forceinline__ void gl_tail(const P& p, int l) {
    const int tid = tid_fresh(), lane = tid & 63, wave = tid >> 6, fr = lane & 15, fq = lane >> 4;
    const bf16* H = WSP(bf16, WS_H); const bf16* W = WSP(bf16, WS_WGL_T) + (size_t)l * 32 * D; float* GL = WSP(float, WS_GL);
    for (int rt = bid_fresh() * 8 + wave; rt < M / 16; rt += grid_fresh() * 8) {
        pg8::f32x4 acc0 = {0.f, 0.f, 0.f, 0.f}, acc1 = {0.f, 0.f, 0.f, 0.f};
        const bf16* ap = H + (size_t)(rt * 16 + fr) * D + fq * 8; const bf16* bp0 = W + (size_t)fr * D + fq * 8; const bf16* bp1 = W + (size_t)(16 + fr) * D + fq * 8;
#pragma unroll 8
        for (int s = 0; s < 32; ++s) { const s16x8_t a = *(const s16x8_t*)(ap + s * 32), b0 = *(const s16x8_t*)(bp0 + s * 32), b1 = *(const s16x8_t*)(bp1 + s * 32);
            acc0 = __builtin_amdgcn_mfma_f32_16x16x32_bf16(a, b0, acc0, 0, 0, 0); acc1 = __builtin_amdgcn_mfma_f32_16x16x32_bf16(a, b1, acc1, 0, 0, 0); }
#pragma unroll
        for (int r = 0; r < 4; ++r) { const long m = (long)rt * 16 + 4 * fq + r; GL[m * 24 + fr] = acc0[r]; if (fr < 8) GL[m * 24 + 16 + fr] = acc1[r]; }
    }
}

struct EpiZ {
    static constexpr bool PERM = true, AFTER_DRAIN = false;
    const P* pp; int l;
    __device__ __forceinline__ void operator()(const pg8::f32x4 (&acc)[2][2][4][2], const pg8::Unit& u, int wr, int wc, int fr, int fq) const {
        const P& p = *pp; bf16* Z = WSP(bf16, WS_Z); const bf16* CSB = WSP(bf16, WS_CSB);
        const int pn = u.pn;
        int mode = 0; float scale = 1.f; const float* gain = nullptr;
        if (pn == 0) mode = 1; else if (pn == 1) { mode = 1; scale = 0.125f; } else if (pn == 3) mode = 3; else if (pn == 4 || pn == 5) mode = 4;
        else if (pn == 6 || pn == 7) { mode = 2; scale = 0.125f; gain = p.nsa_q_norm_g + l * 64; }
        else if (pn == 9 && wc < 2) { mode = 2; gain = p.nsa_k_norm_g + (l * 3 + 1) * 64; }
        else if (pn == 10 && wc < 2) { mode = 2; gain = p.nsa_k_norm_g + (l * 3 + 2) * 64; }
        float g0[8], g1[8];
        if (mode == 2) {
#pragma unroll
            for (int j = 0; j < 8; ++j) { g0[j] = gain[8 * fq + j] * scale; g1[j] = gain[32 + 8 * fq + j] * scale; } }
        else {
#pragma unroll
            for (int j = 0; j < 8; ++j) { g0[j] = scale; g1[j] = scale; } }
        const int row0 = u.pm * 256 + wr * 64 + fr + (u.half == 2 ? 128 : 0), col0 = pn * 256 + wc * 64 + 8 * fq;
#pragma unroll
        for (int ai = 0; ai < 2; ++ai) { if (ai == 1 && u.half) continue;
#pragma unroll
         for (int mp = 0; mp < 2; ++mp) {
          pg8::u32x4 cwa[2], swa[2];
          if (mode == 1 || mode == 2) {
#pragma unroll
            for (int mm = 0; mm < 2; ++mm) { const long row = row0 + ai * 128 + (2 * mp + mm) * 16; cwa[mm] = *(const pg8::u32x4*)(CSB + row * 64 + 8 * fq); swa[mm] = *(const pg8::u32x4*)(CSB + row * 64 + 32 + 8 * fq); } }
#pragma unroll
            for (int mm = 0; mm < 2; ++mm) { const int m = 2 * mp + mm; const long row = row0 + ai * 128 + m * 16;
                float a[8], b[8];
#pragma unroll
                for (int j = 0; j < 4; ++j) { a[j] = acc[ai][0][m][0][j]; a[4 + j] = acc[ai][0][m][1][j]; b[j] = acc[ai][1][m][0][j]; b[4 + j] = acc[ai][1][m][1][j]; }
                if (mode == 1 || mode == 2) {
                    float r = 1.f;
                    if (mode == 2) { float ss = 0.f;
#pragma unroll
                        for (int j = 0; j < 8; ++j) ss += a[j] * a[j] + b[j] * b[j];
                        ss += __shfl_xor(ss, 16); ss += __shfl_xor(ss, 32); r = __builtin_amdgcn_rsqf(ss * (1.f / 64.f) + EPS); }
                    const pg8::u32x4 cw = cwa[mm], sw = swa[mm];
#pragma unroll
                    for (int j = 0; j < 8; ++j) { const unsigned cu = cw[j >> 1], su = sw[j >> 1];
                        const float cs = __builtin_bit_cast(float, (j & 1) ? (cu & 0xffff0000u) : (cu << 16)), sn = __builtin_bit_cast(float, (j & 1) ? (su & 0xffff0000u) : (su << 16));
                        const float x1 = a[j] * r * g0[j], x2 = b[j] * r * g1[j];
                        a[j] = x1 * cs - x2 * sn; b[j] = x1 * sn + x2 * cs; } }
                else if (mode == 3) {
#pragma unroll
                    for (int j = 0; j < 8; ++j) { a[j] = silu_fast(a[j]); b[j] = silu_fast(b[j]); } }
                else if (mode == 4) {
#pragma unroll
                    for (int j = 0; j < 8; ++j) { a[j] = gelu_fast(a[j]); b[j] = gelu_fast(b[j]); } }
                pg8::u32x4 wa, wb;
                wa.x = pk_bf16(a[0], a[1]); wa.y = pk_bf16(a[2], a[3]); wa.z = pk_bf16(a[4], a[5]); wa.w = pk_bf16(a[6], a[7]);
                wb.x = pk_bf16(b[0], b[1]); wb.y = pk_bf16(b[2], b[3]); wb.z = pk_bf16(b[4], b[5]); wb.w = pk_bf16(b[6], b[7]);
                *(pg8::u32x4*)(Z + row * ZW + col0) = wa; *(pg8::u32x4*)(Z + row * ZW + col0 + 32) = wb; } } }
    }
};
typedef short s16x4_t __attribute__((ext_vector_type(4)));
typedef float f32x4m __attribute__((ext_vector_type(4)));
#define MFMA16(a, b, c) __builtin_amdgcn_mfma_f32_16x16x32_bf16((a), (b), (c), 0, 0, 0)
constexpr int LP = 144;
__device__ __forceinline__ s16x4_t lds_tr4(LAS const unsigned char* p) { return __builtin_bit_cast(s16x4_t, __builtin_amdgcn_ds_read_tr16_b64_v4i16((LAS s16x4_t*)p)); }
__device__ __forceinline__ s16x8_t tr_frag(LAS const unsigned char* X, int P, int k0, int c0, int lane) {
    const int fq = lane >> 4, q = (lane & 15) >> 2, pp = lane & 3;
    LAS const unsigned char* a = X + (k0 + 8 * fq + q) * P + (c0 + 4 * pp) * 2;
    const s16x4_t lo = lds_tr4(a), hi = lds_tr4(a + 4 * P);
    return (s16x8_t){lo[0], lo[1], lo[2], lo[3], hi[0], hi[1], hi[2], hi[3]};
}
__device__ __forceinline__ s16x8_t tr_frag_perm(LAS const unsigned char* X, int P, int k0, int c0, int lane) {
    const int fq = lane >> 4, q = (lane & 15) >> 2, pp = lane & 3;
    LAS const unsigned char* a = X + (k0 + 4 * fq + q) * P + (c0 + 4 * pp) * 2;
    const s16x4_t lo = lds_tr4(a), hi = lds_tr4(a + 16 * P);
    return (s16x8_t){lo[0], lo[1], lo[2], lo[3], hi[0], hi[1], hi[2], hi[3]};
}
__device__ __forceinline__ s16x8_t pack8(const f32x4m& a, const f32x4m& b) {
    const unsigned w0 = pk_bf16(a[0], a[1]), w1 = pk_bf16(a[2], a[3]), w2 = pk_bf16(b[0], b[1]), w3 = pk_bf16(b[2], b[3]);
    return __builtin_bit_cast(s16x8_t, (u32x4_t){w0, w1, w2, w3});
}
__device__ __forceinline__ float bflo(unsigned u) { return __builtin_bit_cast(float, u << 16); }
__device__ __forceinline__ float bfhi(unsigned u) { return __builtin_bit_cast(float, u & 0xffff0000u); }

struct CmpSched {
    static constexpr bool GATHER = false; static constexpr int GOFF_LDS = 0;
    const P* pp; int l, c;
    __device__ __forceinline__ bool next(int i, pg8::Unit& u) const { if (i > 0 || c >= 32) return false; u.pm = c & 7; u.pn = 0; u.aux = c >> 3; u.half = 0; return true; }
    __device__ __forceinline__ int ktiles() const { return 16; }
    __device__ __forceinline__ const char* a_base() const { return (const char*)(pp->ws + WS_Z); }
    __device__ __forceinline__ size_t a_kstep() const { return (size_t)ZW * 2; }
    __device__ __forceinline__ unsigned a_off(const pg8::Unit& u, int row, int C) const {
        const int R = u.pm * 256 + row, kv = u.aux & 1, g = u.aux >> 1;
        return (unsigned)(((size_t)R * 16 * ZW + (kv ? C_VC : C_KC) + g * 64 + C) * 2); }
    __device__ __forceinline__ unsigned b_ld() const { return 1024 * 2u; }
    __device__ __forceinline__ const char* b_tile(const pg8::Unit& u, int t) const { return (const char*)(pp->ws + WS_CW1_T) + (size_t)(l * 2 + (u.aux & 1)) * 256 * 1024 * 2 + (size_t)t * 128; }
};
struct EpiCmp {
    static constexpr bool PERM = false, AFTER_DRAIN = true;
    const P* pp; int l;
    __device__ __forceinline__ void operator()(const pg8::f32x4 (&)[2][2][4][2], const pg8::Unit&, int, int, int, int) const {}
    __device__ __forceinline__ void fused(const pg8::f32x4 (&acc)[2][2][4][2], const pg8::Unit& u, int wr, int wc, int fr, int fq, LAS unsigned char* lds) const {
        const P& p = *pp; const int kv = u.aux & 1, g = u.aux >> 1, lane = tid_fresh() & 63, w = tid_fresh() >> 6;
        constexpr int HP = 272;
        constexpr int HOFF = 257 * HP;
        const float* bias = WSP(float, WS_PEB) + (l * 2 + kv) * 128;
#pragma unroll
        for (int n = 0; n < 2; ++n) { const int c = 32 * wc + 16 * n + 4 * fq;
#pragma unroll
            for (int ai = 0; ai < 2; ++ai)
#pragma unroll
                for (int m = 0; m < 4; ++m) { const int r = 128 * ai + 64 * wr + 16 * m + fr; const f32x4m v = acc[ai][1][m][n];
                    u32x2_t o; o.x = pk_bf16(v[0], v[1]); o.y = pk_bf16(v[2], v[3]); *(LAS u32x2_t*)(lds + r * HP + c * 2) = o; } }
        if (tid_fresh() < 32) { unsigned zz = 0u; asm volatile("" : "+v"(zz)); *(LAS u32x2_t*)(lds + 256 * HP + tid_fresh() * 8) = (u32x2_t){zz, zz}; }
        __syncthreads();
#pragma unroll
        for (int n = 0; n < 2; ++n) { const int c = 32 * wc + 16 * n + 4 * fq; const f32x4m bv = *(const f32x4m*)(bias + c);
#pragma unroll
            for (int ai = 0; ai < 2; ++ai)
#pragma unroll
                for (int m = 0; m < 4; ++m) { const int r = 128 * ai + 64 * wr + 16 * m + fr; const u32x2_t u1 = *(const LAS u32x2_t*)(lds + (r + 1) * HP + c * 2);
                    const f32x4m v = acc[ai][0][m][n] + bv + (f32x4m){bflo(u1.x), bfhi(u1.x), bflo(u1.y), bfhi(u1.y)};
                    u32x2_t o; o.x = pk_bf16(gelu_fast(v[0]), gelu_fast(v[1])); o.y = pk_bf16(gelu_fast(v[2]), gelu_fast(v[3])); *(LAS u32x2_t*)(lds + HOFF + r * HP + c * 2) = o; } }
        __syncthreads();
        const bf16* W2 = WSP(bf16, WS_CW2_T) + (size_t)(l * 2 + kv) * 64 * 128;
        const float* gk = p.nsa_k_norm_g + (l * 3 + 0) * 64;
#pragma unroll
        for (int rt = 0; rt < 2; ++rt) {
            f32x4m o[4];
#pragma unroll
            for (int ct = 0; ct < 4; ++ct) o[ct] = (f32x4m){0.f, 0.f, 0.f, 0.f};
#pragma unroll
            for (int s = 0; s < 4; ++s) { const s16x8_t a = *(const LAS s16x8_t*)(lds + HOFF + (32 * w + 16 * rt + fr) * HP + (32 * s + 8 * fq) * 2);
#pragma unroll
                for (int ct = 0; ct < 4; ++ct) { const s16x8_t b = *(const s16x8_t*)(W2 + (16 * ct + fr) * 128 + 32 * s + 8 * fq); o[ct] = MFMA16(a, b, o[ct]); } }
            float csv[4][4];
            if (kv == 0) {
#pragma unroll
                for (int reg = 0; reg < 4; ++reg) { const int R = u.pm * 256 + 32 * w + 16 * rt + 4 * fq + reg, b = R >> 7, n = R & 127, nn = n < NCMP ? n : NCMP - 1;
                    const float* cs = WSP(float, WS_CS) + ((size_t)b * NS + 16 * nn + 31) * 64; csv[reg][0] = cs[fr]; csv[reg][1] = cs[32 + fr]; csv[reg][2] = cs[16 + fr]; csv[reg][3] = cs[48 + fr]; } }
#pragma unroll
            for (int reg = 0; reg < 4; ++reg) { const int R = u.pm * 256 + 32 * w + 16 * rt + 4 * fq + reg, b = R >> 7, n = R & 127;
                float v0 = o[0][reg], v1 = o[1][reg], v2 = o[2][reg], v3 = o[3][reg];
                if (kv == 0) { float ss = v0 * v0 + v1 * v1 + v2 * v2 + v3 * v3;
                    ss += __shfl_xor(ss, 1); ss += __shfl_xor(ss, 2); ss += __shfl_xor(ss, 4); ss += __shfl_xor(ss, 8);
                    const float r = 1.0f / sqrtf(ss * (1.f / 64.f) + EPS);
                    v0 *= r * gk[fr]; v1 *= r * gk[16 + fr]; v2 *= r * gk[32 + fr]; v3 *= r * gk[48 + fr];
                    const float c0 = csv[reg][0], s0 = csv[reg][1], c1 = csv[reg][2], s1 = csv[reg][3];
                    const float a0 = v0 * c0 - v2 * s0, a2 = v0 * s0 + v2 * c0, a1 = v1 * c1 - v3 * s1, a3 = v1 * s1 + v3 * c1; v0 = a0; v1 = a1; v2 = a2; v3 = a3; }
                { if (n >= NCMP) { v0 = 0.f; v1 = 0.f; v2 = 0.f; v3 = 0.f; }
                    bf16* dst = (kv ? WSP(bf16, WS_VC) : WSP(bf16, WS_KC)) + ((size_t)(b * 2 + g) * (NCMP + 1) + n) * 64;
                    dst[fr] = f2bf(v0); dst[16 + fr] = f2bf(v1); dst[32 + fr] = f2bf(v2); dst[48 + fr] = f2bf(v3); } }
        }
        __syncthreads();
    }
};
__device__ __forceinline__ void ret_kv_unit(const P& p, LAS unsigned char* lds, int l, int unit) {
    const int tid = tid_fresh(), lane = tid & 63, w = tid >> 6, fr = lane & 15, fq = lane >> 4;
    const int c = unit % NCH, h = (unit / NCH) % 4, b = unit / (NCH * 4);
    const bf16* Z = WSP(bf16, WS_Z); const size_t m0 = (size_t)b * NS + (size_t)c * 128;
    const float lg2 = log2f(1.f - exp2f(-5.f - (float)h));
    LAS unsigned char* KL = lds; LAS unsigned char* VL = lds + 128 * LP;
#pragma unroll
    for (int i = 0; i < 2; ++i) { const int pc = tid + i * NTH, r = pc >> 3, q = pc & 7;
        const u32x4_t kw = *(const u32x4_t*)(Z + (m0 + r) * ZW + C_RK + 64 * h + q * 8), vw = *(const u32x4_t*)(Z + (m0 + r) * ZW + C_RV + 64 * h + q * 8);
        const float dk = exp2f((float)(127 - r) * lg2); u32x4_t ko;
#pragma unroll
        for (int j = 0; j < 4; ++j) ko[j] = pk_bf16(bflo(kw[j]) * dk, bfhi(kw[j]) * dk);
        *(LAS u32x4_t*)(KL + r * LP + q * 16) = ko; *(LAS u32x4_t*)(VL + r * LP + q * 16) = vw; }
    __syncthreads();
    const int et = w >> 1, d0 = 2 * (w & 1);
    f32x4m a0 = {0.f, 0.f, 0.f, 0.f}, a1 = {0.f, 0.f, 0.f, 0.f};
#pragma unroll
    for (int ks = 0; ks < 4; ++ks) { const s16x8_t va = tr_frag(VL, LP, 32 * ks, 16 * et, lane);
        a0 = MFMA16(va, tr_frag(KL, LP, 32 * ks, 16 * d0, lane), a0); a1 = MFMA16(va, tr_frag(KL, LP, 32 * ks, 16 * (d0 + 1), lane), a1); }
    float* KV = WSP(float, WS_KVS) + (size_t)unit * 4096;
#pragma unroll
    for (int reg = 0; reg < 4; ++reg) { const int e = 16 * et + 4 * fq + reg; KV[e * 64 + 16 * d0 + fr] = a0[reg]; KV[e * 64 + 16 * (d0 + 1) + fr] = a1[reg]; }
    __syncthreads();
}

__device__ __forceinline__ void ret_out_unit(const P& p, LAS unsigned char* lds, int l, int unit) {
    const int tid = tid_fresh(), lane = tid & 63, w = tid >> 6, fr = lane & 15, fq = lane >> 4;
    const int c = unit % NCH, h = (unit / NCH) % 4, b = unit / (NCH * 4);
    const bf16* Z = WSP(bf16, WS_Z); bf16* MIX = WSP(bf16, WS_MIX); const size_t m0 = (size_t)b * NS + (size_t)c * 128;
    const float lg2 = log2f(1.f - exp2f(-5.f - (float)h));
    LAS unsigned char* KL = lds; LAS unsigned char* VL = lds + 128 * LP; LAS unsigned char* ST = lds + 256 * LP;
#pragma unroll
    for (int i = 0; i < 2; ++i) { const int pc = tid + i * NTH, r = pc >> 3, q = pc & 7;
        *(LAS u32x4_t*)(KL + r * LP + q * 16) = *(const u32x4_t*)(Z + (m0 + r) * ZW + C_RK + 64 * h + q * 8);
        *(LAS u32x4_t*)(VL + r * LP + q * 16) = *(const u32x4_t*)(Z + (m0 + r) * ZW + C_RV + 64 * h + q * 8); }
    {
        const float lgc = 128.f * lg2; const float* KV = WSP(float, WS_KVS) + (size_t)(unit - c) * 4096 + tid * 8;
        f32x4m s0 = {0.f, 0.f, 0.f, 0.f}, s1 = {0.f, 0.f, 0.f, 0.f};
        f32x4m ld0[NCH - 1], ld1[NCH - 1];
#pragma unroll
        for (int cc = 0; cc < NCH - 1; ++cc) { ld0[cc] = *(const f32x4m*)(KV + (size_t)cc * 4096); ld1[cc] = *(const f32x4m*)(KV + (size_t)cc * 4096 + 4); }
#pragma unroll
        for (int cc = 0; cc < NCH - 1; ++cc) { const float wgt = cc < c ? __builtin_amdgcn_exp2f((float)(c - 1 - cc) * lgc) : 0.f; s0 += ld0[cc] * wgt; s1 += ld1[cc] * wgt; }
        const int e = tid >> 3, d = (tid & 7) * 8; u32x4_t o; o.x = pk_bf16(s0[0], s0[1]); o.y = pk_bf16(s0[2], s0[3]); o.z = pk_bf16(s1[0], s1[1]); o.w = pk_bf16(s1[2], s1[3]);
        *(LAS u32x4_t*)(ST + e * LP + d * 2) = o; }
    __syncthreads();
    const size_t mq = m0 + 16 * w + fr; const int nq = 16 * w + fr;
    s16x8_t qf[2];
#pragma unroll
    for (int s = 0; s < 2; ++s) qf[s] = *(const s16x8_t*)(Z + mq * ZW + C_RQ + 64 * h + 32 * s + 8 * fq);
    f32x4m O[4];
#pragma unroll
    for (int dt = 0; dt < 4; ++dt) O[dt] = (f32x4m){0.f, 0.f, 0.f, 0.f};
    for (int ks = 0; ks <= (w >> 1); ++ks) {
        f32x4m S2[2];
#pragma unroll
        for (int t = 0; t < 2; ++t) { const int kt = 2 * ks + t; f32x4m sacc = {0.f, 0.f, 0.f, 0.f};
#pragma unroll
            for (int s = 0; s < 2; ++s) sacc = MFMA16(*(const LAS s16x8_t*)(KL + (16 * kt + fr) * LP + (32 * s + 8 * fq) * 2), qf[s], sacc);
#pragma unroll
            for (int reg = 0; reg < 4; ++reg) { const int kk = 16 * kt + 4 * fq + reg; sacc[reg] = kk <= nq ? sacc[reg] * __builtin_amdgcn_exp2f((float)(nq - kk) * lg2) : 0.f; }
            S2[t] = sacc; }
        const s16x8_t pf = pack8(S2[0], S2[1]);
#pragma unroll
        for (int dt = 0; dt < 4; ++dt) O[dt] = MFMA16(tr_frag_perm(VL, LP, 32 * ks, 16 * dt, lane), pf, O[dt]);
    }
    { const float dq = exp2f((float)(nq + 1) * lg2);
#pragma unroll
      for (int dt = 0; dt < 4; ++dt) { f32x4m t = {0.f, 0.f, 0.f, 0.f};
#pragma unroll
          for (int s = 0; s < 2; ++s) t = MFMA16(*(const LAS s16x8_t*)(ST + (16 * dt + fr) * LP + (32 * s + 8 * fq) * 2), qf[s], t);
          O[dt] += t * dq; } }
    float ss = 0.f;
#pragma unroll
    for (int dt = 0; dt < 4; ++dt) ss += O[dt][0] * O[dt][0] + O[dt][1] * O[dt][1] + O[dt][2] * O[dt][2] + O[dt][3] * O[dt][3];
    ss += __shfl_xor(ss, 16); ss += __shfl_xor(ss, 32);
    const float r = 1.0f / sqrtf(ss * (1.f / 64.f) + EPS);
    f32x4m gnv[4]; u32x2_t rgv[4];
#pragma unroll
    for (int dt = 0; dt < 4; ++dt) { const int e = 16 * dt + 4 * fq; gnv[dt] = *(const f32x4m*)(p.ret_norm_g + (l * 4 + h) * 64 + e); rgv[dt] = *(const u32x2_t*)(Z + mq * ZW + C_RG + 64 * h + e); }
#pragma unroll
    for (int dt = 0; dt < 4; ++dt) { const int e = 16 * dt + 4 * fq; const f32x4m gn = gnv[dt];
        const u32x2_t rg = rgv[dt];
        u32x2_t o; o.x = pk_bf16(O[dt][0] * r * gn[0] * bflo(rg.x), O[dt][1] * r * gn[1] * bfhi(rg.x)); o.y = pk_bf16(O[dt][2] * r * gn[2] * bflo(rg.y), O[dt][3] * r * gn[3] * bfhi(rg.y));
        *(u32x2_t*)(MIX + mq * D + 64 * h + e) = o; }
    __syncthreads();
}
__device__ __forceinline__ void gmlp_unit(const P& p, LAS unsigned char* lds, int l, int unit) {
    const int tid = tid_fresh(), lane = tid & 63, w = tid >> 6, fr = lane & 15, fq = lane >> 4;
    const bf16* Z = WSP(bf16, WS_Z); bf16* MIX = WSP(bf16, WS_MIX); const size_t m0 = (size_t)unit * 128;
    constexpr int VP = 528;
    { const int r = tid >> 2, q = tid & 3; const bf16* src = Z + (m0 + r) * ZW + C_GV + q * 64;
      u32x4_t v[8]; float s = 0.f;
#pragma unroll
      for (int i = 0; i < 8; ++i) { v[i] = *(const u32x4_t*)(src + i * 8);
#pragma unroll
          for (int j = 0; j < 4; ++j) s += bflo(v[i][j]) + bfhi(v[i][j]); }
      s += __shfl_xor(s, 1); s += __shfl_xor(s, 2); const float mu = s * (1.f / 256.f); float s2 = 0.f;
#pragma unroll
      for (int i = 0; i < 8; ++i)
#pragma unroll
          for (int j = 0; j < 4; ++j) { const float a = bflo(v[i][j]) - mu, b2 = bfhi(v[i][j]) - mu; s2 += a * a + b2 * b2; }
      s2 += __shfl_xor(s2, 1); s2 += __shfl_xor(s2, 2); const float rstd = 1.0f / sqrtf(s2 * (1.f / 256.f) + EPS);
      const float* gl = p.gmlp_ln_g + l * 256 + q * 64;
#pragma unroll
      for (int i = 0; i < 8; ++i) { u32x4_t o;
#pragma unroll
          for (int j = 0; j < 4; ++j) o[j] = pk_bf16((bflo(v[i][j]) - mu) * rstd * gl[i * 8 + 2 * j], (bfhi(v[i][j]) - mu) * rstd * gl[i * 8 + 2 * j + 1]);
          *(LAS u32x4_t*)(lds + r * VP + (q * 64 + i * 8) * 2) = o; } }
    __syncthreads();
    const int t0 = 16 * w, nks = (w >> 1) + 1;
    constexpr int SOFF = 128 * VP;
    LAS unsigned char* ST = lds + SOFF + w * 16 * VP;
    s16x8_t wf[4][4];
#pragma unroll
    for (int g = 0; g < 4; ++g)
#pragma unroll
        for (int ks = 0; ks < 4; ++ks) wf[g][ks] = ks < nks ? *(const s16x8_t*)(WSP(bf16, WS_GWS) + (size_t)(l * 4 + g) * 128 * 128 + (t0 + fr) * 128 + 32 * ks + 8 * fq) : (s16x8_t){0, 0, 0, 0, 0, 0, 0, 0};
    float bsv[4][4];
#pragma unroll
    for (int g = 0; g < 4; ++g)
#pragma unroll
        for (int reg = 0; reg < 4; ++reg) bsv[g][reg] = p.gmlp_b[(l * 4 + g) * 128 + t0 + 4 * fq + reg];
    const int orow = lane >> 2, oseg = lane & 3; u32x4_t uv[8];
#pragma unroll
    for (int k = 0; k < 8; ++k) uv[k] = *(const u32x4_t*)(Z + (m0 + t0 + orow) * ZW + C_GU + 64 * oseg + 8 * k);
#pragma unroll
    for (int g = 0; g < 4; ++g) {
        f32x4m acc[4];
#pragma unroll
        for (int ct = 0; ct < 4; ++ct) acc[ct] = (f32x4m){0.f, 0.f, 0.f, 0.f};
#pragma unroll
        for (int ks = 0; ks < 4; ++ks) { if (ks < nks) {
#pragma unroll
            for (int ct = 0; ct < 4; ++ct) acc[ct] = MFMA16(wf[g][ks], tr_frag(lds, VP, 32 * ks, 64 * g + 16 * ct, lane), acc[ct]); } }
#pragma unroll
        for (int reg = 0; reg < 4; ++reg)
#pragma unroll
            for (int ct = 0; ct < 4; ++ct) *(LAS bf16*)(ST + (4 * fq + reg) * VP + (64 * g + 16 * ct + fr) * 2) = f2bf(acc[ct][reg] + bsv[g][reg]);
    }
#pragma unroll
    for (int k = 0; k < 8; ++k) { const u32x4_t sv = *(const LAS u32x4_t*)(ST + orow * VP + (64 * oseg + 8 * k) * 2); u32x4_t o;
#pragma unroll
        for (int q = 0; q < 4; ++q) o[q] = pk_bf16(bflo(uv[k][q]) * bflo(sv[q]), bfhi(uv[k][q]) * bfhi(sv[q]));
        *(u32x4_t*)(MIX + (m0 + t0 + orow) * D + 256 + 64 * oseg + 8 * k) = o; }
    __syncthreads();
}
__device__ __forceinline__ void premix_phase(const P& p, LAS unsigned char* lds, int l) {
    { CmpSched S; S.pp = &p; S.l = l; S.c = bid_fresh(); EpiCmp E{&p, l}; pg8::gemm_phase(lds, S, E); }
    const int G = grid_fresh(), bx = bid_fresh();
    if (G > 64) { if (bx >= 32) { for (int u = bx - 32; u < NB * 4 * NCH; u += G - 32) ret_kv_unit(p, lds, l, u); for (int u = bx - 32; u < NB * NCH; u += G - 32) gmlp_unit(p, lds, l, u); } }
    else { for (int u = bx; u < NB * 4 * NCH; u += G) ret_kv_unit(p, lds, l, u); for (int u = bx; u < NB * NCH; u += G) gmlp_unit(p, lds, l, u); }
}

__device__ __forceinline__ s16x8_t tr_frag_perm_swz(LAS const unsigned char* X, int k0, int c0, int lane) {
    const int fq = lane >> 4, q = (lane & 15) >> 2, pp = lane & 3, row = k0 + 4 * fq + q, col = c0 + 4 * pp;
    LAS const unsigned char* a = X + row * 128 + ((((col >> 3) ^ (row & 7))) << 4) + (col & 7) * 2;
    const s16x4_t lo = lds_tr4(a), hi = lds_tr4(a + 16 * 128);
    return (s16x8_t){lo[0], lo[1], lo[2], lo[3], hi[0], hi[1], hi[2], hi[3]};
}
constexpr int NSA_KV = 2 * 64 * 128;
constexpr int NSA_IMP = 3 * NSA_KV, NSA_INVL = NSA_IMP + 8 * 8192, NSA_SELM = NSA_INVL + 64 * 4 * 4;
static_assert(NSA_SELM + 256 <= 147456 - 64, "NSA LDS map");
__device__ __forceinline__ void nsa_unit(const P& p, LAS unsigned char* lds, int l, int b, int g, int i) {
    const int tid = tid_fresh(), lane = tid & 63, w = tid >> 6, fr = lane & 15, fq = lane >> 4;
    const bf16* Z = WSP(bf16, WS_Z); bf16* MIX = WSP(bf16, WS_MIX); const float* GL = WSP(float, WS_GL);
    const size_t mb = (size_t)b * NS;
    const int nc = (i >= 16) ? 2 : 1, wlo = i > 8 ? i - 8 : 0, nblk = nc + (i + 1) + (i - wlo + 1);
    LAS float* IMPH = (LAS float*)(lds + NSA_IMP + w * 8192); LAS float* INVL = (LAS float*)(lds + NSA_INVL); LAS unsigned* SELM = (LAS unsigned*)(lds + NSA_SELM);
    LAS f32x4m* OFL = (LAS f32x4m*)(lds + NSA_IMP + w * 8192 + lane * 16);
    int tok[2]; s16x8_t qf[2][2];
#pragma unroll
    for (int qt = 0; qt < 2; ++qt) { tok[qt] = 8 * w + 4 * qt + (fr >> 2);
#pragma unroll
        for (int s = 0; s < 2; ++s) qf[qt][s] = *(const s16x8_t*)(Z + (mb + 64 * i + tok[qt]) * ZW + C_NQ + 64 * (4 * g + (fr & 3)) + 32 * s + 8 * fq); }
    f32x4m O[2][4]; float lsum[2] = {0.f, 0.f}; float carry[2] = {0.f, 0.f}; unsigned selm[2] = {0u, 0u};
#pragma unroll
    for (int qt = 0; qt < 2; ++qt)
#pragma unroll
        for (int dt = 0; dt < 4; ++dt) O[qt][dt] = (f32x4m){0.f, 0.f, 0.f, 0.f};
    const int skey = tid >> 3, spx = (tid & 7) ^ (skey & 7);
    auto kv_ptrs = [&](int it, const bf16*& kp, const bf16*& vp) {
        if (it < nc) { const size_t o = ((size_t)(b * 2 + g) * (NCMP + 1) + 64 * it + skey) * 64 + spx * 8; kp = WSP(bf16, WS_KC) + o; vp = WSP(bf16, WS_VC) + o; }
        else if (it < nc + i + 1) { const size_t o = (mb + 64 * (it - nc) + skey) * ZW + 64 * g + spx * 8; kp = Z + o + C_KS; vp = Z + o + C_VS; }
        else { const size_t o = (mb + 64 * (wlo + it - nc - i - 1) + skey) * ZW + 64 * g + spx * 8; kp = Z + o + C_KW; vp = Z + o + C_VW; } };
    asm volatile("" : "+v"(qf[0][0]), "+v"(qf[0][1]), "+v"(qf[1][0]), "+v"(qf[1][1]));
    float bnd_c = WSP(float, WS_BND)[l * 3 + 0], bnd_s = WSP(float, WS_BND)[l * 3 + 1], bnd_w = WSP(float, WS_BND)[l * 3 + 2];
    asm volatile("" : "+v"(bnd_c), "+v"(bnd_s), "+v"(bnd_w));
#define NSA_DMA(IT, BUF) do { const bf16 *kp_, *vp_; kv_ptrs((IT), kp_, vp_); \
        const unsigned lb_ = (unsigned)__builtin_amdgcn_readfirstlane((int)((unsigned)(size_t)lds + (unsigned)((BUF) * NSA_KV) + (unsigned)w * 1024u)); unsigned sv_; \
        asm volatile("s_mov_b32 %0, m0\n\ts_mov_b32 m0, %3\n\ts_nop 0\n\tglobal_load_lds_dwordx4 %1, off\n\ts_add_u32 m0, m0, 0x2000\n\ts_nop 0\n\tglobal_load_lds_dwordx4 %2, off\n\ts_mov_b32 m0, %0" \
                     : "=&s"(sv_) : "v"(kp_), "v"(vp_), "s"(lb_) : "memory"); } while (0)
    __syncthreads();
    NSA_DMA(0, 0);
    if (nblk > 1) { NSA_DMA(1, 1); asm volatile("s_waitcnt vmcnt(2)" ::: "memory"); } else asm volatile("s_waitcnt vmcnt(0)" ::: "memory");
    __builtin_amdgcn_s_barrier(); asm volatile("" ::: "memory");
    int bufc = 0;
#pragma unroll 1
    for (int it = 0; it < nblk; ++it) {
        const bool dma_now = it + 2 < nblk;
        if (dma_now) { const int bn = bufc == 0 ? 2 : bufc - 1; NSA_DMA(it + 2, bn); }
        LAS const unsigned char* Kb = lds + bufc * NSA_KV; LAS const unsigned char* Vb = Kb + 8192;
        const int br = it < nc ? 0 : (it < nc + i + 1 ? 1 : 2);
        const int j = br == 0 ? it : (br == 1 ? it - nc : wlo + it - nc - i - 1);
        const float bnd = br == 0 ? bnd_c : (br == 1 ? bnd_s : bnd_w);
        const bool needmask = (br == 0) || (j == i) || (br == 2 && j == i - 8);
        const bool lower = (br == 2 && j == i - 8);
        bool rowok[2]; int thr[2]; float oa[2], ob[2];
#pragma unroll
        for (int qt = 0; qt < 2; ++qt) {
            rowok[qt] = (br == 1) ? (((selm[qt] >> j) & 1u) != 0u) : true;
            thr[qt] = (br == 0) ? ((64 * i + tok[qt] - 31) >> 4) - 64 * j : tok[qt];
            const float on = rowok[qt] ? bnd : 1e30f;
            oa[qt] = lower ? 1e30f : on; ob[qt] = lower ? on : 1e30f; }
        const bool act0 = __ballot(rowok[0]) != 0ull, act1 = __ballot(rowok[1]) != 0ull;
        if (act0 || act1) {
            f32x4m pv[2][4];
#pragma unroll
            for (int qt = 0; qt < 2; ++qt)
#pragma unroll
                for (int kt = 0; kt < 4; ++kt) pv[qt][kt] = (f32x4m){0.f, 0.f, 0.f, 0.f};
#pragma unroll
            for (int sI = 0; sI < 2; ++sI) { s16x8_t kf[4];
#pragma unroll
                for (int kt = 0; kt < 4; ++kt) kf[kt] = *(const LAS s16x8_t*)(Kb + (16 * kt + fr) * 128 + (((4 * sI + fq) ^ (fr & 7)) << 4));
#pragma unroll
                for (int kt = 0; kt < 4; ++kt)
#pragma unroll
                    for (int qt = 0; qt < 2; ++qt) pv[qt][kt] = MFMA16(kf[kt], qf[qt][sI], pv[qt][kt]); }
            s16x8_t vf[2][4];
#pragma unroll
            for (int ks = 0; ks < 2; ++ks)
#pragma unroll
                for (int dt = 0; dt < 4; ++dt) vf[ks][dt] = tr_frag_perm_swz(Vb, 32 * ks, 16 * dt, lane);
#pragma unroll
            for (int qt = 0; qt < 2; ++qt) {
                if (needmask) {
#pragma unroll
                    for (int kt = 0; kt < 4; ++kt)
#pragma unroll
                        for (int reg = 0; reg < 4; ++reg) { const int kk = 16 * kt + 4 * fq + reg; const float off = kk <= thr[qt] ? oa[qt] : ob[qt];
                            pv[qt][kt][reg] = __builtin_amdgcn_exp2f(pv[qt][kt][reg] * 1.4426950408889634f - off); lsum[qt] += pv[qt][kt][reg]; } }
                else {
#pragma unroll
                    for (int kt = 0; kt < 4; ++kt)
#pragma unroll
                        for (int reg = 0; reg < 4; ++reg) { pv[qt][kt][reg] = __builtin_amdgcn_exp2f(pv[qt][kt][reg] * 1.4426950408889634f - oa[qt]); lsum[qt] += pv[qt][kt][reg]; } }
                if (br == 0) {
                    const int src = (lane + 48) & 63;
#pragma unroll
                    for (int kt = 0; kt < 4; ++kt) { const float a4 = pv[qt][kt][0] + pv[qt][kt][1] + pv[qt][kt][2] + pv[qt][kt][3];
                        const float xs = __shfl(pv[qt][kt][3], src), xp = __shfl(kt == 0 ? carry[qt] : pv[qt][kt > 0 ? kt - 1 : 0][3], src);
                        IMPH[((4 * qt + (fr >> 2)) * 4 + (fr & 3)) * 32 + 16 * j + 4 * kt + fq] = a4 + (fq == 0 ? xp : xs); }
                    carry[qt] = pv[qt][3][3]; }
                const s16x8_t pfa = pack8(pv[qt][0], pv[qt][1]), pfb = pack8(pv[qt][2], pv[qt][3]);
#pragma unroll
                for (int dt = 0; dt < 4; ++dt) O[qt][dt] = MFMA16(vf[0][dt], pfa, O[qt][dt]);
#pragma unroll
                for (int dt = 0; dt < 4; ++dt) O[qt][dt] = MFMA16(vf[1][dt], pfb, O[qt][dt]);
                __builtin_amdgcn_sched_barrier(0);
            }
        }
        const bool bend = (it == nc - 1) || (it == nc + i) || (it == nblk - 1);
        if (bend) {
            float scl[2];
#pragma unroll
            for (int qt = 0; qt < 2; ++qt) { float ls = lsum[qt]; ls += __shfl_xor(ls, 16); ls += __shfl_xor(ls, 32);
                const float inv = ls > 0.f ? 1.0f / ls : 0.f;
                const float gate = 1.0f / (1.0f + __expf(-GL[(mb + 64 * i + tok[qt]) * 24 + (4 * g + (fr & 3)) * 3 + br]));
                scl[qt] = gate * inv; lsum[qt] = 0.f;
                if (br == 0 && fq == 0) INVL[tok[qt] * 4 + (fr & 3)] = inv; }
            if (br == 0) {
#pragma unroll 1
                for (int rnd = 0; rnd < 4; ++rnd) { const int tk = 8 * w + 2 * rnd + (lane >> 5), jj = lane & 31;
                    const bool forced = (jj == 0) || (jj == i) || (jj == i - 1);
                    float sc = -1.f;
                    if (jj <= i) { sc = 0.f;
#pragma unroll
                        for (int r = 0; r < 4; ++r) sc += IMPH[((2 * rnd + (lane >> 5)) * 4 + r) * 32 + jj] * INVL[tk * 4 + r]; }
                    if (forced) sc = 1e4f;
                    int rank = 0;
#pragma unroll
                    for (int d = 1; d < 32; ++d) { const int oj = (jj + d) & 31; const float o = __shfl(sc, (lane & 32) | oj); rank += (o > sc || (o == sc && oj < jj)) ? 1 : 0; }
                    const unsigned long long bal = __ballot(rank < 8);
                    if (lane == 0) { SELM[8 * w + 2 * rnd] = (unsigned)bal; SELM[8 * w + 2 * rnd + 1] = (unsigned)(bal >> 32); } }
                selm[0] = SELM[tok[0]]; selm[1] = SELM[tok[1]];
            }
#pragma unroll
            for (int qt = 0; qt < 2; ++qt)
#pragma unroll
                for (int dt = 0; dt < 4; ++dt) { const f32x4m prev = br == 0 ? (f32x4m){0.f, 0.f, 0.f, 0.f} : OFL[(qt * 4 + dt) * 64]; OFL[(qt * 4 + dt) * 64] = prev + O[qt][dt] * scl[qt]; O[qt][dt] = (f32x4m){0.f, 0.f, 0.f, 0.f}; }
        }
        if (dma_now) asm volatile("s_waitcnt vmcnt(2)" ::: "memory"); else asm volatile("s_waitcnt vmcnt(0)" ::: "memory");
        asm volatile("s_waitcnt lgkmcnt(0)" ::: "memory");
        __builtin_amdgcn_s_barrier(); asm volatile("" ::: "memory");
        bufc = bufc == 2 ? 0 : bufc + 1;
    }
#undef NSA_DMA
#pragma unroll
    for (int qt = 0; qt < 2; ++qt)
#pragma unroll
        for (int dt = 0; dt < 4; ++dt) { const f32x4m of = OFL[(qt * 4 + dt) * 64]; u32x2_t o; o.x = pk_bf16(of[0], of[1]); o.y = pk_bf16(of[2], of[3]);
            *(u32x2_t*)(MIX + (mb + 64 * i + tok[qt]) * D + 512 + 64 * (4 * g + (fr & 3)) + 16 * dt + 4 * fq) = o; }
}
__device__ __forceinline__ void nsa_units(const P& p, LAS unsigned char* lds, int l, int vcu, int G) {
    for (int u = vcu; u < NB * 2 * NSEL; u += G) { const int k = u >> 8, v = u & 255, bg = v >> 3, r8 = v & 7;
        const int i = k == 0 ? 31 - r8 : (k == 1 ? 16 + r8 : (k == 2 ? 15 - r8 : r8));
        nsa_unit(p, lds, l, bg >> 1, bg & 1, i); }
}
constexpr int MOE_TAB = 131072;
constexpr size_t WS_ACT = WS_Z;
static_assert((size_t)(M + 24 * 256) * 1024 * 2 <= (size_t)M * ZW * 2, "ACT must fit inside Z");
__device__ __forceinline__ void moe_table(const P& p, LAS unsigned char* lds, int l) {
    LAS int* tab = LDSP(int, MOE_TAB);
    if (tid_fresh() == 0) { int acc = 0; for (int c = 0; c < 24; ++c) { const int n = WSP(int, WS_CTL)[CW_CNT + l * 64 + c]; tab[c] = acc; tab[25 + c] = n; acc += (n + 255) >> 8; } tab[24] = acc; }
    __syncthreads();
}
__device__ __forceinline__ void pair_experts(int cls, int& ea, int& eb) { const int g = cls / 6, pr = cls % 6; const int lo = pr < 3 ? 0 : (pr < 5 ? 1 : 2), hi = pr < 3 ? pr + 1 : (pr < 5 ? pr - 1 : 3); ea = g * 4 + lo; eb = g * 4 + hi; }
template <int NPN> struct MoeSchedBase {
    const P* pp; LAS int* tab; int l, G, c;
    __device__ __forceinline__ bool next(int i, pg8::Unit& u) const {
        int L, hf; if (!pg8::deal_unit(i, G, c, tab[24] * NPN, L, hf)) return false; u.half = hf;
        const int rt = L / NPN; int cls = 0;
        for (int k = 1; k < 24; ++k) cls = (tab[k] <= rt) ? k : cls;
        while (tab[25 + cls] == 0 && cls > 0) --cls;
        u.pm = rt; u.pn = L % NPN; u.aux = cls | ((rt - tab[cls]) << 8); return true;
    }
};
struct MoeSchedA : MoeSchedBase<8> {
    static constexpr bool GATHER = true; static constexpr int GOFF_LDS = MOE_TAB + 1024;
    __device__ __forceinline__ int ktiles() const { return D / 64; }
    __device__ __forceinline__ size_t a_kstep() const { return 128; }
    __device__ __forceinline__ const char* a_base() const { return (const char*)(pp->ws + WS_H); }
    __device__ __forceinline__ unsigned a_off(const pg8::Unit& u, int row, int C) const {
        const P& p = *pp; const int cls = u.aux & 255, slot = (u.aux >> 8) * 256 + row, n = tab[25 + cls];
        const int tok = WSP(int, WS_CTOK)[(size_t)cls * M + (slot < n ? slot : 0)];
        return (unsigned)(tok * D + C) * 2u; }
    __device__ __forceinline__ unsigned b_ld() const { return D * 2u; }
    __device__ __forceinline__ const char* b_tile(const pg8::Unit& u, int t) const {
        int ea, eb; pair_experts(u.aux & 255, ea, eb); const int e = u.pn < 4 ? ea : eb;
        return (const char*)(pp->ws + WS_WGU_T) + ((size_t)(l * 16 + e) * 1024 + (size_t)(u.pn & 3) * 256) * D * 2 + (size_t)t * 128; }
};
struct MoeSchedB : MoeSchedBase<4> {
    static constexpr bool GATHER = false; static constexpr int GOFF_LDS = 0;
    __device__ __forceinline__ int ktiles() const { return 16; }
    __device__ __forceinline__ size_t a_kstep() const { return 128; }
    __device__ __forceinline__ const char* a_base() const { return (const char*)(pp->ws + WS_ACT); }
    __device__ __forceinline__ unsigned a_off(const pg8::Unit& u, int row, int C) const { return (unsigned)((u.pm * 256 + row) * 1024 + C) * 2u; }
    __device__ __forceinline__ unsigned b_ld() const { return 512 * 2u; }
    __device__ __forceinline__ const char* b_tile(const pg8::Unit& u, int t) const {
        int ea, eb; pair_experts(u.aux & 255, ea, eb); const int e = t < 8 ? ea : eb;
        return (const char*)(pp->ws + WS_WD_T) + ((size_t)(l * 16 + e) * D + (size_t)u.pn * 256) * 512 * 2 + (size_t)(t & 7) * 128; }
};
struct EpiMoeA {
    static constexpr bool PERM = true, AFTER_DRAIN = false;
    const P* pp; LAS int* tab;
    __device__ __forceinline__ void operator()(const pg8::f32x4 (&acc)[2][2][4][2], const pg8::Unit& u, int wr, int wc, int fr, int fq) const {
        const P& p = *pp; const int cls = u.aux & 255, s0 = (u.aux >> 8) * 256, n = tab[25 + cls], which = u.pn >> 2;
        bf16* O = WSP(bf16, WS_ACT);
        float wts[2][4];
#pragma unroll
        for (int ai = 0; ai < 2; ++ai)
#pragma unroll
            for (int m = 0; m < 4; ++m) { const int slot = s0 + (u.half ? 0 : ai * 128) + wr * 64 + m * 16 + fr + (u.half == 2 ? 128 : 0); wts[ai][m] = slot < n ? WSP(float, WS_CWT)[((size_t)cls * M + slot) * 2 + which] : 0.f; }
#pragma unroll
        for (int ai = 0; ai < 2; ++ai)
#pragma unroll
            for (int m = 0; m < 4; ++m) { if (ai == 1 && u.half) continue; const int r = ai * 128 + wr * 64 + m * 16 + fr + (u.half == 2 ? 128 : 0);
                const float w = wts[ai][m];
                const pg8::f32x4 g0 = acc[ai][0][m][0], g1 = acc[ai][0][m][1], u0 = acc[ai][1][m][0], u1 = acc[ai][1][m][1];
                float v[8];
#pragma unroll
                for (int j = 0; j < 4; ++j) { v[j] = w * silu_fast(g0[j]) * u0[j]; v[4 + j] = w * silu_fast(g1[j]) * u1[j]; }
                pg8::u32x4 o; o.x = pk_bf16(v[0], v[1]); o.y = pk_bf16(v[2], v[3]); o.z = pk_bf16(v[4], v[5]); o.w = pk_bf16(v[6], v[7]);
                *(pg8::u32x4*)(O + (size_t)(u.pm * 256 + r) * 1024 + u.pn * 128 + wc * 32 + 8 * fq) = o; }
    }
};
struct EpiMoeB {
    static constexpr bool PERM = true, AFTER_DRAIN = false;
    const P* pp; LAS int* tab; int l; bool dry; const bf16* xin; void* xout; bool obf;
    __device__ __forceinline__ void operator()(const pg8::f32x4 (&acc)[2][2][4][2], const pg8::Unit& u, int wr, int wc, int fr, int fq) const {
        const P& p = *pp; const int cls = u.aux & 255, s0 = (u.aux >> 8) * 256, n = dry ? 0 : tab[25 + cls], col0 = u.pn * 256 + wc * 32 + 8 * fq;
        int toks[2][4];
#pragma unroll
        for (int ai = 0; ai < 2; ++ai)
#pragma unroll
            for (int m = 0; m < 4; ++m) { const int slot = s0 + (u.half ? 0 : ai * 128) + wr * 64 + m * 16 + fr + (u.half == 2 ? 128 : 0); toks[ai][m] = slot < n ? WSP(int, WS_CTOK)[(size_t)cls * M + slot] : -1; }
#pragma unroll
        for (int ai = 0; ai < 2; ++ai) { if (ai == 1 && u.half) continue;
#pragma unroll
            for (int mp = 0; mp < 2; ++mp) {
                pg8::u32x4 xw[2][2]; pg8::f32x4 ga[2][2], gb[2][2];
#pragma unroll
                for (int mm = 0; mm < 2; ++mm) { const int tok = toks[ai][2 * mp + mm], tk = tok < 0 ? 0 : tok;
                    const float* gp = WSP(float, WS_MOD) + ((size_t)l * NB + tk / NS) * 6144 + 5120 + col0; const size_t ro = (size_t)tk * D + col0;
#pragma unroll
                    for (int bj = 0; bj < 2; ++bj) { xw[mm][bj] = *(const pg8::u32x4*)(xin + ro + bj * 128); ga[mm][bj] = *(const pg8::f32x4*)(gp + bj * 128); gb[mm][bj] = *(const pg8::f32x4*)(gp + bj * 128 + 4); } }
#pragma unroll
                for (int mm = 0; mm < 2; ++mm) { const int m = 2 * mp + mm, tok = toks[ai][m]; if (tok < 0) continue; const size_t ro = (size_t)tok * D + col0;
#pragma unroll
                    for (int bj = 0; bj < 2; ++bj) { const pg8::u32x4 w = xw[mm][bj];
                        pg8::f32x4 x0 = {__builtin_bit_cast(float, w.x << 16), __builtin_bit_cast(float, w.x & 0xffff0000u), __builtin_bit_cast(float, w.y << 16), __builtin_bit_cast(float, w.y & 0xffff0000u)};
                        pg8::f32x4 x1 = {__builtin_bit_cast(float, w.z << 16), __builtin_bit_cast(float, w.z & 0xffff0000u), __builtin_bit_cast(float, w.w << 16), __builtin_bit_cast(float, w.w & 0xffff0000u)};
                        x0 += ga[mm][bj] * acc[ai][bj][m][0]; x1 += gb[mm][bj] * acc[ai][bj][m][1];
                        if (obf) { pg8::u32x4 o; o.x = pk_bf16(x0[0], x0[1]); o.y = pk_bf16(x0[2], x0[3]); o.z = pk_bf16(x1[0], x1[1]); o.w = pk_bf16(x1[2], x1[3]); *(pg8::u32x4*)((bf16*)xout + ro + bj * 128) = o; }
                        else { *(pg8::f32x4*)((float*)xout + ro + bj * 128) = x0; *(pg8::f32x4*)((float*)xout + ro + bj * 128 + 4) = x1; } } } } }
    }
};
__device__ __forceinline__ void moe_a_phase(const P& p, LAS unsigned char* lds, int l) {
    moe_table(p, lds, l);
    MoeSchedA S; S.pp = &p; S.tab = LDSP(int, MOE_TAB); S.l = l; S.G = grid_fresh(); S.c = bid_fresh();
    EpiMoeA E{&p, LDSP(int, MOE_TAB)}; pg8::gemm_phase(lds, S, E);
}
__device__ __forceinline__ void moe_b_phase(const P& p, LAS unsigned char* lds, int l, bool dry = false, void* xout = nullptr, int obf = -1) {
    if (!xout) xout = p.out;
    if (obf < 0) obf = (l + 1 < NL);
    moe_table(p, lds, l);
    MoeSchedB S; S.pp = &p; S.tab = LDSP(int, MOE_TAB); S.l = l; S.G = grid_fresh(); S.c = bid_fresh();
    EpiMoeB E{&p, LDSP(int, MOE_TAB), l, dry, WSP(bf16, WS_XB), xout, obf != 0}; pg8::gemm_phase(lds, S, E);
}
constexpr int LDS_BYTES = 147456;
struct Args { P p; };
typedef const __attribute__((address_space(4))) P* KargP;
__device__ __forceinline__ KargP p_fresh() { KargP k = (KargP)__builtin_amdgcn_kernarg_segment_ptr(); asm volatile("" : "+s"(k)); return k; }
__device__ __forceinline__ P load_p() { KargP k = p_fresh(); P q; const void* const __attribute__((address_space(4)))* src = (const void* const __attribute__((address_space(4)))*)k; const void** dst = (const void**)&q;
#pragma unroll
    for (int i = 0; i < (int)(sizeof(P) / sizeof(void*)); ++i) dst[i] = src[i];
    return q; }
#define LAYER_BODY(l) do { \
        { const P p = load_p(); norm_phase(p, lds, l ? (const void*)p.out : (const void*)p.x, l != 0, l, 0); } \
        GRID_BAR(); \
        { const P p = load_p(); pg8::StaticSched S; S.init(WSP(bf16, WS_H), WSP(bf16, WS_WIN_T) + (size_t)l * ZW * D, M, ZW, D, grid_fresh(), bid_fresh()); EpiZ E{&p, l}; pg8::gemm_phase(lds, S, E); gl_tail(p, l); } \
        GRID_BAR(); \
        { const P p = load_p(); premix_phase(p, lds, l); } \
        GRID_BAR(); \
        { const P p = load_p(); { const int G_ = grid_fresh(), bx_ = bid_fresh(); nsa_units(p, lds, l, (G_ & 7) == 0 ? (bx_ & 7) * (G_ >> 3) + (bx_ >> 3) : bx_, G_); } }        \
        { const P p = load_p(); for (int u = bid_fresh(); u < NB * 4 * NCH; u += grid_fresh()) ret_out_unit(p, lds, l, u); } \
        GRID_BAR(); \
        { const P p = load_p(); pg8::StaticSched S; S.init(WSP(bf16, WS_MIX), WSP(bf16, WS_WOUT_T) + (size_t)l * D * D, M, D, D, grid_fresh(), bid_fresh()); \
          pg8::EpiResidual E{l ? (const void*)p.out : (const void*)p.x, l != 0, WSP(bf16, WS_XB), WSP(float, WS_MOD) + (size_t)l * NB * 6144 + 2048}; pg8::gemm_phase(lds, S, E); } \
        GRID_BAR(); \
        { const P p = load_p(); norm_phase(p, lds, WSP(bf16, WS_XB), true, l, 1); } \
        GRID_BAR(); \
        { const P p = load_p(); moe_a_phase(p, lds, l); } \
        GRID_BAR(); \
        { const P p = load_p(); moe_b_phase(p, lds, l); } \
} while (0)
__global__ void __launch_bounds__(NTH, 2) fwd_kernel(Args a) {
    extern __shared__ __attribute__((aligned(16))) unsigned char lds_raw[];
    LAS unsigned char* lds = (LAS unsigned char*)lds_raw;
    volatile LAS unsigned* MISC = (volatile LAS unsigned*)(lds + LDS_BYTES - 64);
    if (threadIdx.x < 16) MISC[threadIdx.x] = 0u;
    __syncthreads();
    (void)xcd_barrier_post((unsigned*)(a.p.ws + WS_CTL) + CW_BAR, MISC);
#define GRID_BAR() do { XcdBarrier bar_; bar_.bar = (unsigned*)(load_p().ws + WS_CTL) + CW_BAR; bar_.x = xb_xcc_id(); bar_.st = (volatile LAS unsigned*)(lds + LDS_BYTES - 64); xcd_barrier(bar_); } while (0)
    { const P p = load_p(); p0_prologue(p, lds); }
    GRID_BAR();
    LAYER_BODY(0);
    GRID_BAR();
    LAYER_BODY(1);
}
extern "C" void kernel_launch(void* const* d_in, const int* in_sizes, int n_in, void* d_out, int out_size, void* d_ws, size_t ws_size, hipStream_t stream) {
    static int grid = 0;
    if (grid == 0) {
        int dev = 0, cus = 0, per_cu = 0;
        if (n_in != 26 || out_size != M * D || ws_size < WS_END) { fprintf(stderr, "kernel_launch: unexpected shapes (n_in %d out %d ws %zu need %zu)\n", n_in, out_size, ws_size, (size_t)WS_END); grid = -1; return; }
        if (hipGetDevice(&dev) != hipSuccess || hipDeviceGetAttribute(&cus, hipDeviceAttributeMultiprocessorCount, dev) != hipSuccess) { grid = -1; return; }
        if (hipFuncSetAttribute((const void*)fwd_kernel, hipFuncAttributeMaxDynamicSharedMemorySize, LDS_BYTES) != hipSuccess) { fprintf(stderr, "kernel_launch: hipFuncSetAttribute failed\n"); grid = -1; return; }
        if (hipOccupancyMaxActiveBlocksPerMultiprocessor(&per_cu, (const void*)fwd_kernel, NTH, LDS_BYTES) != hipSuccess || per_cu < 1) { fprintf(stderr, "kernel_launch: occupancy query reports %d workgroups per CU\n", per_cu); per_cu = 1; }
        (void)hipGetLastError();
        grid = cus;
    }
    if (grid < 0) return;
    (void)hipMemsetAsync((char*)d_ws + WS_CTL, 0, 1u << 20, stream);
    Args a{};
    const void** pp = (const void**)&a.p;
    for (int i = 0; i < 26; ++i) pp[i] = d_in[i];
    a.p.out = (float*)d_out; a.p.ws = (unsigned char*)d_ws;
    hipLaunchKernelGGL(fwd_kernel, dim3(grid), dim3(NTH), LDS_BYTES, stream, a);
}
```

```cpp
#include <hip/hip_runtime.h>
#include <cstdio>
#include <cstdint>
#define HD __device__ __attribute__((always_inline))
__device__ __forceinline__ int tid_fresh() { int t = threadIdx.x; asm volatile("" : "+v"(t)); return t; }
__device__ __forceinline__ int bid_fresh() { int t = blockIdx.x; asm volatile("" : "+s"(t)); return t; }
__device__ __forceinline__ int grid_fresh() { int t = gridDim.x; asm volatile("" : "+s"(t)); return t; }
#ifndef CFG_B
#define CFG_B 16
#endif
#ifndef CFG_S
#define CFG_S 2048
#endif
constexpr int NB = CFG_B, NS = CFG_S, M = NB * NS, D = 1024, NIN = 2840, ZW = 2816, NL = 2;
constexpr int C_RQ = 0, C_RK = 256, C_RV = 512, C_RG = 768, C_GU = 1024, C_GV = 1280, C_NQ = 1536, C_KC = 2048, C_VC = 2176,
              C_KS = 2304, C_VS = 2432, C_KW = 2560, C_VW = 2688;
constexpr int NCMP = NS / 16 - 1, NSEL = NS / 64, NCH = NS / 128;
constexpr float EPS = 1e-6f;

typedef unsigned short bf16;
HD inline bf16 f2bf(float f) { unsigned u = __builtin_bit_cast(unsigned, f); u += 0x7FFFu + ((u >> 16) & 1u); return (bf16)(u >> 16); }
HD inline float bf2f(bf16 b) { return __builtin_bit_cast(float, ((unsigned)b) << 16); }
HD inline float silu_f(float x) { return x / (1.f + expf(-x)); }
HD inline float sigm_f(float x) { return 1.f / (1.f + expf(-x)); }
HD inline float gelu_f(float x) { return 0.5f * x * (1.f + tanhf(0.7978845608028654f * (x + 0.044715f * x * x * x))); }
#ifndef HOST_EMU
__device__ __forceinline__ float gelu_fast(float x) { const float u = 1.5957691216057308f * (x + 0.044715f * x * x * x); return x * __builtin_amdgcn_rcpf(1.f + __expf(-u)); }
__device__ __forceinline__ float silu_fast(float x) { return x * __builtin_amdgcn_rcpf(1.f + __expf(-x)); }
#endif
HD inline float invfreq(int i) { return exp2f(-(float)i * (13.287712379549449f / 32.f)); }

constexpr size_t MiB = 1u << 20;
constexpr size_t al(size_t x) { return (x + 255) & ~(size_t)255; }
constexpr size_t WS_CTL = 0;
constexpr int CW_BAR = 4096, CW_CNT = 16384;
constexpr size_t WS_MOD = 1 * MiB;
constexpr size_t WS_RS = WS_MOD + al((size_t)NL * NB * 6144 * 4);
constexpr size_t WS_GL = WS_RS + al((size_t)M * 4);
constexpr size_t WS_LOG = WS_GL + al((size_t)M * 24 * 4);
constexpr size_t WS_ROUT = WS_LOG + al((size_t)M * 16 * 4);
constexpr size_t WS_KC = WS_ROUT + al((size_t)M * 16);
constexpr size_t WS_VC = WS_KC + al((size_t)NB * 2 * (NCMP + 1) * 64 * 2);
constexpr size_t WS_HID = WS_VC + al((size_t)NB * 2 * (NCMP + 1) * 64 * 2);
constexpr size_t WS_CRAW = WS_HID + al((size_t)NB * NCMP * 4 * 128 * 4);
constexpr size_t WS_SEL = WS_CRAW + al((size_t)NB * NCMP * 4 * 64 * 4);
constexpr size_t WS_CS = WS_SEL + al((size_t)M * 16 * 4);
constexpr size_t WS_CSB = WS_CS + al((size_t)M * 64 * 4);
constexpr size_t WS_PEB = WS_CSB + al((size_t)M * 64 * 2);
constexpr size_t WS_BND = WS_PEB + 4096;
constexpr size_t WS_KVS = WS_BND + 256;
constexpr size_t WS_CTOK = WS_KVS + al((size_t)NB * 4 * NCH * 4096 * 4);
constexpr size_t WS_CWT = WS_CTOK + al((size_t)24 * M * 4);
constexpr size_t WS_WIN_T = WS_CWT + al((size_t)24 * M * 8);
constexpr size_t WS_WGL_T = WS_WIN_T + al((size_t)NL * ZW * D * 2);
constexpr size_t WS_WOUT_T = WS_WGL_T + al((size_t)NL * 32 * D * 2);
constexpr size_t WS_WGU_T = WS_WOUT_T + al((size_t)NL * D * D * 2);
constexpr size_t WS_WD_T = WS_WGU_T + al((size_t)NL * 16 * 1024 * D * 2);
constexpr size_t WS_CW1_T = WS_WD_T + al((size_t)NL * 16 * D * 512 * 2);
constexpr size_t WS_CW2_T = WS_CW1_T + al((size_t)NL * 2 * 256 * 1024 * 2);
constexpr size_t WS_GWS = WS_CW2_T + al((size_t)NL * 2 * 64 * 128 * 2);
constexpr size_t WS_H = al(WS_GWS + (size_t)NL * 4 * 128 * 128 * 2);
constexpr size_t WS_Z = WS_H + al((size_t)M * D * 2);
constexpr size_t WS_XB = WS_Z + 88 * MiB;
constexpr size_t WS_MIX = WS_Z + al((size_t)M * ZW * 2);
constexpr size_t WS_END = WS_MIX + al((size_t)M * D * 2);
constexpr size_t WS_PB = WS_END;
constexpr size_t WS_END_NAIVE = WS_PB + al((size_t)M * 2 * 128 * 4);
constexpr size_t WS_YN = WS_H;
constexpr size_t WS_ACTN = WS_Z;
static_assert(WS_XB + (size_t)M * D * 2 <= WS_Z + (size_t)M * ZW * 2, "XB must fit in Z above ACT");
static_assert(CFG_B != 16 || CFG_S != 2048 || WS_END <= 512 * MiB, "workspace map exceeds 512 MiB");

struct P {
    const float *x, *c; const int* pos;
    const float *ada_w, *ada_b, *norm_mix_g, *norm_ffn_g, *w_in, *w_out, *ret_norm_g, *gmlp_ln_g, *gmlp_ws, *gmlp_b, *nsa_q_norm_g, *nsa_k_norm_g,
        *cmp_pe_k, *cmp_pe_v, *cmp_w1_k, *cmp_w2_k, *cmp_w1_v, *cmp_w2_v, *router_w, *router_b, *moe_w_gate, *moe_w_up, *moe_w_down;
    float* out; unsigned char* ws;
};
struct Rout { int e0, e1; float w0, w1; };

#define WSP(T, off) ((T*)(p.ws + (off)))

#define XB_TMO      128
#define XB_XCNT(j)  (256  + 64 * (j))
#define XB_XSUB(j)  (1280 + 64 * (j))
#define XB_XGEN(j)  (2304 + 64 * (j))
#define XB_TOP      3328
#define XB_TOPGEN   3392
#define XCD_BAR_WORDS 3456
#ifndef XB_SPIN_CAP
#define XB_SPIN_CAP (1u << 15)
#endif
#define LAS __attribute__((address_space(3)))
__device__ __forceinline__ unsigned xb_ld(unsigned* p)              { return __hip_atomic_load(p, __ATOMIC_RELAXED, __HIP_MEMORY_SCOPE_AGENT); }
__device__ __forceinline__ unsigned xb_add(unsigned* p, unsigned v) { return __hip_atomic_fetch_add(p, v, __ATOMIC_RELAXED, __HIP_MEMORY_SCOPE_AGENT); }
__device__ __forceinline__ unsigned xb_xcc_id() { return (unsigned)__builtin_amdgcn_s_getreg((3 << 11) | 20) & 0xFu; }
#define XB_SPIN(cond, bar) do { unsigned _sp = 0; while (cond) { __builtin_amdgcn_s_sleep(1); \
    if ((++_sp & 255u) == 0u) { if (xb_ld(&(bar)[XB_TMO])) break; if (_sp > XB_SPIN_CAP) { atomicAdd(&(bar)[XB_TMO], 1u); break; } } } } while (0)
struct XcdBarrier { unsigned* bar; unsigned x; volatile LAS unsigned* st; };
__device__ __forceinline__ XcdBarrier xcd_barrier_post(unsigned* bar, volatile LAS unsigned* st) {
    XcdBarrier b; b.bar = bar; b.x = xb_xcc_id(); b.st = st;
    if (threadIdx.x == 0) (void)xb_add(&bar[XB_XCNT(b.x)], 1u);
    return b;
}
__device__ __forceinline__ void xcd_barrier_complete(unsigned* bar, unsigned x, unsigned& nloc, unsigned& nx) {
    const unsigned G = gridDim.x * gridDim.y * gridDim.z;
    unsigned sum, cnt, mine, sp = 0u;
    for (;;) {
        sum = 0u; cnt = 0u; mine = 0u;
#pragma unroll
        for (unsigned j = 0; j < 16; ++j) { const unsigned c = xb_ld(&bar[XB_XCNT(j)]); sum += c; cnt += (c > 0u) ? 1u : 0u; mine = (j == x) ? c : mine; }
        if (sum == G) break;
        __builtin_amdgcn_s_sleep(1);
        if ((++sp & 255u) == 0u) { if (xb_ld(&bar[XB_TMO])) break; if (sp > XB_SPIN_CAP) { atomicAdd(&bar[XB_TMO], 1u); break; } }
    }
    nloc = mine > 0u ? mine : 1u; nx = cnt > 0u ? cnt : 1u;
}
__device__ __forceinline__ void xcd_barrier(const XcdBarrier& b) {
    asm volatile("s_waitcnt vmcnt(0)" ::: "memory");
    __syncthreads();
    if (threadIdx.x == 0) {
        unsigned* bar = b.bar;
        __builtin_amdgcn_s_waitcnt(0);
        unsigned nloc = b.st[0], nx = b.st[1];
        if (nloc == 0u) { xcd_barrier_complete(bar, b.x, nloc, nx); b.st[0] = nloc; b.st[1] = nx; }
        const unsigned old = xb_add(&bar[XB_XSUB(b.x)], 1u);
        const unsigned gen = old / nloc;
        if (old + 1u == (gen + 1u) * nloc) {
            __builtin_amdgcn_fence(__ATOMIC_RELEASE, "agent");
            asm volatile("s_waitcnt vmcnt(0)" ::: "memory");
            const unsigned og = xb_add(&bar[XB_TOP], 1u);
            const unsigned tg = og / nx;
            if (og + 1u == (tg + 1u) * nx) xb_add(&bar[XB_TOPGEN], 1u);
            else XB_SPIN(xb_ld(&bar[XB_TOPGEN]) == tg, bar);
            __builtin_amdgcn_fence(__ATOMIC_ACQUIRE, "agent");
            xb_add(&bar[XB_XGEN(b.x)], 1u);
            asm volatile("s_waitcnt vmcnt(0)" ::: "memory");
        } else {
            XB_SPIN(xb_ld(&bar[XB_XGEN(b.x)]) == gen, bar);
            __builtin_amdgcn_fence(__ATOMIC_ACQUIRE, "agent");
            asm volatile("s_waitcnt vmcnt(0)" ::: "memory");
        }
    }
    __syncthreads();
}
namespace pg8 {
#define PG8_LAS __attribute__((address_space(3)))
typedef short bf16x8 __attribute__((ext_vector_type(8)));
typedef float f32x4 __attribute__((ext_vector_type(4)));
typedef float f32x2 __attribute__((ext_vector_type(2)));
typedef unsigned u32x4 __attribute__((ext_vector_type(4)));
typedef unsigned u32x2 __attribute__((ext_vector_type(2)));
constexpr int BM = 256, BK = 64, HALF = 128, HTB = HALF * BK * 2, STAGE_BYTES = 8 * HTB, NXCD = 8, WGM = 8;
__device__ __forceinline__ int lds_byte(int r, int c) { const int st = (r >> 4) * 2 + (c >> 5), rr = r & 15, cc = c & 31, ob = rr * 64 + cc * 2; return st * 1024 + (ob ^ (((ob >> 9) & 1) << 5)); }
__device__ __forceinline__ void stage_rc(int b, int& R, int& C) { const int st = b / 1024, sb = b % 1024, swz = sb ^ (((sb >> 9) & 1) << 5); R = (st >> 1) * 16 + swz / 64; C = (st & 1) * 32 + (swz % 64) / 2; }
__device__ __forceinline__ int perm32(int rho) { const int n = rho >> 4, i = rho & 15; return 8 * (i >> 2) + 4 * n + (i & 3); }
__device__ __forceinline__ unsigned cvt_pk_bf16(float lo, float hi) { unsigned r; asm volatile("v_cvt_pk_bf16_f32 %0, %1, %2" : "=v"(r) : "v"(lo), "v"(hi)); return r; }

struct Unit { int pm, pn, aux, half; };
__device__ __forceinline__ bool deal_unit(int i, int G, int c, int U, int& L, int& half) {
    const int F = (U / G) * G, R = U - F; const long Li = (long)i * G + c; half = 0;
    if (Li < F) { L = (int)Li; return true; }
    if (R == 0 || i > U / G) return false;
    if (2 * R <= G) { if (c >= 2 * R) return false; L = F + (c >> 1); half = 1 + (c & 1); return true; }
    if (Li >= U) return false; L = (int)Li; return true; }
struct StaticSched {
    static constexpr bool GATHER = false; static constexpr int GOFF_LDS = 0;
    const char* A; const char* Bt; int K, nM, nN, nwg, G, c;
    __device__ void init(const void* A_, const void* Bt_, int M_, int N_, int K_, int G_, int c_) { A = (const char*)A_; Bt = (const char*)Bt_; K = K_; nM = M_ / BM; nN = N_ / BM; nwg = nM * nN; G = G_; c = c_; }
    __device__ __forceinline__ bool next(int i, Unit& u) const {
        int L, hf; if (!deal_unit(i, G, c, nwg, L, hf)) return false; u.half = hf;
        int wgid = L; { const int q = nwg / NXCD, r = nwg % NXCD, xcd = wgid % NXCD, off = wgid / NXCD; wgid = (xcd < r ? xcd * (q + 1) : r * (q + 1) + (xcd - r) * q) + off; }
        const int nig = WGM * nN, gid = wgid / nig, fm = gid * WGM, gsz = (nM - fm) < WGM ? (nM - fm) : WGM;
        u.pm = fm + ((wgid % nig) % gsz); u.pn = (wgid % nig) / gsz; u.aux = 0; return true;
    }
    __device__ __forceinline__ int ktiles() const { return K / BK; }
    __device__ __forceinline__ const char* a_base() const { return A; }
    __device__ __forceinline__ size_t a_kstep() const { return BK * 2; }
    __device__ __forceinline__ unsigned a_off(const Unit& u, int row, int C) const { return (unsigned)((u.pm * BM + row) * K + C) * 2u; }
    __device__ __forceinline__ unsigned b_ld() const { return (unsigned)K * 2u; }
    __device__ __forceinline__ const char* b_tile(const Unit& u, int t) const { return Bt + (size_t)u.pn * BM * K * 2 + (size_t)t * (BK * 2); }
};

#ifndef PG8_SP2
#define PG8_SP2 true
#endif
#ifndef PG8_ALIGN
#define PG8_ALIGN true
#endif
template <class Epi, class Sched, bool SP2 = PG8_SP2, bool ALIGN_EPI = PG8_ALIGN>
__device__ __forceinline__ void gemm_phase(PG8_LAS unsigned char* lds, const Sched& S, const Epi& E) {
    const int tid = tid_fresh(), wid = __builtin_amdgcn_readfirstlane(tid >> 6), lane = tid & 63, wr = wid >> 2, wc = wid & 3, fr = lane & 15, fq = lane >> 4;
    const int nt = S.ktiles();
    unsigned voffB[2];
    const unsigned ldb = S.b_ld();
#pragma unroll
    for (int i = 0; i < 2; ++i) { int R, C; stage_rc(tid * 16 + i * 8192, R, C); const int Rb = Epi::PERM ? ((R & ~31) + perm32(R & 31)) : R; voffB[i] = (unsigned)Rb * ldb + (unsigned)C * 2u; }
    const unsigned hstepB = (unsigned)HALF * ldb;
    const unsigned ldsw = (unsigned)wid * 1024u;
    const int aoff = lds_byte(wr * 64 + fr, fq * 8), boff = lds_byte(wc * 32 + fr, fq * 8);
    const char* gA = S.a_base(); const size_t akst = S.a_kstep();
#define PG8_SA(b, h) (((b) * 2 + (h)) * HTB)
#define PG8_SB(b, h) ((4 + (b) * 2 + (h)) * HTB)
#define PG8_STAGE_A(bufoff, offarr, h, tt) do { _Pragma("unroll") for (int _i = 0; _i < 2; ++_i) \
        __builtin_amdgcn_global_load_lds((const unsigned*)(gA + (size_t)(tt) * akst + (offarr)[h][_i]), (PG8_LAS unsigned*)(lds + (bufoff) + ldsw + _i * 8192), 16, 0, 0); } while (0)
#define PG8_STAGE_B(bufoff, bptr, h) do { _Pragma("unroll") for (int _i = 0; _i < 2; ++_i) \
        __builtin_amdgcn_global_load_lds((const unsigned*)((bptr) + (h) * hstepB + voffB[_i]), (PG8_LAS unsigned*)(lds + (bufoff) + ldsw + _i * 8192), 16, 0, 0); } while (0)
#define PG8_LDA(dst, b, h) do { _Pragma("unroll") for (int m = 0; m < 4; ++m) _Pragma("unroll") for (int k = 0; k < 2; ++k) dst[m][k] = *(const PG8_LAS bf16x8*)(lds + PG8_SA(b, h) + aoff + m * 2048 + k * 1024); } while (0)
#define PG8_LDB(dst, b, h) do { _Pragma("unroll") for (int n = 0; n < 2; ++n) _Pragma("unroll") for (int k = 0; k < 2; ++k) dst[n][k] = *(const PG8_LAS bf16x8*)(lds + PG8_SB(b, h) + boff + n * 2048 + k * 1024); } while (0)
#define PG8_MMA(ai, bj, At, Bt) do { __builtin_amdgcn_s_setprio(1); _Pragma("unroll") for (int m = 0; m < 4; ++m) _Pragma("unroll") for (int n = 0; n < 2; ++n) _Pragma("unroll") for (int k = 0; k < 2; ++k) \
        acc[ai][bj][m][n] = __builtin_amdgcn_mfma_f32_16x16x32_bf16(Bt[n][k], At[m][k], acc[ai][bj][m][n], 0, 0, 0); __builtin_amdgcn_s_setprio(0); } while (0)
#define PG8_WAIT_V(n) asm volatile("s_waitcnt vmcnt(" #n ")" ::: "memory")
#define PG8_WAIT_L(n) asm volatile("s_waitcnt lgkmcnt(" #n ")" ::: "memory")
#define PG8_BAR __builtin_amdgcn_s_barrier()
#define PG8_SCHED __builtin_amdgcn_sched_barrier(0)
#define PG8_AOFFS(dst, u) do { _Pragma("unroll") for (int _i = 0; _i < 2; ++_i) { int _R, _C; stage_rc(tid * 16 + _i * 8192, _R, _C); _Pragma("unroll") for (int _h = 0; _h < 2; ++_h) dst[_h][_i] = S.a_off(u, ((u).half ? ((u).half == 2 ? HALF : 0) : _h * HALF) + _R, _C); } } while (0)
#define PG8_NOFF_PUT() do { *(PG8_LAS u32x4*)(lds + Sched::GOFF_LDS + tid * 16) = (u32x4){noff[0][0], noff[0][1], noff[1][0], noff[1][1]}; } while (0)
#define PG8_NOFF_GET(dst) do { const u32x4 _v = *(const PG8_LAS u32x4*)(lds + Sched::GOFF_LDS + tid * 16); dst[0][0] = _v.x; dst[0][1] = _v.y; dst[1][0] = _v.z; dst[1][1] = _v.w; } while (0)
    Unit cur, nxt; int ui = 0;
    if (!S.next(0, cur)) return;
    f32x4 acc[2][2][4][2];
#pragma unroll
    for (int a = 0; a < 2; ++a)
#pragma unroll
        for (int b = 0; b < 2; ++b)
#pragma unroll
            for (int m = 0; m < 4; ++m)
#pragma unroll
                for (int n = 0; n < 2; ++n) acc[a][b][m][n] = (f32x4){0.f, 0.f, 0.f, 0.f};
    bf16x8 At[4][2], B0[2][2], B1[2][2];
    constexpr bool GATHER = Sched::GATHER;
    unsigned coff[2][2], noff[2][2];
    PG8_AOFFS(coff, cur);
    { const char* b0 = S.b_tile(cur, 0); const char* b1 = S.b_tile(cur, 1);
      if constexpr (SP2) {
      PG8_STAGE_B(PG8_SB(0, 0), b0, 0); PG8_STAGE_B(PG8_SB(0, 1), b0, 1); PG8_STAGE_A(PG8_SA(0, 0), coff, 0, 0); PG8_STAGE_A(PG8_SA(0, 1), coff, 1, 0);
      if (wr == 1) PG8_BAR;
      PG8_WAIT_V(2); PG8_BAR;
      PG8_STAGE_B(PG8_SB(1, 0), b1, 0); PG8_STAGE_A(PG8_SA(1, 0), coff, 0, 1); PG8_STAGE_B(PG8_SB(1, 1), b1, 1);
      PG8_WAIT_V(6); PG8_BAR;
      } else {
      PG8_STAGE_B(PG8_SB(0, 0), b0, 0); PG8_STAGE_A(PG8_SA(0, 0), coff, 0, 0); PG8_STAGE_B(PG8_SB(0, 1), b0, 1); PG8_STAGE_A(PG8_SA(0, 1), coff, 1, 0);
      if (wr == 1) PG8_BAR;
      PG8_WAIT_V(4); PG8_BAR;
      PG8_STAGE_B(PG8_SB(1, 0), b1, 0); PG8_STAGE_A(PG8_SA(1, 0), coff, 0, 1); PG8_STAGE_B(PG8_SB(1, 1), b1, 1);
      PG8_WAIT_V(6); PG8_BAR; } }
    for (;;) {
        const bool has_next = S.next(ui + 1, nxt);
        if (has_next) { if constexpr (GATHER) { PG8_AOFFS(noff, nxt); PG8_NOFF_PUT(); } }
        else { nxt = cur;
#pragma unroll
            for (int _h = 0; _h < 2; ++_h)
#pragma unroll
                for (int _i = 0; _i < 2; ++_i) if constexpr (GATHER) noff[_h][_i] = coff[_h][_i]; if constexpr (GATHER) PG8_NOFF_PUT(); }
        for (int t = 0; t < nt; t += 2) {
            const bool last = (t == nt - 2);
            const int t2 = last ? 0 : t + 2, t3 = t2 + 1;
            const char* b2 = last ? S.b_tile(nxt, 0) : S.b_tile(cur, t + 2);
            const char* b3 = last ? S.b_tile(nxt, 1) : S.b_tile(cur, t + 3);
            unsigned o2[2][2];
            if constexpr (GATHER) {
#pragma unroll
                for (int _h = 0; _h < 2; ++_h)
#pragma unroll
                    for (int _i = 0; _i < 2; ++_i) o2[_h][_i] = coff[_h][_i];
                if (last) PG8_NOFF_GET(o2); }
            else { if (last) PG8_AOFFS(o2, nxt); else PG8_AOFFS(o2, cur); PG8_AOFFS(coff, cur); }
            if constexpr (SP2) {
            PG8_LDB(B0, 0, 0); PG8_LDB(B1, 0, 1); PG8_SCHED; PG8_LDA(At, 0, 0); PG8_STAGE_A(PG8_SA(1, 1), coff, 1, t + 1);
            PG8_WAIT_V(8); PG8_WAIT_L(0); PG8_BAR; PG8_MMA(0, 0, At, B0); PG8_MMA(0, 1, At, B1); PG8_BAR; PG8_SCHED;
            PG8_LDA(At, 0, 1); PG8_STAGE_B(PG8_SB(0, 0), b2, 0); PG8_STAGE_B(PG8_SB(0, 1), b2, 1); PG8_STAGE_A(PG8_SA(0, 0), o2, 0, t2);
            PG8_WAIT_V(8); PG8_WAIT_L(0); PG8_BAR; if (!cur.half) { PG8_MMA(1, 0, At, B0); PG8_MMA(1, 1, At, B1); } PG8_BAR; PG8_SCHED;
            PG8_LDB(B0, 1, 0); PG8_LDB(B1, 1, 1); PG8_SCHED; PG8_LDA(At, 1, 0); PG8_STAGE_A(PG8_SA(0, 1), o2, 1, t2);
            PG8_WAIT_V(8); PG8_WAIT_L(0); PG8_BAR; PG8_MMA(0, 0, At, B0); PG8_MMA(0, 1, At, B1); PG8_BAR; PG8_SCHED;
            PG8_LDA(At, 1, 1); PG8_STAGE_B(PG8_SB(1, 0), b3, 0); PG8_STAGE_B(PG8_SB(1, 1), b3, 1); PG8_STAGE_A(PG8_SA(1, 0), o2, 0, t3);
            PG8_WAIT_V(8); PG8_WAIT_L(0); PG8_BAR; if (!cur.half) { PG8_MMA(1, 0, At, B0); PG8_MMA(1, 1, At, B1); } PG8_BAR; PG8_SCHED;
            } else {
            PG8_LDB(B0, 0, 0); PG8_SCHED; PG8_LDA(At, 0, 0); PG8_STAGE_A(PG8_SA(1, 1), coff, 1, t + 1);
            PG8_WAIT_L(8); PG8_BAR; PG8_WAIT_L(0); PG8_MMA(0, 0, At, B0); PG8_BAR; PG8_SCHED;
            PG8_LDB(B1, 0, 1); PG8_STAGE_B(PG8_SB(0, 0), b2, 0);
            PG8_BAR; PG8_WAIT_L(0); PG8_MMA(0, 1, At, B1); PG8_BAR;
            PG8_LDA(At, 0, 1); PG8_STAGE_A(PG8_SA(0, 0), o2, 0, t2);
            PG8_BAR; PG8_WAIT_L(0); PG8_MMA(1, 0, At, B0); PG8_BAR; PG8_SCHED;
            PG8_STAGE_B(PG8_SB(0, 1), b2, 1);
            PG8_WAIT_V(6); PG8_BAR; PG8_MMA(1, 1, At, B1); PG8_BAR;
            PG8_LDB(B0, 1, 0); PG8_SCHED; PG8_LDA(At, 1, 0); PG8_STAGE_A(PG8_SA(0, 1), o2, 1, t2);
            PG8_WAIT_L(8); PG8_BAR; PG8_WAIT_L(0); PG8_MMA(0, 0, At, B0); PG8_BAR; PG8_SCHED;
            PG8_LDB(B1, 1, 1); PG8_STAGE_B(PG8_SB(1, 0), b3, 0);
            PG8_BAR; PG8_WAIT_L(0); PG8_MMA(0, 1, At, B1); PG8_BAR;
            PG8_LDA(At, 1, 1); PG8_STAGE_A(PG8_SA(1, 0), o2, 0, t3);
            PG8_BAR; PG8_WAIT_L(0); PG8_MMA(1, 0, At, B0); PG8_BAR; PG8_SCHED;
            PG8_STAGE_B(PG8_SB(1, 1), b3, 1);
            PG8_WAIT_V(6); PG8_BAR; PG8_MMA(1, 1, At, B1); PG8_BAR;
            }
        }
        if constexpr (ALIGN_EPI) { if (wr == 0) PG8_BAR; }
        if constexpr (!Epi::AFTER_DRAIN) E(acc, cur, wr, wc, fr, fq);
        if (!has_next) break;
#pragma unroll
        for (int a = 0; a < 2; ++a)
#pragma unroll
            for (int b = 0; b < 2; ++b)
#pragma unroll
                for (int m = 0; m < 4; ++m)
#pragma unroll
                    for (int n = 0; n < 2; ++n) acc[a][b][m][n] = (f32x4){0.f, 0.f, 0.f, 0.f};
        cur = nxt; ++ui;
        if constexpr (ALIGN_EPI) { if (wr == 1) PG8_BAR; }
#pragma unroll
        for (int _h = 0; _h < 2; ++_h)
#pragma unroll
            for (int _i = 0; _i < 2; ++_i) if constexpr (GATHER) coff[_h][_i] = 0u;
        if constexpr (GATHER) PG8_NOFF_GET(coff);
    }
    PG8_WAIT_V(0);
    if constexpr (!ALIGN_EPI) { if (wr == 0) PG8_BAR; }
    PG8_BAR;
    if constexpr (Epi::AFTER_DRAIN) E.fused(acc, cur, wr, wc, fr, fq, lds);
#undef PG8_SA
#undef PG8_SB
#undef PG8_STAGE_A
#undef PG8_STAGE_B
#undef PG8_LDA
#undef PG8_LDB
#undef PG8_MMA
#undef PG8_WAIT_V
#undef PG8_WAIT_L
#undef PG8_BAR
#undef PG8_SCHED
#undef PG8_AOFFS
#undef PG8_NOFF_PUT
#undef PG8_NOFF_GET
}

struct EpiBf16Store {
    static constexpr bool PERM = true, AFTER_DRAIN = false;
    bf16* O; int ldc;
    __device__ __forceinline__ void operator()(const f32x4 (&acc)[2][2][4][2], const Unit& u, int wr, int wc, int fr, int fq) const {
        const int row0 = u.pm * BM + wr * 64 + fr + (u.half == 2 ? HALF : 0), col0 = u.pn * BM + wc * 32 + 8 * fq;
#pragma unroll
        for (int ai = 0; ai < 2; ++ai)
#pragma unroll
            for (int m = 0; m < 4; ++m) { if (ai == 1 && u.half) continue; bf16* rowp = O + (size_t)(row0 + ai * HALF + m * 16) * ldc + col0;
#pragma unroll
                for (int bj = 0; bj < 2; ++bj) { const f32x4 v0 = acc[ai][bj][m][0], v1 = acc[ai][bj][m][1];
                    u32x4 w; w.x = cvt_pk_bf16(v0[0], v0[1]); w.y = cvt_pk_bf16(v0[2], v0[3]); w.z = cvt_pk_bf16(v1[0], v1[1]); w.w = cvt_pk_bf16(v1[2], v1[3]);
                    *(u32x4*)(rowp + bj * HALF) = w; } }
    }
};
struct EpiResidual {
    static constexpr bool PERM = true, AFTER_DRAIN = false;
    const void* xs; bool xbf; bf16* out; const float* gate;
    __device__ __forceinline__ void operator()(const f32x4 (&acc)[2][2][4][2], const Unit& u, int wr, int wc, int fr, int fq) const {
        const int row0 = u.pm * BM + wr * 64 + fr + (u.half == 2 ? HALF : 0), col0 = u.pn * BM + wc * 32 + 8 * fq;
        const float* gp = gate + (size_t)((u.pm * BM) / NS) * 6144 + col0;
        f32x4 gv[2][2];
#pragma unroll
        for (int bj = 0; bj < 2; ++bj)
#pragma unroll
            for (int n = 0; n < 2; ++n) gv[bj][n] = *(const f32x4*)(gp + bj * HALF + n * 4);
#pragma unroll
        for (int ai = 0; ai < 2; ++ai) { if (ai == 1 && u.half) continue;
#pragma unroll
          for (int mp = 0; mp < 2; ++mp) {
            f32x4 x0[2][2], x1[2][2];
#pragma unroll
            for (int mm = 0; mm < 2; ++mm) { const size_t ro = (size_t)(row0 + ai * HALF + (2 * mp + mm) * 16) * D + col0;
#pragma unroll
                for (int bj = 0; bj < 2; ++bj) {
                    if (xbf) { const u32x4 w = *(const u32x4*)((const bf16*)xs + ro + bj * HALF);
                        x0[mm][bj] = (f32x4){__builtin_bit_cast(float, w.x << 16), __builtin_bit_cast(float, w.x & 0xffff0000u), __builtin_bit_cast(float, w.y << 16), __builtin_bit_cast(float, w.y & 0xffff0000u)};
                        x1[mm][bj] = (f32x4){__builtin_bit_cast(float, w.z << 16), __builtin_bit_cast(float, w.z & 0xffff0000u), __builtin_bit_cast(float, w.w << 16), __builtin_bit_cast(float, w.w & 0xffff0000u)}; }
                    else { x0[mm][bj] = *(const f32x4*)((const float*)xs + ro + bj * HALF); x1[mm][bj] = *(const f32x4*)((const float*)xs + ro + bj * HALF + 4); } } }
#pragma unroll
            for (int mm = 0; mm < 2; ++mm) { const int m = 2 * mp + mm; const size_t ro = (size_t)(row0 + ai * HALF + m * 16) * D + col0;
#pragma unroll
                for (int bj = 0; bj < 2; ++bj) { const f32x4 y0 = x0[mm][bj] + gv[bj][0] * acc[ai][bj][m][0], y1 = x1[mm][bj] + gv[bj][1] * acc[ai][bj][m][1];
                    u32x4 o; o.x = cvt_pk_bf16(y0[0], y0[1]); o.y = cvt_pk_bf16(y0[2], y0[3]); o.z = cvt_pk_bf16(y1[0], y1[1]); o.w = cvt_pk_bf16(y1[2], y1[3]);
                    *(u32x4*)(out + ro + bj * HALF) = o; } } } }
    }
};
}
constexpr int NTH = 512;
typedef float f32x4_t __attribute__((ext_vector_type(4)));
typedef unsigned u32x4_t __attribute__((ext_vector_type(4)));
typedef unsigned u32x2_t __attribute__((ext_vector_type(2)));
typedef short s16x8_t __attribute__((ext_vector_type(8)));
#define LDSP(T, off) ((LAS T*)(lds + (off)))
__device__ __forceinline__ float wave_sum(float v) {
#pragma unroll
    for (int o = 1; o < 64; o <<= 1) v += __shfl_xor(v, o);
    return v;
}
__device__ __forceinline__ unsigned pk_bf16(float lo, float hi) { return pg8::cvt_pk_bf16(lo, hi); }

constexpr int CVT_WIN = 2 * 16 * 44, CVT_WOUT = 2 * 16 * 16, CVT_G = 32 * 16 * 8, CVT_U = CVT_G, CVT_D = 32 * 8 * 16, CVT_C1 = 4 * 32 * 2, CVT_C2 = 4 * 2;
constexpr int CVT_TOTAL = CVT_WIN + CVT_WOUT + CVT_G + CVT_U + CVT_D + CVT_C1 + CVT_C2;
__device__ __forceinline__ void cvt_job(const P& p, int T, const float*& src, size_t& lds_, bf16*& dst, size_t& ldd, bool& perm) {
    perm = false;
    if (T < CVT_WIN) { const int l = T / 704, r = T % 704, kt = r / 44, nt = r % 44;
        src = p.w_in + (size_t)l * D * NIN + (size_t)kt * 64 * NIN + nt * 64; lds_ = NIN; dst = WSP(bf16, WS_WIN_T) + (size_t)l * ZW * D + (size_t)((nt / 4) * 256 + (nt % 4) * 32) * D + kt * 64; ldd = D; perm = true; return; }
    T -= CVT_WIN;
    if (T < CVT_WOUT) { const int l = T / 256, r = T % 256, kt = r / 16, nt = r % 16;
        src = p.w_out + (size_t)l * D * D + (size_t)kt * 64 * D + nt * 64; lds_ = D; dst = WSP(bf16, WS_WOUT_T) + (size_t)l * D * D + (size_t)nt * 64 * D + kt * 64; ldd = D; return; }
    T -= CVT_WOUT;
    if (T < CVT_G + CVT_U) { const int up = T >= CVT_G; if (up) T -= CVT_G; const int le = T / 128, r = T % 128, kt = r / 8, nt = r % 8;
        src = (up ? p.moe_w_up : p.moe_w_gate) + (size_t)le * D * 512 + (size_t)kt * 64 * 512 + nt * 64; lds_ = 512;
        const int row0 = 256 * (nt / 2) + 64 * (nt % 2) + (up ? 128 : 0);
        dst = WSP(bf16, WS_WGU_T) + (size_t)le * 1024 * D + (size_t)row0 * D + kt * 64; ldd = D; return; }
    T -= CVT_G + CVT_U;
    if (T < CVT_D) { const int le = T / 128, r = T % 128, kt = r / 16, nt = r % 16;
        src = p.moe_w_down + (size_t)le * 512 * D + (size_t)kt * 64 * D + nt * 64; lds_ = D; dst = WSP(bf16, WS_WD_T) + (size_t)le * D * 512 + (size_t)nt * 64 * 512 + kt * 64; ldd = 512; return; }
    T -= CVT_D;
    if (T < CVT_C1) { const int lk = T / 64, l = lk / 2, kv = lk % 2, r = T % 64, kt = r / 2, nt = r % 2;
        src = (kv ? p.cmp_w1_v : p.cmp_w1_k) + (size_t)l * 2048 * 128 + (size_t)kt * 64 * 128 + nt * 64; lds_ = 128; dst = WSP(bf16, WS_CW1_T) + (size_t)lk * 256 * 1024 + (size_t)((kt >= 16 ? 128 : 0) + nt * 64) * 1024 + (kt & 15) * 64; ldd = 1024; return; }
    T -= CVT_C1;
    { const int lk = T / 2, l = lk / 2, kv = lk % 2, kt = T % 2;
        src = (kv ? p.cmp_w2_v : p.cmp_w2_k) + (size_t)l * 128 * 64 + (size_t)kt * 64 * 64; lds_ = 64; dst = WSP(bf16, WS_CW2_T) + (size_t)lk * 64 * 128 + kt * 64; ldd = 128; }
}
__device__ __forceinline__ void p0_prologue(const P& p, LAS unsigned char* lds) {
    const int tid = tid_fresh();
    if (bid_fresh() < 192) {
        LAS float* sc = LDSP(float, 0);
        LAS float* red = LDSP(float, 65536);
        for (int i = tid; i < NB * D; i += NTH) sc[i] = silu_f(p.c[i]);
        __syncthreads();
        const int lane = tid & 63, wv_ = tid >> 6, col = bid_fresh() * 64 + lane, l = col / 6144, n = col % 6144;
        float acc[NB];
#pragma unroll
        for (int b = 0; b < NB; ++b) acc[b] = 0.f;
        const float* w = p.ada_w + (size_t)l * D * 6144 + n;
        for (int k = wv_ * 128; k < wv_ * 128 + 128; k += 16) { float wv[16];
#pragma unroll
            for (int u = 0; u < 16; ++u) wv[u] = w[(size_t)(k + u) * 6144];
#pragma unroll
            for (int u = 0; u < 16; ++u)
#pragma unroll
                for (int b = 0; b < NB; ++b) acc[b] += sc[b * D + k + u] * wv[u]; }
#pragma unroll
        for (int b = 0; b < NB; ++b) red[(wv_ * NB + b) * 64 + lane] = acc[b];
        __syncthreads();
        for (int i = tid; i < NB * 64; i += NTH) { const int b = i >> 6, c = i & 63, cc = bid_fresh() * 64 + c, ll = cc / 6144, nn = cc % 6144; float s = p.ada_b[ll * 6144 + nn];
#pragma unroll
            for (int q = 0; q < 8; ++q) s += red[(q * NB + b) * 64 + c];
            WSP(float, WS_MOD)[((size_t)ll * NB + b) * 6144 + nn] = s; }
        __syncthreads();
    }
    { constexpr int TP = 8; const int G = grid_fresh(), bx = bid_fresh();
      for (int T0 = bx * TP; T0 < CVT_TOTAL; T0 += G * TP) {
        f32x4_t va[TP], vb[TP]; bf16* dst[TP]; size_t ld[TP]; bool perm[TP];
        const int k = tid >> 3, ns = (tid & 7) * 8;
#pragma unroll
        for (int q = 0; q < TP; ++q) { const int T = T0 + q < CVT_TOTAL ? T0 + q : CVT_TOTAL - 1; const float* src; size_t ls; cvt_job(p, T, src, ls, dst[q], ld[q], perm[q]);
            va[q] = *(const f32x4_t*)(src + (size_t)k * ls + ns); vb[q] = *(const f32x4_t*)(src + (size_t)k * ls + ns + 4); }
#pragma unroll
        for (int q = 0; q < TP; ++q) { LAS float* tile = LDSP(float, q * 64 * 65 * 4);
#pragma unroll
            for (int j = 0; j < 4; ++j) { tile[k * 65 + ns + j] = va[q][j]; tile[k * 65 + ns + 4 + j] = vb[q][j]; } }
        __syncthreads();
#pragma unroll
        for (int q = 0; q < TP; ++q) { if (T0 + q < CVT_TOTAL) { LAS float* tile = LDSP(float, q * 64 * 65 * 4); const int n = tid >> 3, ks = (tid & 7) * 8; u32x4_t w;
            w.x = pk_bf16(tile[(ks + 0) * 65 + n], tile[(ks + 1) * 65 + n]); w.y = pk_bf16(tile[(ks + 2) * 65 + n], tile[(ks + 3) * 65 + n]);
            w.z = pk_bf16(tile[(ks + 4) * 65 + n], tile[(ks + 5) * 65 + n]); w.w = pk_bf16(tile[(ks + 6) * 65 + n], tile[(ks + 7) * 65 + n]);
            const int nrow = perm[q] ? 128 * (n >> 5) + (n & 31) : n;
            *(u32x4_t*)(dst[q] + (size_t)nrow * ld[q] + ks) = w; } }
        __syncthreads();
      } }
    const long gid = (long)bid_fresh() * NTH + tid, gsz = (long)grid_fresh() * NTH;
    for (long i = gid; i < 2L * 32 * D; i += gsz) { const int k = (int)(i % D), j = (int)((i / D) % 32), l = (int)(i / (32 * D));
        WSP(bf16, WS_WGL_T)[i] = j < 24 ? f2bf(p.w_in[(size_t)l * D * NIN + (size_t)k * NIN + ZW + j]) : (bf16)0; }
    { const int lane = tid & 63, gw = (int)(gid >> 6), nw = (int)(gsz >> 6);
      for (int o = gw; o < 2 * 2 * 128; o += nw) { const int j = o % 128, kv = (o / 128) % 2, l = o / 256;
        const float* pe = (kv ? p.cmp_pe_v : p.cmp_pe_k) + (size_t)l * 2048; const float* w1 = (kv ? p.cmp_w1_v : p.cmp_w1_k) + (size_t)l * 2048 * 128 + j; float sacc = 0.f;
#pragma unroll 8
        for (int k = lane; k < 2048; k += 64) sacc += pe[k] * w1[(size_t)k * 128];
        sacc = wave_sum(sacc); if (lane == 0) WSP(float, WS_PEB)[o] = sacc; } }
    if (gid < 6) { const int l = (int)gid / 3, br = (int)gid % 3; float mq = 0.f, mk = 0.f;
        for (int e = 0; e < 64; ++e) { mq = fmaxf(mq, fabsf(p.nsa_q_norm_g[l * 64 + e])); mk = fmaxf(mk, fabsf(p.nsa_k_norm_g[(l * 3 + br) * 64 + e])); }
        WSP(float, WS_BND)[gid] = 8.f * mq * mk * 1.4426950408889634f; }
    for (long i = gid; i < 2L * 4 * 128 * 128; i += gsz) { const int s = (int)(i % 128), t = (int)((i / 128) % 128); WSP(bf16, WS_GWS)[i] = s <= t ? f2bf(p.gmlp_ws[i]) : (bf16)0; }
    for (long i = gid; i < (long)M * 32; i += gsz) { const long m = i / 32; const int j = (int)(i % 32); const float ang = (float)p.pos[m] * invfreq(j);
        const float cv = cosf(ang), sv = sinf(ang); WSP(float, WS_CS)[m * 64 + j] = cv; WSP(float, WS_CS)[m * 64 + 32 + j] = sv; WSP(bf16, WS_CSB)[m * 64 + j] = f2bf(cv); WSP(bf16, WS_CSB)[m * 64 + 32 + j] = f2bf(sv); }
}

__device__ __forceinline__ f32x4_t ld4x(const void* base, size_t idx, bool isbf) {
    if (isbf) { const u32x2_t w = *(const u32x2_t*)((const bf16*)base + idx); return (f32x4_t){__builtin_bit_cast(float, w.x << 16), __builtin_bit_cast(float, w.x & 0xffff0000u), __builtin_bit_cast(float, w.y << 16), __builtin_bit_cast(float, w.y & 0xffff0000u)}; }
    return *(const f32x4_t*)((const float*)base + idx); }
__device__ __forceinline__ void norm_phase(const P& p, LAS unsigned char* lds, const void* xs, bool xbf, int l, int which, int cbank = -1) {
    if (cbank < 0) cbank = l;
    const int tid = tid_fresh(), lane = tid & 63, wave = tid >> 6;
    const float* g = (which ? p.norm_ffn_g : p.norm_mix_g) + l * D;
    bf16* H = WSP(bf16, WS_H);
    LAS float* wr_l = LDSP(float, 0);
    LAS float* lg_l = LDSP(float, 65536);
    LAS int* lcnt = LDSP(int, 65536 + 8192);
    LAS float* red_l = LDSP(float, 65536 + 8192 + 256);
    LAS float* rs_l = LDSP(float, 65536 + 8192 + 256 + 2048);
    for (int rb = bid_fresh(); rb < M / 128; rb += grid_fresh()) {
        const int b = (rb * 128) / NS; const float* mod = WSP(float, WS_MOD) + ((size_t)l * NB + b) * 6144 + which * 3072;
        if (which) {
            __syncthreads();
            if (tid < 48) lcnt[tid] = 0;
            for (int i = tid; i < D * 16; i += NTH) { const int k = i >> 4, e = i & 15; wr_l[(k >> 4) * 256 + ((k >> 2) & 3) * 64 + e * 4 + (k & 3)] = g[k] * (1.f + mod[1024 + k]) * p.router_w[i]; }
            if (tid < 256) { const int e = tid & 15, part = tid >> 4; float s = 0.f; for (int k = part * 64; k < part * 64 + 64; ++k) s += mod[k] * p.router_w[k * 16 + e]; red_l[part * 16 + e] = s; }
            __syncthreads();
            if (tid < 16) { float s = 0.f;
#pragma unroll
                for (int q = 0; q < 16; ++q) s += red_l[q * 16 + tid]; red_l[256 + tid] = s; }
            __syncthreads();
            const int r = lane & 15, kq = lane >> 4; const size_t xr = (size_t)((long)rb * 128 + wave * 16 + r) * D + 4 * kq;
            f32x4_t acc = {0.f, 0.f, 0.f, 0.f}; float ss = 0.f;
#pragma unroll 8
            for (int t = 0; t < 64; ++t) { const f32x4_t xv = ld4x(xs, xr + 16 * t, xbf); const f32x4_t av = *(const LAS f32x4_t*)(wr_l + t * 256 + kq * 64 + r * 4);
                ss += xv[0] * xv[0] + xv[1] * xv[1] + xv[2] * xv[2] + xv[3] * xv[3];
                acc = __builtin_amdgcn_mfma_f32_16x16x4f32(av[0], xv[0], acc, 0, 0, 0); acc = __builtin_amdgcn_mfma_f32_16x16x4f32(av[1], xv[1], acc, 0, 0, 0);
                acc = __builtin_amdgcn_mfma_f32_16x16x4f32(av[2], xv[2], acc, 0, 0, 0); acc = __builtin_amdgcn_mfma_f32_16x16x4f32(av[3], xv[3], acc, 0, 0, 0); }
            ss += __shfl_xor(ss, 16); ss += __shfl_xor(ss, 32);
            const float rs = 1.0f / sqrtf(ss * (1.f / D) + EPS);
            if (kq == 0) rs_l[wave * 16 + r] = rs;
#pragma unroll
            for (int reg = 0; reg < 4; ++reg) lg_l[(wave * 16 + r) * 16 + 4 * kq + reg] = rs * acc[reg] + red_l[256 + 4 * kq + reg];
        }
        f32x4_t gmv[4], shv[4];
#pragma unroll
        for (int i = 0; i < 4; ++i) { const int k0 = 256 * i + 4 * lane; const f32x4_t gv = *(const f32x4_t*)(g + k0), sc = *(const f32x4_t*)(mod + 1024 + k0); shv[i] = *(const f32x4_t*)(mod + k0);
#pragma unroll
            for (int j = 0; j < 4; ++j) gmv[i][j] = gv[j] * (1.f + sc[j]); }
        f32x4_t hn[4][4];
#pragma unroll
        for (int r = 0; r < 4; ++r)
#pragma unroll
            for (int i = 0; i < 4; ++i) hn[r][i] = ld4x(xs, (size_t)((long)rb * 128 + wave * 16 + r) * D + 256 * i + 4 * lane, xbf);
#pragma unroll
        for (int grp = 0; grp < 4; ++grp) {
            const long row0 = (long)rb * 128 + wave * 16 + grp * 4;
            f32x4_t hv[4][4]; float ss[4];
#pragma unroll
            for (int r = 0; r < 4; ++r) { ss[r] = 0.f;
#pragma unroll
                for (int i = 0; i < 4; ++i) { hv[r][i] = hn[r][i]; if (!which) ss[r] += hv[r][i][0] * hv[r][i][0] + hv[r][i][1] * hv[r][i][1] + hv[r][i][2] * hv[r][i][2] + hv[r][i][3] * hv[r][i][3]; } }
            if (grp < 3) {
#pragma unroll
                for (int r = 0; r < 4; ++r)
#pragma unroll
                    for (int i = 0; i < 4; ++i) hn[r][i] = ld4x(xs, (size_t)(row0 + 4 + r) * D + 256 * i + 4 * lane, xbf); }
#pragma unroll
            for (int r = 0; r < 4; ++r) ss[r] = which ? rs_l[wave * 16 + grp * 4 + r] : 1.0f / sqrtf(wave_sum(ss[r]) * (1.f / D) + EPS);
#pragma unroll
            for (int i = 0; i < 4; ++i) { const int k0 = 256 * i + 4 * lane;
#pragma unroll
                for (int r = 0; r < 4; ++r) { hv[r][i] = hv[r][i] * ss[r] * gmv[i] + shv[i];
                    u32x2_t w; w.x = pk_bf16(hv[r][i][0], hv[r][i][1]); w.y = pk_bf16(hv[r][i][2], hv[r][i][3]); *(u32x2_t*)(H + (row0 + r) * D + k0) = w; } }
        }
        if (which) {
            int cls = -1, rank = 0; float wa = 0.f, wb = 0.f; const long row = (long)rb * 128 + wave * 16 + lane;
            __builtin_amdgcn_s_waitcnt(0);
            if (lane < 16) {
                const LAS float* q = lg_l + (wave * 16 + lane) * 16;
                float mx = q[0];
#pragma unroll
                for (int e = 1; e < 16; ++e) mx = fmaxf(mx, q[e]);
                float den = 0.f;
#pragma unroll
                for (int e = 0; e < 16; ++e) den += expf(q[e] - mx);
                float bestg = -3e38f; int bg = 0;
#pragma unroll
                for (int gI = 0; gI < 4; ++gI) { float a = -3e38f, b2 = -3e38f;
#pragma unroll
                    for (int j = 0; j < 4; ++j) { const float s = expf(q[gI * 4 + j] - mx) / den + p.router_b[gI * 4 + j]; if (s > a) { b2 = a; a = s; } else if (s > b2) b2 = s; }
                    if (a + b2 > bestg) { bestg = a + b2; bg = gI; } }
                float a = -3e38f, b2 = -3e38f; int ia = 0, ib = 0;
#pragma unroll
                for (int j = 0; j < 4; ++j) { const float s = expf(q[bg * 4 + j] - mx) / den + p.router_b[bg * 4 + j];
                    if (s > a) { b2 = a; ib = ia; a = s; ia = j; } else if (s > b2) { b2 = s; ib = j; } }
                const float p0 = expf(q[bg * 4 + ia] - mx) / den, p1 = expf(q[bg * 4 + ib] - mx) / den;
                const float w0 = p0 / (p0 + p1), w1 = p1 / (p0 + p1);
                const int lo = ia < ib ? ia : ib, hi = ia < ib ? ib : ia;
                wa = ia < ib ? w0 : w1; wb = ia < ib ? w1 : w0;
                const int pairidx = lo == 0 ? hi - 1 : (lo == 1 ? hi + 1 : 5);
                cls = bg * 6 + pairidx;
                rank = atomicAdd((int*)&lcnt[cls], 1);
                Rout r; r.e0 = bg * 4 + ia; r.e1 = bg * 4 + ib; r.w0 = w0; r.w1 = w1; WSP(Rout, WS_ROUT)[row] = r;
            }
            __syncthreads();
            if (tid < 24) { const int c = lcnt[tid]; lcnt[24 + tid] = c ? atomicAdd(WSP(int, WS_CTL) + CW_CNT + cbank * 64 + tid, c) : 0; }
            __syncthreads();
            if (lane < 16) { const int slot = lcnt[24 + cls] + rank; WSP(int, WS_CTOK)[(size_t)cls * M + slot] = (int)row; float* wp = WSP(float, WS_CWT) + ((size_t)cls * M + slot) * 2; wp[0] = wa; wp[1] = wb; }
            __syncthreads();
            if (tid < 24) lcnt[tid] = 0;
            __syncthreads();
        }
    }
}

__device__ __forceinline__ void gl_tail(const P& p, int l) {
    const int tid = tid_fresh(), lane = tid & 63, wave = tid >> 6, fr = lane & 15, fq = lane >> 4;
    const bf16* H = WSP(bf16, WS_H); const bf16* W = WSP(bf16, WS_WGL_T) + (size_t)l * 32 * D; float* GL = WSP(float, WS_GL);
    for (int rt = bid_fresh() * 8 + wave; rt < M / 16; rt += grid_fresh() * 8) {
        pg8::f32x4 acc0 = {0.f, 0.f, 0.f, 0.f}, acc1 = {0.f, 0.f, 0.f, 0.f};
        const bf16* ap = H + (size_t)(rt * 16 + fr) * D + fq * 8; const bf16* bp0 = W + (size_t)fr * D + fq * 8; const bf16* bp1 = W + (size_t)(16 + fr) * D + fq * 8;
#pragma unroll 8
        for (int s = 0; s < 32; ++s) { const s16x8_t a = *(const s16x8_t*)(ap + s * 32), b0 = *(const s16x8_t*)(bp0 + s * 32), b1 = *(const s16x8_t*)(bp1 + s * 32);
            acc0 = __builtin_amdgcn_mfma_f32_16x16x32_bf16(a, b0, acc0, 0, 0, 0); acc1 = __builtin_amdgcn_mfma_f32_16x16x32_bf16(a, b1, acc1, 0, 0, 0); }
#pragma unroll
        for (int r = 0; r < 4; ++r) { const long m = (long)rt * 16 + 4 * fq + r; GL[m * 24 + fr] = acc0[r]; if (fr < 8) GL[m * 24 + 16 + fr] = acc1[r]; }
    }
}

struct EpiZ {
    static constexpr bool PERM = true, AFTER_DRAIN = false;
    const P* pp; int l;
    __device__ __forceinline__ void operator()(const pg8::f32x4 (&acc)[2][2][4][2], const pg8::Unit& u, int wr, int wc, int fr, int fq) const {
        const P& p = *pp; bf16* Z = WSP(bf16, WS_Z); const bf16* CSB = WSP(bf16, WS_CSB);
        const int pn = u.pn;
        int mode = 0; float scale = 1.f; const float* gain = nullptr;
        if (pn == 0) mode = 1; else if (pn == 1) { mode = 1; scale = 0.125f; } else if (pn == 3) mode = 3; else if (pn == 4 || pn == 5) mode = 4;
        else if (pn == 6 || pn == 7) { mode = 2; scale = 0.125f; gain = p.nsa_q_norm_g + l * 64; }
        else if (pn == 9 && wc < 2) { mode = 2; gain = p.nsa_k_norm_g + (l * 3 + 1) * 64; }
        else if (pn == 10 && wc < 2) { mode = 2; gain = p.nsa_k_norm_g + (l * 3 + 2) * 64; }
        float g0[8], g1[8];
        if (mode == 2) {
#pragma unroll
            for (int j = 0; j < 8; ++j) { g0[j] = gain[8 * fq + j] * scale; g1[j] = gain[32 + 8 * fq + j] * scale; } }
        else {
#pragma unroll
            for (int j = 0; j < 8; ++j) { g0[j] = scale; g1[j] = scale; } }
        const int row0 = u.pm * 256 + wr * 64 + fr + (u.half == 2 ? 128 : 0), col0 = pn * 256 + wc * 64 + 8 * fq;
        float posf[2][4], frq[8];
        if (mode == 1 || mode == 2) {
#pragma unroll
            for (int ai = 0; ai < 2; ++ai)
#pragma unroll
                for (int m = 0; m < 4; ++m) posf[ai][m] = (float)p.pos[row0 + (u.half ? 0 : ai * 128) + m * 16];
#pragma unroll
            for (int j = 0; j < 8; ++j) frq[j] = invfreq(8 * fq + j) * 0.15915494309189535f; }
#pragma unroll
        for (int ai = 0; ai < 2; ++ai) { if (ai == 1 && u.half) continue;
#pragma unroll
         for (int mp = 0; mp < 2; ++mp) {
#pragma unroll
            for (int mm = 0; mm < 2; ++mm) { const int m = 2 * mp + mm; const long row = row0 + ai * 128 + m * 16;
                float a[8], b[8];
#pragma unroll
                for (int j = 0; j < 4; ++j) { a[j] = acc[ai][0][m][0][j]; a[4 + j] = acc[ai][0][m][1][j]; b[j] = acc[ai][1][m][0][j]; b[4 + j] = acc[ai][1][m][1][j]; }
                if (mode == 1 || mode == 2) {
                    float r = 1.f;
                    if (mode == 2) { float ss = 0.f;
#pragma unroll
                        for (int j = 0; j < 8; ++j) ss += a[j] * a[j] + b[j] * b[j];
                        ss += __shfl_xor(ss, 16); ss += __shfl_xor(ss, 32); r = __builtin_amdgcn_rsqf(ss * (1.f / 64.f) + EPS); }
#pragma unroll
                    for (int j = 0; j < 8; ++j) { const float tr = __builtin_amdgcn_fractf(posf[ai][m] * frq[j]); const float cs = __builtin_amdgcn_cosf(tr), sn = __builtin_amdgcn_sinf(tr);
                        const float x1 = a[j] * r * g0[j], x2 = b[j] * r * g1[j];
                        a[j] = x1 * cs - x2 * sn; b[j] = x1 * sn + x2 * cs; } }
                else if (mode == 3) {
#pragma unroll
                    for (int j = 0; j < 8; ++j) { a[j] = silu_fast(a[j]); b[j] = silu_fast(b[j]); } }
                else if (mode == 4) {
#pragma unroll
                    for (int j = 0; j < 8; ++j) { a[j] = gelu_fast(a[j]); b[j] = gelu_fast(b[j]); } }
                pg8::u32x4 wa, wb;
                wa.x = pk_bf16(a[0], a[1]); wa.y = pk_bf16(a[2], a[3]); wa.z = pk_bf16(a[4], a[5]); wa.w = pk_bf16(a[6], a[7]);
                wb.x = pk_bf16(b[0], b[1]); wb.y = pk_bf16(b[2], b[3]); wb.z = pk_bf16(b[4], b[5]); wb.w = pk_bf16(b[6], b[7]);
                *(pg8::u32x4*)(Z + row * ZW + col0) = wa; *(pg8::u32x4*)(Z + row * ZW + col0 + 32) = wb; } } }
    }
};
typedef short s16x4_t __attribute__((ext_vector_type(4)));
typedef float f32x4m __attribute__((ext_vector_type(4)));
#define MFMA16(a, b, c) __builtin_amdgcn_mfma_f32_16x16x32_bf16((a), (b), (c), 0, 0, 0)
constexpr int LP = 144;
__device__ __forceinline__ s16x4_t lds_tr4(LAS const unsigned char* p) { return __builtin_bit_cast(s16x4_t, __builtin_amdgcn_ds_read_tr16_b64_v4i16((LAS s16x4_t*)p)); }
__device__ __forceinline__ s16x8_t tr_frag(LAS const unsigned char* X, int P, int k0, int c0, int lane) {
    const int fq = lane >> 4, q = (lane & 15) >> 2, pp = lane & 3;
    LAS const unsigned char* a = X + (k0 + 8 * fq + q) * P + (c0 + 4 * pp) * 2;
    const s16x4_t lo = lds_tr4(a), hi = lds_tr4(a + 4 * P);
    return (s16x8_t){lo[0], lo[1], lo[2], lo[3], hi[0], hi[1], hi[2], hi[3]};
}
__device__ __forceinline__ s16x8_t tr_frag_perm(LAS const unsigned char* X, int P, int k0, int c0, int lane) {
    const int fq = lane >> 4, q = (lane & 15) >> 2, pp = lane & 3;
    LAS const unsigned char* a = X + (k0 + 4 * fq + q) * P + (c0 + 4 * pp) * 2;
    const s16x4_t lo = lds_tr4(a), hi = lds_tr4(a + 16 * P);
    return (s16x8_t){lo[0], lo[1], lo[2], lo[3], hi[0], hi[1], hi[2], hi[3]};
}
__device__ __forceinline__ s16x8_t pack8(const f32x4m& a, const f32x4m& b) {
    const unsigned w0 = pk_bf16(a[0], a[1]), w1 = pk_bf16(a[2], a[3]), w2 = pk_bf16(b[0], b[1]), w3 = pk_bf16(b[2], b[3]);
    return __builtin_bit_cast(s16x8_t, (u32x4_t){w0, w1, w2, w3});
}
__device__ __forceinline__ float bflo(unsigned u) { return __builtin_bit_cast(float, u << 16); }
__device__ __forceinline__ float bfhi(unsigned u) { return __builtin_bit_cast(float, u & 0xffff0000u); }

struct CmpSched {
    static constexpr bool GATHER = false; static constexpr int GOFF_LDS = 0;
    const P* pp; int l, c;
    __device__ __forceinline__ bool next(int i, pg8::Unit& u) const { if (i > 0 || c >= 32) return false; u.pm = c & 7; u.pn = 0; u.aux = c >> 3; u.half = 0; return true; }
    __device__ __forceinline__ int ktiles() const { return 16; }
    __device__ __forceinline__ const char* a_base() const { return (const char*)(pp->ws + WS_Z); }
    __device__ __forceinline__ size_t a_kstep() const { return (size_t)ZW * 2; }
    __device__ __forceinline__ unsigned a_off(const pg8::Unit& u, int row, int C) const {
        const int R = u.pm * 256 + row, kv = u.aux & 1, g = u.aux >> 1;
        return (unsigned)(((size_t)R * 16 * ZW + (kv ? C_VC : C_KC) + g * 64 + C) * 2); }
    __device__ __forceinline__ unsigned b_ld() const { return 1024 * 2u; }
    __device__ __forceinline__ const char* b_tile(const pg8::Unit& u, int t) const { return (const char*)(pp->ws + WS_CW1_T) + (size_t)(l * 2 + (u.aux & 1)) * 256 * 1024 * 2 + (size_t)t * 128; }
};
struct EpiCmp {
    static constexpr bool PERM = false, AFTER_DRAIN = true;
    const P* pp; int l;
    __device__ __forceinline__ void operator()(const pg8::f32x4 (&)[2][2][4][2], const pg8::Unit&, int, int, int, int) const {}
    __device__ __forceinline__ void fused(const pg8::f32x4 (&acc)[2][2][4][2], const pg8::Unit& u, int wr, int wc, int fr, int fq, LAS unsigned char* lds) const {
        const P& p = *pp; const int kv = u.aux & 1, g = u.aux >> 1, lane = tid_fresh() & 63, w = tid_fresh() >> 6;
        constexpr int HP = 272;
        constexpr int HOFF = 257 * HP;
        const float* bias = WSP(float, WS_PEB) + (l * 2 + kv) * 128;
#pragma unroll
        for (int n = 0; n < 2; ++n) { const int c = 32 * wc + 16 * n + 4 * fq;
#pragma unroll
            for (int ai = 0; ai < 2; ++ai)
#pragma unroll
                for (int m = 0; m < 4; ++m) { const int r = 128 * ai + 64 * wr + 16 * m + fr; const f32x4m v = acc[ai][1][m][n];
                    u32x2_t o; o.x = pk_bf16(v[0], v[1]); o.y = pk_bf16(v[2], v[3]); *(LAS u32x2_t*)(lds + r * HP + c * 2) = o; } }
        if (tid_fresh() < 32) { unsigned zz = 0u; asm volatile("" : "+v"(zz)); *(LAS u32x2_t*)(lds + 256 * HP + tid_fresh() * 8) = (u32x2_t){zz, zz}; }
        __syncthreads();
#pragma unroll
        for (int n = 0; n < 2; ++n) { const int c = 32 * wc + 16 * n + 4 * fq; const f32x4m bv = *(const f32x4m*)(bias + c);
#pragma unroll
            for (int ai = 0; ai < 2; ++ai)
#pragma unroll
                for (int m = 0; m < 4; ++m) { const int r = 128 * ai + 64 * wr + 16 * m + fr; const u32x2_t u1 = *(const LAS u32x2_t*)(lds + (r + 1) * HP + c * 2);
                    const f32x4m v = acc[ai][0][m][n] + bv + (f32x4m){bflo(u1.x), bfhi(u1.x), bflo(u1.y), bfhi(u1.y)};
                    u32x2_t o; o.x = pk_bf16(gelu_fast(v[0]), gelu_fast(v[1])); o.y = pk_bf16(gelu_fast(v[2]), gelu_fast(v[3])); *(LAS u32x2_t*)(lds + HOFF + r * HP + c * 2) = o; } }
        __syncthreads();
        const bf16* W2 = WSP(bf16, WS_CW2_T) + (size_t)(l * 2 + kv) * 64 * 128;
        const float* gk = p.nsa_k_norm_g + (l * 3 + 0) * 64;
#pragma unroll
        for (int rt = 0; rt < 2; ++rt) {
            f32x4m o[4];
#pragma unroll
            for (int ct = 0; ct < 4; ++ct) o[ct] = (f32x4m){0.f, 0.f, 0.f, 0.f};
#pragma unroll
            for (int s = 0; s < 4; ++s) { const s16x8_t a = *(const LAS s16x8_t*)(lds + HOFF + (32 * w + 16 * rt + fr) * HP + (32 * s + 8 * fq) * 2);
#pragma unroll
                for (int ct = 0; ct < 4; ++ct) { const s16x8_t b = *(const s16x8_t*)(W2 + (16 * ct + fr) * 128 + 32 * s + 8 * fq); o[ct] = MFMA16(a, b, o[ct]); } }
            float csv[4][4];
            if (kv == 0) {
#pragma unroll
                for (int reg = 0; reg < 4; ++reg) { const int R = u.pm * 256 + 32 * w + 16 * rt + 4 * fq + reg, b = R >> 7, n = R & 127, nn = n < NCMP ? n : NCMP - 1;
                    const float* cs = WSP(float, WS_CS) + ((size_t)b * NS + 16 * nn + 31) * 64; csv[reg][0] = cs[fr]; csv[reg][1] = cs[32 + fr]; csv[reg][2] = cs[16 + fr]; csv[reg][3] = cs[48 + fr]; } }
#pragma unroll
            for (int reg = 0; reg < 4; ++reg) { const int R = u.pm * 256 + 32 * w + 16 * rt + 4 * fq + reg, b = R >> 7, n = R & 127;
                float v0 = o[0][reg], v1 = o[1][reg], v2 = o[2][reg], v3 = o[3][reg];
                if (kv == 0) { float ss = v0 * v0 + v1 * v1 + v2 * v2 + v3 * v3;
                    ss += __shfl_xor(ss, 1); ss += __shfl_xor(ss, 2); ss += __shfl_xor(ss, 4); ss += __shfl_xor(ss, 8);
                    const float r = 1.0f / sqrtf(ss * (1.f / 64.f) + EPS);
                    v0 *= r * gk[fr]; v1 *= r * gk[16 + fr]; v2 *= r * gk[32 + fr]; v3 *= r * gk[48 + fr];
                    const float c0 = csv[reg][0], s0 = csv[reg][1], c1 = csv[reg][2], s1 = csv[reg][3];
                    const float a0 = v0 * c0 - v2 * s0, a2 = v0 * s0 + v2 * c0, a1 = v1 * c1 - v3 * s1, a3 = v1 * s1 + v3 * c1; v0 = a0; v1 = a1; v2 = a2; v3 = a3; }
                { if (n >= NCMP) { v0 = 0.f; v1 = 0.f; v2 = 0.f; v3 = 0.f; }
                    bf16* dst = (kv ? WSP(bf16, WS_VC) : WSP(bf16, WS_KC)) + ((size_t)(b * 2 + g) * (NCMP + 1) + n) * 64;
                    dst[fr] = f2bf(v0); dst[16 + fr] = f2bf(v1); dst[32 + fr] = f2bf(v2); dst[48 + fr] = f2bf(v3); } }
        }
        __syncthreads();
    }
};
__device__ __forceinline__ void ret_kv_unit(const P& p, LAS unsigned char* lds, int l, int unit) {
    const int tid = tid_fresh(), lane = tid & 63, w = tid >> 6, fr = lane & 15, fq = lane >> 4;
    const int c = unit % NCH, h = (unit / NCH) % 4, b = unit / (NCH * 4);
    const bf16* Z = WSP(bf16, WS_Z); const size_t m0 = (size_t)b * NS + (size_t)c * 128;
    const float lg2 = log2f(1.f - exp2f(-5.f - (float)h));
    LAS unsigned char* KL = lds; LAS unsigned char* VL = lds + 128 * LP;
#pragma unroll
    for (int i = 0; i < 2; ++i) { const int pc = tid + i * NTH, r = pc >> 3, q = pc & 7;
        const u32x4_t kw = *(const u32x4_t*)(Z + (m0 + r) * ZW + C_RK + 64 * h + q * 8), vw = *(const u32x4_t*)(Z + (m0 + r) * ZW + C_RV + 64 * h + q * 8);
        const float dk = exp2f((float)(127 - r) * lg2); u32x4_t ko;
#pragma unroll
        for (int j = 0; j < 4; ++j) ko[j] = pk_bf16(bflo(kw[j]) * dk, bfhi(kw[j]) * dk);
        *(LAS u32x4_t*)(KL + r * LP + q * 16) = ko; *(LAS u32x4_t*)(VL + r * LP + q * 16) = vw; }
    __syncthreads();
    const int et = w >> 1, d0 = 2 * (w & 1);
    f32x4m a0 = {0.f, 0.f, 0.f, 0.f}, a1 = {0.f, 0.f, 0.f, 0.f};
#pragma unroll
    for (int ks = 0; ks < 4; ++ks) { const s16x8_t va = tr_frag(VL, LP, 32 * ks, 16 * et, lane);
        a0 = MFMA16(va, tr_frag(KL, LP, 32 * ks, 16 * d0, lane), a0); a1 = MFMA16(va, tr_frag(KL, LP, 32 * ks, 16 * (d0 + 1), lane), a1); }
    float* KV = WSP(float, WS_KVS) + (size_t)unit * 4096;
#pragma unroll
    for (int reg = 0; reg < 4; ++reg) { const int e = 16 * et + 4 * fq + reg; KV[e * 64 + 16 * d0 + fr] = a0[reg]; KV[e * 64 + 16 * (d0 + 1) + fr] = a1[reg]; }
    __syncthreads();
}

__device__ __forceinline__ void ret_out_unit(const P& p, LAS unsigned char* lds, int l, int unit) {
    const int tid = tid_fresh(), lane = tid & 63, w = tid >> 6, fr = lane & 15, fq = lane >> 4;
    const int c = unit % NCH, h = (unit / NCH) % 4, b = unit / (NCH * 4);
    const bf16* Z = WSP(bf16, WS_Z); bf16* MIX = WSP(bf16, WS_MIX); const size_t m0 = (size_t)b * NS + (size_t)c * 128;
    const float lg2 = log2f(1.f - exp2f(-5.f - (float)h));
    LAS unsigned char* KL = lds; LAS unsigned char* VL = lds + 128 * LP; LAS unsigned char* ST = lds + 256 * LP;
#pragma unroll
    for (int i = 0; i < 2; ++i) { const int pc = tid + i * NTH, r = pc >> 3, q = pc & 7;
        *(LAS u32x4_t*)(KL + r * LP + q * 16) = *(const u32x4_t*)(Z + (m0 + r) * ZW + C_RK + 64 * h + q * 8);
        *(LAS u32x4_t*)(VL + r * LP + q * 16) = *(const u32x4_t*)(Z + (m0 + r) * ZW + C_RV + 64 * h + q * 8); }
    {
        const float lgc = 128.f * lg2; const float* KV = WSP(float, WS_KVS) + (size_t)(unit - c) * 4096 + tid * 8;
        f32x4m s0 = {0.f, 0.f, 0.f, 0.f}, s1 = {0.f, 0.f, 0.f, 0.f};
        f32x4m ld0[NCH - 1], ld1[NCH - 1];
#pragma unroll
        for (int cc = 0; cc < NCH - 1; ++cc) { ld0[cc] = *(const f32x4m*)(KV + (size_t)cc * 4096); ld1[cc] = *(const f32x4m*)(KV + (size_t)cc * 4096 + 4); }
#pragma unroll
        for (int cc = 0; cc < NCH - 1; ++cc) { const float wgt = cc < c ? __builtin_amdgcn_exp2f((float)(c - 1 - cc) * lgc) : 0.f; s0 += ld0[cc] * wgt; s1 += ld1[cc] * wgt; }
        const int e = tid >> 3, d = (tid & 7) * 8; u32x4_t o; o.x = pk_bf16(s0[0], s0[1]); o.y = pk_bf16(s0[2], s0[3]); o.z = pk_bf16(s1[0], s1[1]); o.w = pk_bf16(s1[2], s1[3]);
        *(LAS u32x4_t*)(ST + e * LP + d * 2) = o; }
    __syncthreads();
    const size_t mq = m0 + 16 * w + fr; const int nq = 16 * w + fr;
    s16x8_t qf[2];
#pragma unroll
    for (int s = 0; s < 2; ++s) qf[s] = *(const s16x8_t*)(Z + mq * ZW + C_RQ + 64 * h + 32 * s + 8 * fq);
    f32x4m O[4];
#pragma unroll
    for (int dt = 0; dt < 4; ++dt) O[dt] = (f32x4m){0.f, 0.f, 0.f, 0.f};
    for (int ks = 0; ks <= (w >> 1); ++ks) {
        f32x4m S2[2];
#pragma unroll
        for (int t = 0; t < 2; ++t) { const int kt = 2 * ks + t; f32x4m sacc = {0.f, 0.f, 0.f, 0.f};
#pragma unroll
            for (int s = 0; s < 2; ++s) sacc = MFMA16(*(const LAS s16x8_t*)(KL + (16 * kt + fr) * LP + (32 * s + 8 * fq) * 2), qf[s], sacc);
#pragma unroll
            for (int reg = 0; reg < 4; ++reg) { const int kk = 16 * kt + 4 * fq + reg; sacc[reg] = kk <= nq ? sacc[reg] * __builtin_amdgcn_exp2f((float)(nq - kk) * lg2) : 0.f; }
            S2[t] = sacc; }
        const s16x8_t pf = pack8(S2[0], S2[1]);
#pragma unroll
        for (int dt = 0; dt < 4; ++dt) O[dt] = MFMA16(tr_frag_perm(VL, LP, 32 * ks, 16 * dt, lane), pf, O[dt]);
    }
    { const float dq = exp2f((float)(nq + 1) * lg2);
#pragma unroll
      for (int dt = 0; dt < 4; ++dt) { f32x4m t = {0.f, 0.f, 0.f, 0.f};
#pragma unroll
          for (int s = 0; s < 2; ++s) t = MFMA16(*(const LAS s16x8_t*)(ST + (16 * dt + fr) * LP + (32 * s + 8 * fq) * 2), qf[s], t);
          O[dt] += t * dq; } }
    float ss = 0.f;
#pragma unroll
    for (int dt = 0; dt < 4; ++dt) ss += O[dt][0] * O[dt][0] + O[dt][1] * O[dt][1] + O[dt][2] * O[dt][2] + O[dt][3] * O[dt][3];
    ss += __shfl_xor(ss, 16); ss += __shfl_xor(ss, 32);
    const float r = 1.0f / sqrtf(ss * (1.f / 64.f) + EPS);
    f32x4m gnv[4]; u32x2_t rgv[4];
#pragma unroll
    for (int dt = 0; dt < 4; ++dt) { const int e = 16 * dt + 4 * fq; gnv[dt] = *(const f32x4m*)(p.ret_norm_g + (l * 4 + h) * 64 + e); rgv[dt] = *(const u32x2_t*)(Z + mq * ZW + C_RG + 64 * h + e); }
#pragma unroll
    for (int dt = 0; dt < 4; ++dt) { const int e = 16 * dt + 4 * fq; const f32x4m gn = gnv[dt];
        const u32x2_t rg = rgv[dt];
        u32x2_t o; o.x = pk_bf16(O[dt][0] * r * gn[0] * bflo(rg.x), O[dt][1] * r * gn[1] * bfhi(rg.x)); o.y = pk_bf16(O[dt][2] * r * gn[2] * bflo(rg.y), O[dt][3] * r * gn[3] * bfhi(rg.y));
        *(u32x2_t*)(MIX + mq * D + 64 * h + e) = o; }
    __syncthreads();
}
__device__ __forceinline__ void gmlp_unit(const P& p, LAS unsigned char* lds, int l, int unit) {
    const int tid = tid_fresh(), lane = tid & 63, w = tid >> 6, fr = lane & 15, fq = lane >> 4;
    const bf16* Z = WSP(bf16, WS_Z); bf16* MIX = WSP(bf16, WS_MIX); const size_t m0 = (size_t)unit * 128;
    constexpr int VP = 528;
    { const int r = tid >> 2, q = tid & 3; const bf16* src = Z + (m0 + r) * ZW + C_GV + q * 64;
      u32x4_t v[8]; float s = 0.f;
#pragma unroll
      for (int i = 0; i < 8; ++i) { v[i] = *(const u32x4_t*)(src + i * 8);
#pragma unroll
          for (int j = 0; j < 4; ++j) s += bflo(v[i][j]) + bfhi(v[i][j]); }
      s += __shfl_xor(s, 1); s += __shfl_xor(s, 2); const float mu = s * (1.f / 256.f); float s2 = 0.f;
#pragma unroll
      for (int i = 0; i < 8; ++i)
#pragma unroll
          for (int j = 0; j < 4; ++j) { const float a = bflo(v[i][j]) - mu, b2 = bfhi(v[i][j]) - mu; s2 += a * a + b2 * b2; }
      s2 += __shfl_xor(s2, 1); s2 += __shfl_xor(s2, 2); const float rstd = 1.0f / sqrtf(s2 * (1.f / 256.f) + EPS);
      const float* gl = p.gmlp_ln_g + l * 256 + q * 64;
#pragma unroll
      for (int i = 0; i < 8; ++i) { u32x4_t o;
#pragma unroll
          for (int j = 0; j < 4; ++j) o[j] = pk_bf16((bflo(v[i][j]) - mu) * rstd * gl[i * 8 + 2 * j], (bfhi(v[i][j]) - mu) * rstd * gl[i * 8 + 2 * j + 1]);
          *(LAS u32x4_t*)(lds + r * VP + (q * 64 + i * 8) * 2) = o; } }
    __syncthreads();
    const int t0 = 16 * w, nks = (w >> 1) + 1;
    constexpr int SOFF = 128 * VP;
    LAS unsigned char* ST = lds + SOFF + w * 16 * VP;
    s16x8_t wf[4][4];
#pragma unroll
    for (int g = 0; g < 4; ++g)
#pragma unroll
        for (int ks = 0; ks < 4; ++ks) wf[g][ks] = ks < nks ? *(const s16x8_t*)(WSP(bf16, WS_GWS) + (size_t)(l * 4 + g) * 128 * 128 + (t0 + fr) * 128 + 32 * ks + 8 * fq) : (s16x8_t){0, 0, 0, 0, 0, 0, 0, 0};
    float bsv[4][4];
#pragma unroll
    for (int g = 0; g < 4; ++g)
#pragma unroll
        for (int reg = 0; reg < 4; ++reg) bsv[g][reg] = p.gmlp_b[(l * 4 + g) * 128 + t0 + 4 * fq + reg];
    const int orow = lane >> 2, oseg = lane & 3; u32x4_t uv[8];
#pragma unroll
    for (int k = 0; k < 8; ++k) uv[k] = *(const u32x4_t*)(Z + (m0 + t0 + orow) * ZW + C_GU + 64 * oseg + 8 * k);
#pragma unroll
    for (int g = 0; g < 4; ++g) {
        f32x4m acc[4];
#pragma unroll
        for (int ct = 0; ct < 4; ++ct) acc[ct] = (f32x4m){0.f, 0.f, 0.f, 0.f};
#pragma unroll
        for (int ks = 0; ks < 4; ++ks) { if (ks < nks) {
#pragma unroll
            for (int ct = 0; ct < 4; ++ct) acc[ct] = MFMA16(wf[g][ks], tr_frag(lds, VP, 32 * ks, 64 * g + 16 * ct, lane), acc[ct]); } }
#pragma unroll
        for (int reg = 0; reg < 4; ++reg)
#pragma unroll
            for (int ct = 0; ct < 4; ++ct) *(LAS bf16*)(ST + (4 * fq + reg) * VP + (64 * g + 16 * ct + fr) * 2) = f2bf(acc[ct][reg] + bsv[g][reg]);
    }
#pragma unroll
    for (int k = 0; k < 8; ++k) { const u32x4_t sv = *(const LAS u32x4_t*)(ST + orow * VP + (64 * oseg + 8 * k) * 2); u32x4_t o;
#pragma unroll
        for (int q = 0; q < 4; ++q) o[q] = pk_bf16(bflo(uv[k][q]) * bflo(sv[q]), bfhi(uv[k][q]) * bfhi(sv[q]));
        *(u32x4_t*)(MIX + (m0 + t0 + orow) * D + 256 + 64 * oseg + 8 * k) = o; }
    __syncthreads();
}
__device__ __forceinline__ void premix_phase(const P& p, LAS unsigned char* lds, int l) {
    { CmpSched S; S.pp = &p; S.l = l; S.c = bid_fresh(); EpiCmp E{&p, l}; pg8::gemm_phase(lds, S, E); }
    const int G = grid_fresh(), bx = bid_fresh();
    if (G > 64) { if (bx >= 32) { for (int u = bx - 32; u < NB * 4 * NCH; u += G - 32) ret_kv_unit(p, lds, l, u); for (int u = bx - 32; u < NB * NCH; u += G - 32) gmlp_unit(p, lds, l, u); } }
    else { for (int u = bx; u < NB * 4 * NCH; u += G) ret_kv_unit(p, lds, l, u); for (int u = bx; u < NB * NCH; u += G) gmlp_unit(p, lds, l, u); }
}

__device__ __forceinline__ s16x8_t tr_frag_perm_swz(LAS const unsigned char* X, int k0, int c0, int lane) {
    const int fq = lane >> 4, q = (lane & 15) >> 2, pp = lane & 3, row = k0 + 4 * fq + q, col = c0 + 4 * pp;
    LAS const unsigned char* a = X + row * 128 + ((((col >> 3) ^ (row & 7))) << 4) + (col & 7) * 2;
    const s16x4_t lo = lds_tr4(a), hi = lds_tr4(a + 16 * 128);
    return (s16x8_t){lo[0], lo[1], lo[2], lo[3], hi[0], hi[1], hi[2], hi[3]};
}
constexpr int NSA_KV = 2 * 64 * 128;
constexpr int NSA_IMP = 3 * NSA_KV, NSA_INVL = NSA_IMP + 8 * 8192, NSA_SELM = NSA_INVL + 64 * 4 * 4;
static_assert(NSA_SELM + 256 <= 147456 - 64, "NSA LDS map");
__device__ __forceinline__ void nsa_unit(const P& p, LAS unsigned char* lds, int l, int b, int g, int i) {
    const int tid = tid_fresh(), lane = tid & 63, w = tid >> 6, fr = lane & 15, fq = lane >> 4;
    const bf16* Z = WSP(bf16, WS_Z); bf16* MIX = WSP(bf16, WS_MIX); const float* GL = WSP(float, WS_GL);
    const size_t mb = (size_t)b * NS;
    const int nc = (i >= 16) ? 2 : 1, wlo = i > 8 ? i - 8 : 0, nblk = nc + (i + 1) + (i - wlo + 1);
    LAS float* IMPH = (LAS float*)(lds + NSA_IMP + w * 8192); LAS float* INVL = (LAS float*)(lds + NSA_INVL); LAS unsigned* SELM = (LAS unsigned*)(lds + NSA_SELM);
    LAS f32x4m* OFL = (LAS f32x4m*)(lds + NSA_IMP + w * 8192 + lane * 16);
    int tok[2]; s16x8_t qf[2][2];
#pragma unroll
    for (int qt = 0; qt < 2; ++qt) { tok[qt] = 8 * w + 4 * qt + (fr >> 2);
#pragma unroll
        for (int s = 0; s < 2; ++s) qf[qt][s] = *(const s16x8_t*)(Z + (mb + 64 * i + tok[qt]) * ZW + C_NQ + 64 * (4 * g + (fr & 3)) + 32 * s + 8 * fq); }
    f32x4m O[2][4]; float lsum[2] = {0.f, 0.f}; float carry[2] = {0.f, 0.f}; unsigned selm[2] = {0u, 0u};
#pragma unroll
    for (int qt = 0; qt < 2; ++qt)
#pragma unroll
        for (int dt = 0; dt < 4; ++dt) O[qt][dt] = (f32x4m){0.f, 0.f, 0.f, 0.f};
    const int skey = tid >> 3, spx = (tid & 7) ^ (skey & 7);
    auto kv_ptrs = [&](int it, const bf16*& kp, const bf16*& vp) {
        if (it < nc) { const size_t o = ((size_t)(b * 2 + g) * (NCMP + 1) + 64 * it + skey) * 64 + spx * 8; kp = WSP(bf16, WS_KC) + o; vp = WSP(bf16, WS_VC) + o; }
        else if (it < nc + i + 1) { const size_t o = (mb + 64 * (it - nc) + skey) * ZW + 64 * g + spx * 8; kp = Z + o + C_KS; vp = Z + o + C_VS; }
        else { const size_t o = (mb + 64 * (wlo + it - nc - i - 1) + skey) * ZW + 64 * g + spx * 8; kp = Z + o + C_KW; vp = Z + o + C_VW; } };
    asm volatile("" : "+v"(qf[0][0]), "+v"(qf[0][1]), "+v"(qf[1][0]), "+v"(qf[1][1]));
    float bnd_c = WSP(float, WS_BND)[l * 3 + 0], bnd_s = WSP(float, WS_BND)[l * 3 + 1], bnd_w = WSP(float, WS_BND)[l * 3 + 2];
    asm volatile("" : "+v"(bnd_c), "+v"(bnd_s), "+v"(bnd_w));
#define NSA_DMA(IT, BUF) do { const bf16 *kp_, *vp_; kv_ptrs((IT), kp_, vp_); \
        const unsigned lb_ = (unsigned)__builtin_amdgcn_readfirstlane((int)((unsigned)(size_t)lds + (unsigned)((BUF) * NSA_KV) + (unsigned)w * 1024u)); unsigned sv_; \
        asm volatile("s_mov_b32 %0, m0\n\ts_mov_b32 m0, %3\n\ts_nop 0\n\tglobal_load_lds_dwordx4 %1, off\n\ts_add_u32 m0, m0, 0x2000\n\ts_nop 0\n\tglobal_load_lds_dwordx4 %2, off\n\ts_mov_b32 m0, %0" \
                     : "=&s"(sv_) : "v"(kp_), "v"(vp_), "s"(lb_) : "memory"); } while (0)
    __syncthreads();
    NSA_DMA(0, 0);
    if (nblk > 1) { NSA_DMA(1, 1); asm volatile("s_waitcnt vmcnt(2)" ::: "memory"); } else asm volatile("s_waitcnt vmcnt(0)" ::: "memory");
    __builtin_amdgcn_s_barrier(); asm volatile("" ::: "memory");
    int bufc = 0;
#pragma unroll 1
    for (int it = 0; it < nblk; ++it) {
        const bool dma_now = it + 2 < nblk;
        if (dma_now) { const int bn = bufc == 0 ? 2 : bufc - 1; NSA_DMA(it + 2, bn); }
        LAS const unsigned char* Kb = lds + bufc * NSA_KV; LAS const unsigned char* Vb = Kb + 8192;
        const int br = it < nc ? 0 : (it < nc + i + 1 ? 1 : 2);
        const int j = br == 0 ? it : (br == 1 ? it - nc : wlo + it - nc - i - 1);
        const float bnd = br == 0 ? bnd_c : (br == 1 ? bnd_s : bnd_w);
        const bool needmask = (br == 0) || (j == i) || (br == 2 && j == i - 8);
        const bool lower = (br == 2 && j == i - 8);
        bool rowok[2]; int thr[2]; float oa[2], ob[2];
#pragma unroll
        for (int qt = 0; qt < 2; ++qt) {
            rowok[qt] = (br == 1) ? (((selm[qt] >> j) & 1u) != 0u) : true;
            thr[qt] = (br == 0) ? ((64 * i + tok[qt] - 31) >> 4) - 64 * j : tok[qt];
            const float on = rowok[qt] ? bnd : 1e30f;
            oa[qt] = lower ? 1e30f : on; ob[qt] = lower ? on : 1e30f; }
        const bool act0 = __ballot(rowok[0]) != 0ull, act1 = __ballot(rowok[1]) != 0ull;
        if (act0 || act1) {
            f32x4m pv[2][4];
#pragma unroll
            for (int qt = 0; qt < 2; ++qt)
#pragma unroll
                for (int kt = 0; kt < 4; ++kt) pv[qt][kt] = (f32x4m){0.f, 0.f, 0.f, 0.f};
#pragma unroll
            for (int sI = 0; sI < 2; ++sI) { s16x8_t kf[4];
#pragma unroll
                for (int kt = 0; kt < 4; ++kt) kf[kt] = *(const LAS s16x8_t*)(Kb + (16 * kt + fr) * 128 + (((4 * sI + fq) ^ (fr & 7)) << 4));
#pragma unroll
                for (int kt = 0; kt < 4; ++kt)
#pragma unroll
                    for (int qt = 0; qt < 2; ++qt) pv[qt][kt] = MFMA16(kf[kt], qf[qt][sI], pv[qt][kt]); }
            s16x8_t vf[2][4];
#pragma unroll
            for (int ks = 0; ks < 2; ++ks)
#pragma unroll
                for (int dt = 0; dt < 4; ++dt) vf[ks][dt] = tr_frag_perm_swz(Vb, 32 * ks, 16 * dt, lane);
#pragma unroll
            for (int qt = 0; qt < 2; ++qt) {
                if (needmask) {
#pragma unroll
                    for (int kt = 0; kt < 4; ++kt)
#pragma unroll
                        for (int reg = 0; reg < 4; ++reg) { const int kk = 16 * kt + 4 * fq + reg; const float off = kk <= thr[qt] ? oa[qt] : ob[qt];
                            pv[qt][kt][reg] = __builtin_amdgcn_exp2f(pv[qt][kt][reg] * 1.4426950408889634f - off); lsum[qt] += pv[qt][kt][reg]; } }
                else {
#pragma unroll
                    for (int kt = 0; kt < 4; ++kt)
#pragma unroll
                        for (int reg = 0; reg < 4; ++reg) { pv[qt][kt][reg] = __builtin_amdgcn_exp2f(pv[qt][kt][reg] * 1.4426950408889634f - oa[qt]); lsum[qt] += pv[qt][kt][reg]; } }
                if (br == 0) {
                    const int src = (lane + 48) & 63;
#pragma unroll
                    for (int kt = 0; kt < 4; ++kt) { const float a4 = pv[qt][kt][0] + pv[qt][kt][1] + pv[qt][kt][2] + pv[qt][kt][3];
                        const float xs = __shfl(pv[qt][kt][3], src), xp = __shfl(kt == 0 ? carry[qt] : pv[qt][kt > 0 ? kt - 1 : 0][3], src);
                        IMPH[((4 * qt + (fr >> 2)) * 4 + (fr & 3)) * 32 + 16 * j + 4 * kt + fq] = a4 + (fq == 0 ? xp : xs); }
                    carry[qt] = pv[qt][3][3]; }
                const s16x8_t pfa = pack8(pv[qt][0], pv[qt][1]), pfb = pack8(pv[qt][2], pv[qt][3]);
#pragma unroll
                for (int dt = 0; dt < 4; ++dt) O[qt][dt] = MFMA16(vf[0][dt], pfa, O[qt][dt]);
#pragma unroll
                for (int dt = 0; dt < 4; ++dt) O[qt][dt] = MFMA16(vf[1][dt], pfb, O[qt][dt]);
                __builtin_amdgcn_sched_barrier(0);
            }
        }
        const bool bend = (it == nc - 1) || (it == nc + i) || (it == nblk - 1);
        if (bend) {
            float scl[2];
#pragma unroll
            for (int qt = 0; qt < 2; ++qt) { float ls = lsum[qt]; ls += __shfl_xor(ls, 16); ls += __shfl_xor(ls, 32);
                const float inv = ls > 0.f ? 1.0f / ls : 0.f;
                const float gate = 1.0f / (1.0f + __expf(-GL[(mb + 64 * i + tok[qt]) * 24 + (4 * g + (fr & 3)) * 3 + br]));
                scl[qt] = gate * inv; lsum[qt] = 0.f;
                if (br == 0 && fq == 0) INVL[tok[qt] * 4 + (fr & 3)] = inv; }
            if (br == 0) {
#pragma unroll 1
                for (int rnd = 0; rnd < 4; ++rnd) { const int tk = 8 * w + 2 * rnd + (lane >> 5), jj = lane & 31;
                    const bool forced = (jj == 0) || (jj == i) || (jj == i - 1);
                    float sc = -1.f;
                    if (jj <= i) { sc = 0.f;
#pragma unroll
                        for (int r = 0; r < 4; ++r) sc += IMPH[((2 * rnd + (lane >> 5)) * 4 + r) * 32 + jj] * INVL[tk * 4 + r]; }
                    if (forced) sc = 1e4f;
                    int rank = 0;
#pragma unroll
                    for (int d = 1; d < 32; ++d) { const int oj = (jj + d) & 31; const float o = __shfl(sc, (lane & 32) | oj); rank += (o > sc || (o == sc && oj < jj)) ? 1 : 0; }
                    const unsigned long long bal = __ballot(rank < 8);
                    if (lane == 0) { SELM[8 * w + 2 * rnd] = (unsigned)bal; SELM[8 * w + 2 * rnd + 1] = (unsigned)(bal >> 32); } }
                selm[0] = SELM[tok[0]]; selm[1] = SELM[tok[1]];
            }
#pragma unroll
            for (int qt = 0; qt < 2; ++qt)
#pragma unroll
                for (int dt = 0; dt < 4; ++dt) { const f32x4m prev = br == 0 ? (f32x4m){0.f, 0.f, 0.f, 0.f} : OFL[(qt * 4 + dt) * 64]; OFL[(qt * 4 + dt) * 64] = prev + O[qt][dt] * scl[qt]; O[qt][dt] = (f32x4m){0.f, 0.f, 0.f, 0.f}; }
        }
        if (dma_now) asm volatile("s_waitcnt vmcnt(2)" ::: "memory"); else asm volatile("s_waitcnt vmcnt(0)" ::: "memory");
        asm volatile("s_waitcnt lgkmcnt(0)" ::: "memory");
        __builtin_amdgcn_s_barrier(); asm volatile("" ::: "memory");
        bufc = bufc == 2 ? 0 : bufc + 1;
    }
#undef NSA_DMA
#pragma unroll
    for (int qt = 0; qt < 2; ++qt)
#pragma unroll
        for (int dt = 0; dt < 4; ++dt) { const f32x4m of = OFL[(qt * 4 + dt) * 64]; u32x2_t o; o.x = pk_bf16(of[0], of[1]); o.y = pk_bf16(of[2], of[3]);
            *(u32x2_t*)(MIX + (mb + 64 * i + tok[qt]) * D + 512 + 64 * (4 * g + (fr & 3)) + 16 * dt + 4 * fq) = o; }
}
__device__ __forceinline__ void nsa_units(const P& p, LAS unsigned char* lds, int l, int vcu, int G) {
    for (int u = vcu; u < NB * 2 * NSEL; u += G) { const int k = u >> 8, v = u & 255, bg = v >> 3, r8 = v & 7;
        const int i = k == 0 ? 31 - r8 : (k == 1 ? 16 + r8 : (k == 2 ? 15 - r8 : r8));
        nsa_unit(p, lds, l, bg >> 1, bg & 1, i); }
}
constexpr int MOE_TAB = 131072;
constexpr size_t WS_ACT = WS_Z;
static_assert((size_t)(M + 24 * 256) * 1024 * 2 <= (size_t)M * ZW * 2, "ACT must fit inside Z");
__device__ __forceinline__ void moe_table(const P& p, LAS unsigned char* lds, int l) {
    LAS int* tab = LDSP(int, MOE_TAB);
    if (tid_fresh() == 0) { int acc = 0; for (int c = 0; c < 24; ++c) { const int n = WSP(int, WS_CTL)[CW_CNT + l * 64 + c]; tab[c] = acc; tab[25 + c] = n; acc += (n + 255) >> 8; } tab[24] = acc; }
    __syncthreads();
}
__device__ __forceinline__ void pair_experts(int cls, int& ea, int& eb) { const int g = cls / 6, pr = cls % 6; const int lo = pr < 3 ? 0 : (pr < 5 ? 1 : 2), hi = pr < 3 ? pr + 1 : (pr < 5 ? pr - 1 : 3); ea = g * 4 + lo; eb = g * 4 + hi; }
template <int NPN> struct MoeSchedBase {
    const P* pp; LAS int* tab; int l, G, c;
    __device__ __forceinline__ bool next(int i, pg8::Unit& u) const {
        int L, hf; if (!pg8::deal_unit(i, G, c, tab[24] * NPN, L, hf)) return false; u.half = hf;
        const int rt = L / NPN; int cls = 0;
        for (int k = 1; k < 24; ++k) cls = (tab[k] <= rt) ? k : cls;
        while (tab[25 + cls] == 0 && cls > 0) --cls;
        u.pm = rt; u.pn = L % NPN; u.aux = cls | ((rt - tab[cls]) << 8); return true;
    }
};
struct MoeSchedA : MoeSchedBase<8> {
    static constexpr bool GATHER = true; static constexpr int GOFF_LDS = MOE_TAB + 1024;
    __device__ __forceinline__ int ktiles() const { return D / 64; }
    __device__ __forceinline__ size_t a_kstep() const { return 128; }
    __device__ __forceinline__ const char* a_base() const { return (const char*)(pp->ws + WS_H); }
    __device__ __forceinline__ unsigned a_off(const pg8::Unit& u, int row, int C) const {
        const P& p = *pp; const int cls = u.aux & 255, slot = (u.aux >> 8) * 256 + row, n = tab[25 + cls];
        const int tok = WSP(int, WS_CTOK)[(size_t)cls * M + (slot < n ? slot : 0)];
        return (unsigned)(tok * D + C) * 2u; }
    __device__ __forceinline__ unsigned b_ld() const { return D * 2u; }
    __device__ __forceinline__ const char* b_tile(const pg8::Unit& u, int t) const {
        int ea, eb; pair_experts(u.aux & 255, ea, eb); const int e = u.pn < 4 ? ea : eb;
        return (const char*)(pp->ws + WS_WGU_T) + ((size_t)(l * 16 + e) * 1024 + (size_t)(u.pn & 3) * 256) * D * 2 + (size_t)t * 128; }
};
struct MoeSchedB : MoeSchedBase<4> {
    static constexpr bool GATHER = false; static constexpr int GOFF_LDS = 0;
    __device__ __forceinline__ int ktiles() const { return 16; }
    __device__ __forceinline__ size_t a_kstep() const { return 128; }
    __device__ __forceinline__ const char* a_base() const { return (const char*)(pp->ws + WS_ACT); }
    __device__ __forceinline__ unsigned a_off(const pg8::Unit& u, int row, int C) const { return (unsigned)((u.pm * 256 + row) * 1024 + C) * 2u; }
    __device__ __forceinline__ unsigned b_ld() const { return 512 * 2u; }
    __device__ __forceinline__ const char* b_tile(const pg8::Unit& u, int t) const {
        int ea, eb; pair_experts(u.aux & 255, ea, eb); const int e = t < 8 ? ea : eb;
        return (const char*)(pp->ws + WS_WD_T) + ((size_t)(l * 16 + e) * D + (size_t)u.pn * 256) * 512 * 2 + (size_t)(t & 7) * 128; }
};
struct EpiMoeA {
    static constexpr bool PERM = true, AFTER_DRAIN = false;
    const P* pp; LAS int* tab;
    __device__ __forceinline__ void operator()(const pg8::f32x4 (&acc)[2][2][4][2], const pg8::Unit& u, int wr, int wc, int fr, int fq) const {
        const P& p = *pp; const int cls = u.aux & 255, s0 = (u.aux >> 8) * 256, n = tab[25 + cls], which = u.pn >> 2;
        bf16* O = WSP(bf16, WS_ACT);
        float wts[2][4];
#pragma unroll
        for (int ai = 0; ai < 2; ++ai)
#pragma unroll
            for (int m = 0; m < 4; ++m) { const int slot = s0 + (u.half ? 0 : ai * 128) + wr * 64 + m * 16 + fr + (u.half == 2 ? 128 : 0); wts[ai][m] = slot < n ? WSP(float, WS_CWT)[((size_t)cls * M + slot) * 2 + which] : 0.f; }
#pragma unroll
        for (int ai = 0; ai < 2; ++ai)
#pragma unroll
            for (int m = 0; m < 4; ++m) { if (ai == 1 && u.half) continue; const int r = ai * 128 + wr * 64 + m * 16 + fr + (u.half == 2 ? 128 : 0);
                const float w = wts[ai][m];
                const pg8::f32x4 g0 = acc[ai][0][m][0], g1 = acc[ai][0][m][1], u0 = acc[ai][1][m][0], u1 = acc[ai][1][m][1];
                float v[8];
#pragma unroll
                for (int j = 0; j < 4; ++j) { v[j] = w * silu_fast(g0[j]) * u0[j]; v[4 + j] = w * silu_fast(g1[j]) * u1[j]; }
                pg8::u32x4 o; o.x = pk_bf16(v[0], v[1]); o.y = pk_bf16(v[2], v[3]); o.z = pk_bf16(v[4], v[5]); o.w = pk_bf16(v[6], v[7]);
                *(pg8::u32x4*)(O + (size_t)(u.pm * 256 + r) * 1024 + u.pn * 128 + wc * 32 + 8 * fq) = o; }
    }
};
struct EpiMoeB {
    static constexpr bool PERM = true, AFTER_DRAIN = false;
    const P* pp; LAS int* tab; int l; bool dry; const bf16* xin; void* xout; bool obf;
    __device__ __forceinline__ void operator()(const pg8::f32x4 (&acc)[2][2][4][2], const pg8::Unit& u, int wr, int wc, int fr, int fq) const {
        const P& p = *pp; const int cls = u.aux & 255, s0 = (u.aux >> 8) * 256, n = dry ? 0 : tab[25 + cls], col0 = u.pn * 256 + wc * 32 + 8 * fq;
        int toks[2][4];
#pragma unroll
        for (int ai = 0; ai < 2; ++ai)
#pragma unroll
            for (int m = 0; m < 4; ++m) { const int slot = s0 + (u.half ? 0 : ai * 128) + wr * 64 + m * 16 + fr + (u.half == 2 ? 128 : 0); toks[ai][m] = slot < n ? WSP(int, WS_CTOK)[(size_t)cls * M + slot] : -1; }
#pragma unroll
        for (int ai = 0; ai < 2; ++ai) { if (ai == 1 && u.half) continue;
#pragma unroll
            for (int mp = 0; mp < 2; ++mp) {
                pg8::u32x4 xw[2][2]; pg8::f32x4 ga[2][2], gb[2][2];
#pragma unroll
                for (int mm = 0; mm < 2; ++mm) { const int tok = toks[ai][2 * mp + mm], tk = tok < 0 ? 0 : tok;
                    const float* gp = WSP(float, WS_MOD) + ((size_t)l * NB + tk / NS) * 6144 + 5120 + col0; const size_t ro = (size_t)tk * D + col0;
#pragma unroll
                    for (int bj = 0; bj < 2; ++bj) { xw[mm][bj] = *(const pg8::u32x4*)(xin + ro + bj * 128); ga[mm][bj] = *(const pg8::f32x4*)(gp + bj * 128); gb[mm][bj] = *(const pg8::f32x4*)(gp + bj * 128 + 4); } }
#pragma unroll
                for (int mm = 0; mm < 2; ++mm) { const int m = 2 * mp + mm, tok = toks[ai][m]; if (tok < 0) continue; const size_t ro = (size_t)tok * D + col0;
#pragma unroll
                    for (int bj = 0; bj < 2; ++bj) { const pg8::u32x4 w = xw[mm][bj];
                        pg8::f32x4 x0 = {__builtin_bit_cast(float, w.x << 16), __builtin_bit_cast(float, w.x & 0xffff0000u), __builtin_bit_cast(float, w.y << 16), __builtin_bit_cast(float, w.y & 0xffff0000u)};
                        pg8::f32x4 x1 = {__builtin_bit_cast(float, w.z << 16), __builtin_bit_cast(float, w.z & 0xffff0000u), __builtin_bit_cast(float, w.w << 16), __builtin_bit_cast(float, w.w & 0xffff0000u)};
                        x0 += ga[mm][bj] * acc[ai][bj][m][0]; x1 += gb[mm][bj] * acc[ai][bj][m][1];
                        if (obf) { pg8::u32x4 o; o.x = pk_bf16(x0[0], x0[1]); o.y = pk_bf16(x0[2], x0[3]); o.z = pk_bf16(x1[0], x1[1]); o.w = pk_bf16(x1[2], x1[3]); *(pg8::u32x4*)((bf16*)xout + ro + bj * 128) = o; }
                        else { *(pg8::f32x4*)((float*)xout + ro + bj * 128) = x0; *(pg8::f32x4*)((float*)xout + ro + bj * 128 + 4) = x1; } } } } }
    }
};
__device__ __forceinline__ void moe_a_phase(const P& p, LAS unsigned char* lds, int l) {
    moe_table(p, lds, l);
    MoeSchedA S; S.pp = &p; S.tab = LDSP(int, MOE_TAB); S.l = l; S.G = grid_fresh(); S.c = bid_fresh();
    EpiMoeA E{&p, LDSP(int, MOE_TAB)}; pg8::gemm_phase(lds, S, E);
}
__device__ __forceinline__ void moe_b_phase(const P& p, LAS unsigned char* lds, int l, bool dry = false, void* xout = nullptr, int obf = -1) {
    if (!xout) xout = p.out;
    if (obf < 0) obf = (l + 1 < NL);
    moe_table(p, lds, l);
    MoeSchedB S; S.pp = &p; S.tab = LDSP(int, MOE_TAB); S.l = l; S.G = grid_fresh(); S.c = bid_fresh();
    EpiMoeB E{&p, LDSP(int, MOE_TAB), l, dry, WSP(bf16, WS_XB), xout, obf != 0}; pg8::gemm_phase(lds, S, E);
}
constexpr int LDS_BYTES = 147456;
struct Args { P p; };
typedef const __attribute__((address_space(4))) P* KargP;
__device__ __forceinline__ KargP p_fresh() { KargP k = (KargP)__builtin_amdgcn_kernarg_segment_ptr(); asm volatile("" : "+s"(k)); return k; }
__device__ __forceinline__ P load_p() { KargP k = p_fresh(); P q; const void* const __attribute__((address_space(4)))* src = (const void* const __attribute__((address_space(4)))*)k; const void** dst = (const void**)&q;
#pragma unroll
    for (int i = 0; i < (int)(sizeof(P) / sizeof(void*)); ++i) dst[i] = src[i];
    return q; }
#define LAYER_BODY(l) do { \
        { const P p = load_p(); norm_phase(p, lds, l ? (const void*)p.out : (const void*)p.x, l != 0, l, 0); } \
        GRID_BAR(); \
        { const P p = load_p(); pg8::StaticSched S; S.init(WSP(bf16, WS_H), WSP(bf16, WS_WIN_T) + (size_t)l * ZW * D, M, ZW, D, grid_fresh(), bid_fresh()); EpiZ E{&p, l}; pg8::gemm_phase(lds, S, E); gl_tail(p, l); } \
        GRID_BAR(); \
        { const P p = load_p(); premix_phase(p, lds, l); } \
        GRID_BAR(); \
        { const P p = load_p(); { const int G_ = grid_fresh(), bx_ = bid_fresh(); nsa_units(p, lds, l, (G_ & 7) == 0 ? (bx_ & 7) * (G_ >> 3) + (bx_ >> 3) : bx_, G_); } }        \
        { const P p = load_p(); for (int u = bid_fresh(); u < NB * 4 * NCH; u += grid_fresh()) ret_out_unit(p, lds, l, u); } \
        GRID_BAR(); \
        { const P p = load_p(); pg8::StaticSched S; S.init(WSP(bf16, WS_MIX), WSP(bf16, WS_WOUT_T) + (size_t)l * D * D, M, D, D, grid_fresh(), bid_fresh()); \
          pg8::EpiResidual E{l ? (const void*)p.out : (const void*)p.x, l != 0, WSP(bf16, WS_XB), WSP(float, WS_MOD) + (size_t)l * NB * 6144 + 2048}; pg8::gemm_phase(lds, S, E); } \
        GRID_BAR(); \
        { const P p = load_p(); norm_phase(p, lds, WSP(bf16, WS_XB), true, l, 1); } \
        GRID_BAR(); \
        { const P p = load_p(); moe_a_phase(p, lds, l); } \
        GRID_BAR(); \
        { const P p = load_p(); moe_b_phase(p, lds, l); } \
} while (0)
__global__ void __launch_bounds__(NTH, 2) fwd_kernel(Args a) {
    extern __shared__ __attribute__((aligned(16))) unsigned char lds_raw[];
    LAS unsigned char* lds = (LAS unsigned char*)lds_raw;
    volatile LAS unsigned* MISC = (volatile LAS unsigned*)(lds + LDS_BYTES - 64);
    if (threadIdx.x < 16) MISC[threadIdx.x] = 0u;
    __syncthreads();
    (void)xcd_barrier_post((unsigned*)(a.p.ws + WS_CTL) + CW_BAR, MISC);
#define GRID_BAR() do { XcdBarrier bar_; bar_.bar = (unsigned*)(load_p().ws + WS_CTL) + CW_BAR; bar_.x = xb_xcc_id(); bar_.st = (volatile LAS unsigned*)(lds + LDS_BYTES - 64); xcd_barrier(bar_); } while (0)
    { const P p = load_p(); p0_prologue(p, lds); }
    GRID_BAR();
    LAYER_BODY(0);
    GRID_BAR();
    LAYER_BODY(1);
}
extern "C" void kernel_launch(void* const* d_in, const int* in_sizes, int n_in, void* d_out, int out_size, void* d_ws, size_t ws_size, hipStream_t stream) {
    static int grid = 0;
    if (grid == 0) {
        int dev = 0, cus = 0, per_cu = 0;
        if (n_in != 26 || out_size != M * D || ws_size < WS_END) { fprintf(stderr, "kernel_launch: unexpected shapes (n_in %d out %d ws %zu need %zu)\n", n_in, out_size, ws_size, (size_t)WS_END); grid = -1; return; }
        if (hipGetDevice(&dev) != hipSuccess || hipDeviceGetAttribute(&cus, hipDeviceAttributeMultiprocessorCount, dev) != hipSuccess) { grid = -1; return; }
        if (hipFuncSetAttribute((const void*)fwd_kernel, hipFuncAttributeMaxDynamicSharedMemorySize, LDS_BYTES) != hipSuccess) { fprintf(stderr, "kernel_launch: hipFuncSetAttribute failed\n"); grid = -1; return; }
        if (hipOccupancyMaxActiveBlocksPerMultiprocessor(&per_cu, (const void*)fwd_kernel, NTH, LDS_BYTES) != hipSuccess || per_cu < 1) { fprintf(stderr, "kernel_launch: occupancy query reports %d workgroups per CU\n", per_cu); per_cu = 1; }
        (void)hipGetLastError();
        grid = cus;
    }
    if (grid < 0) return;
    (void)hipMemsetAsync((char*)d_ws + WS_CTL, 0, 1u << 20, stream);
    Args a{};
    const void** pp = (const void**)&a.p;
    for (int i = 0; i < 26; ++i) pp[i] = d_in[i];
    a.p.out = (float*)d_out; a.p.ws = (unsigned char*)d_ws;
    hipLaunchKernelGGL(fwd_kernel, dim3(grid), dim3(NTH), LDS_BYTES, stream, a);
}
```

```cpp
#include <hip/hip_runtime.h>
#include <cstdio>
#include <cstdint>
#define HD __device__ __attribute__((always_inline))
__device__ __forceinline__ int tid_fresh() { int t = threadIdx.x; asm volatile("" : "+v"(t)); return t; }
__device__ __forceinline__ int bid_fresh() { int t = blockIdx.x; asm volatile("" : "+s"(t)); return t; }
__device__ __forceinline__ int grid_fresh() { int t = gridDim.x; asm volatile("" : "+s"(t)); return t; }
#ifndef CFG_B
#define CFG_B 16
#endif
#ifndef CFG_S
#define CFG_S 2048
#endif
constexpr int NB = CFG_B, NS = CFG_S, M = NB * NS, D = 1024, NIN = 2840, ZW = 2816, NL = 2;
constexpr int C_RQ = 0, C_RK = 256, C_RV = 512, C_RG = 768, C_GU = 1024, C_GV = 1280, C_NQ = 1536, C_KC = 2048, C_VC = 2176,
              C_KS = 2304, C_VS = 2432, C_KW = 2560, C_VW = 2688;
constexpr int NCMP = NS / 16 - 1, NSEL = NS / 64, NCH = NS / 128;
constexpr float EPS = 1e-6f;

typedef unsigned short bf16;
HD inline bf16 f2bf(float f) { unsigned u = __builtin_bit_cast(unsigned, f); u += 0x7FFFu + ((u >> 16) & 1u); return (bf16)(u >> 16); }
HD inline float bf2f(bf16 b) { return __builtin_bit_cast(float, ((unsigned)b) << 16); }
HD inline float silu_f(float x) { return x / (1.f + expf(-x)); }
HD inline float sigm_f(float x) { return 1.f / (1.f + expf(-x)); }
HD inline float gelu_f(float x) { return 0.5f * x * (1.f + tanhf(0.7978845608028654f * (x + 0.044715f * x * x * x))); }
#ifndef HOST_EMU
__device__ __forceinline__ float gelu_fast(float x) { const float u = 1.5957691216057308f * (x + 0.044715f * x * x * x); return x * __builtin_amdgcn_rcpf(1.f + __expf(-u)); }
__device__ __forceinline__ float silu_fast(float x) { return x * __builtin_amdgcn_rcpf(1.f + __expf(-x)); }
#endif
HD inline float invfreq(int i) { return exp2f(-(float)i * (13.287712379549449f / 32.f)); }

constexpr size_t MiB = 1u << 20;
constexpr size_t al(size_t x) { return (x + 255) & ~(size_t)255; }
constexpr size_t WS_CTL = 0;
constexpr int CW_BAR = 4096, CW_CNT = 16384;
constexpr size_t WS_MOD = 1 * MiB;
constexpr size_t WS_RS = WS_MOD + al((size_t)NL * NB * 6144 * 4);
constexpr size_t WS_GL = WS_RS + al((size_t)M * 4);
constexpr size_t WS_LOG = WS_GL + al((size_t)M * 24 * 4);
constexpr size_t WS_ROUT = WS_LOG + al((size_t)M * 16 * 4);
constexpr size_t WS_KC = WS_ROUT + al((size_t)M * 16);
constexpr size_t WS_VC = WS_KC + al((size_t)NB * 2 * (NCMP + 1) * 64 * 2);
constexpr size_t WS_HID = WS_VC + al((size_t)NB * 2 * (NCMP + 1) * 64 * 2);
constexpr size_t WS_CRAW = WS_HID + al((size_t)NB * NCMP * 4 * 128 * 4);
constexpr size_t WS_SEL = WS_CRAW + al((size_t)NB * NCMP * 4 * 64 * 4);
constexpr size_t WS_CS = WS_SEL + al((size_t)M * 16 * 4);
constexpr size_t WS_CSB = WS_CS + al((size_t)M * 64 * 4);
constexpr size_t WS_PEB = WS_CSB + al((size_t)M * 64 * 2);
constexpr size_t WS_BND = WS_PEB + 4096;
constexpr size_t WS_KVS = WS_BND + 256;
constexpr size_t WS_CTOK = WS_KVS + al((size_t)NB * 4 * NCH * 4096 * 4);
constexpr size_t WS_CWT = WS_CTOK + al((size_t)24 * M * 4);
constexpr size_t WS_WIN_T = WS_CWT + al((size_t)24 * M * 8);
constexpr size_t WS_WGL_T = WS_WIN_T + al((size_t)NL * ZW * D * 2);
constexpr size_t WS_WOUT_T = WS_WGL_T + al((size_t)NL * 32 * D * 2);
constexpr size_t WS_WGU_T = WS_WOUT_T + al((size_t)NL * D * D * 2);
constexpr size_t WS_WD_T = WS_WGU_T + al((size_t)NL * 16 * 1024 * D * 2);
constexpr size_t WS_CW1_T = WS_WD_T + al((size_t)NL * 16 * D * 512 * 2);
constexpr size_t WS_CW2_T = WS_CW1_T + al((size_t)NL * 2 * 256 * 1024 * 2);
constexpr size_t WS_GWS = WS_CW2_T + al((size_t)NL * 2 * 64 * 128 * 2);
constexpr size_t WS_H = al(WS_GWS + (size_t)NL * 4 * 128 * 128 * 2);
constexpr size_t WS_Z = WS_H + al((size_t)M * D * 2);
constexpr size_t WS_XB = WS_Z + 88 * MiB;
constexpr size_t WS_MIX = WS_Z + al((size_t)M * ZW * 2);
constexpr size_t WS_END = WS_MIX + al((size_t)M * D * 2);
constexpr size_t WS_PB = WS_END;
constexpr size_t WS_END_NAIVE = WS_PB + al((size_t)M * 2 * 128 * 4);
constexpr size_t WS_YN = WS_H;
constexpr size_t WS_ACTN = WS_Z;
static_assert(WS_XB + (size_t)M * D * 2 <= WS_Z + (size_t)M * ZW * 2, "XB must fit in Z above ACT");
static_assert(CFG_B != 16 || CFG_S != 2048 || WS_END <= 512 * MiB, "workspace map exceeds 512 MiB");

struct P {
    const float *x, *c; const int* pos;
    const float *ada_w, *ada_b, *norm_mix_g, *norm_ffn_g, *w_in, *w_out, *ret_norm_g, *gmlp_ln_g, *gmlp_ws, *gmlp_b, *nsa_q_norm_g, *nsa_k_norm_g,
        *cmp_pe_k, *cmp_pe_v, *cmp_w1_k, *cmp_w2_k, *cmp_w1_v, *cmp_w2_v, *router_w, *router_b, *moe_w_gate, *moe_w_up, *moe_w_down;
    float* out; unsigned char* ws;
};
struct Rout { int e0, e1; float w0, w1; };

#define WSP(T, off) ((T*)(p.ws + (off)))
#define GSL(i, n) for (long i = gid; i < (long)(n); i += gsz)

HD inline void n_mod(long gid, long gsz, const P& p) {
    float* mod = WSP(float, WS_MOD);
    GSL(i, (long)NL * NB * 6144) {
        const int n = (int)(i % 6144), b = (int)((i / 6144) % NB), l = (int)(i / (6144 * NB));
        float s = p.ada_b[l * 6144 + n];
        for (int k = 0; k < D; ++k) s += silu_f(p.c[b * D + k]) * p.ada_w[((size_t)l * D + k) * 6144 + n];
        mod[i] = s;
    }
}
HD inline void n_rowstat(long gid, long gsz, const P& p, const float* xs) {
    float* rs = WSP(float, WS_RS);
    GSL(r, M) { float s = 0.f; for (int k = 0; k < D; ++k) { const float v = xs[(size_t)r * D + k]; s += v * v; } rs[r] = 1.0f / sqrtf(s / D + EPS); }
}
HD inline float normed(const P& p, const float* xs, int l, int which, long r, int k) {
    const float* mod = WSP(float, WS_MOD) + ((size_t)l * NB + r / NS) * 6144 + which * 3072;
    const float* g = (which ? p.norm_ffn_g : p.norm_mix_g) + l * D;
    return xs[(size_t)r * D + k] * WSP(float, WS_RS)[r] * g[k] * (1.f + mod[1024 + k]) + mod[k];
}
HD inline void n_norm(long gid, long gsz, const P& p, const float* xs, int l, int which) {
    bf16* H = WSP(bf16, WS_H);
    GSL(i, (long)M * D) { const long r = i / D; const int k = (int)(i % D); H[i] = f2bf(normed(p, xs, l, which, r, k)); }
}
HD inline void n_gemm1(long gid, long gsz, const P& p, int l) {
    const bf16* H = WSP(bf16, WS_H); bf16* Z = WSP(bf16, WS_Z); float* GL = WSP(float, WS_GL);
    const float* W = p.w_in + (size_t)l * D * NIN;
    GSL(i, (long)M * NIN) {
        const long m = i / NIN; const int n = (int)(i % NIN);
        float s = 0.f; for (int k = 0; k < D; ++k) s += bf2f(H[m * D + k]) * W[(size_t)k * NIN + n];
        if (n < ZW) Z[m * ZW + n] = f2bf(s); else GL[m * 24 + (n - ZW)] = s;
    }
}
HD inline void rope_inplace(bf16* v, int pos, float premul_scale, const float* g  , bool do_norm) {
    float r = 1.f;
    if (do_norm) { float s = 0.f; for (int e = 0; e < 64; ++e) { const float t = bf2f(v[e]); s += t * t; } r = 1.0f / sqrtf(s / 64.f + EPS); }
    for (int i = 0; i < 32; ++i) {
        float a = bf2f(v[i]), b = bf2f(v[i + 32]);
        if (do_norm) { a = a * r * g[i]; b = b * r * g[i + 32]; }
        const float ang = (float)pos * invfreq(i), cs = cosf(ang), sn = sinf(ang);
        v[i] = f2bf((a * cs - b * sn) * premul_scale); v[i + 32] = f2bf((a * sn + b * cs) * premul_scale);
    }
}
HD inline void n_premix(long gid, long gsz, const P& p, int l) {
    bf16* Z = WSP(bf16, WS_Z);
    GSL(i, (long)M * 29) {
        const long m = i / 29; const int u = (int)(i % 29); bf16* z = Z + m * ZW; const int pos = p.pos[m];
        if (u < 4) rope_inplace(z + C_RQ + 64 * u, pos, 1.f, nullptr, false);
        else if (u < 8) rope_inplace(z + C_RK + 64 * (u - 4), pos, 0.125f, nullptr, false);
        else if (u < 12) { bf16* v = z + C_RG + 64 * (u - 8); for (int e = 0; e < 64; ++e) v[e] = f2bf(silu_f(bf2f(v[e]))); }
        else if (u < 16) { bf16* v = z + C_GU + 64 * (u - 12); for (int e = 0; e < 64; ++e) v[e] = f2bf(gelu_f(bf2f(v[e]))); }
        else if (u == 16) { bf16* v = z + C_GV; float s = 0.f, s2 = 0.f;
            for (int e = 0; e < 256; ++e) s += gelu_f(bf2f(v[e]));
            const float mu = s / 256.f;
            for (int e = 0; e < 256; ++e) { const float d = gelu_f(bf2f(v[e])) - mu; s2 += d * d; }
            const float rstd = 1.0f / sqrtf(s2 / 256.f + EPS);
            for (int e = 0; e < 256; ++e) v[e] = f2bf((gelu_f(bf2f(v[e])) - mu) * rstd * p.gmlp_ln_g[l * 256 + e]); }
        else if (u < 25) rope_inplace(z + C_NQ + 64 * (u - 17), pos, 0.125f, p.nsa_q_norm_g + l * 64, true);
        else if (u < 27) rope_inplace(z + C_KS + 64 * (u - 25), pos, 1.f, p.nsa_k_norm_g + (l * 3 + 1) * 64, true);
        else rope_inplace(z + C_KW + 64 * (u - 27), pos, 1.f, p.nsa_k_norm_g + (l * 3 + 2) * 64, true);
    }
}
HD inline void n_gvln(long gid, long gsz, const P& p, int l) {
    bf16* Z = WSP(bf16, WS_Z);
    GSL(m, M) { bf16* v = Z + m * ZW + C_GV; float s = 0.f, s2 = 0.f;
        for (int e = 0; e < 256; ++e) s += bf2f(v[e]);
        const float mu = s / 256.f;
        for (int e = 0; e < 256; ++e) { const float d = bf2f(v[e]) - mu; s2 += d * d; }
        const float rstd = 1.0f / sqrtf(s2 / 256.f + EPS);
        for (int e = 0; e < 256; ++e) v[e] = f2bf((bf2f(v[e]) - mu) * rstd * p.gmlp_ln_g[l * 256 + e]); }
}
HD inline void n_cmp_h(long gid, long gsz, const P& p, int l) {
    const bf16* Z = WSP(bf16, WS_Z); float* HID = WSP(float, WS_HID);
    GSL(i, (long)NB * NCMP * 4 * 128) {
        const int j = (int)(i % 128), kv = (int)((i / 128) % 2), g = (int)((i / 256) % 2), n = (int)((i / 512) % NCMP), b = (int)(i / (512 * NCMP));
        const float* pe = (kv ? p.cmp_pe_v : p.cmp_pe_k) + (size_t)l * 32 * 64; const float* w1 = (kv ? p.cmp_w1_v : p.cmp_w1_k) + (size_t)l * 32 * 64 * 128;
        const int col = (kv ? C_VC : C_KC) + g * 64; float s = 0.f;
        for (int t = 0; t < 32; ++t) for (int d = 0; d < 64; ++d)
            s += (bf2f(Z[((size_t)b * NS + 16 * n + t) * ZW + col + d]) + pe[t * 64 + d]) * w1[(t * 64 + d) * 128 + j];
        HID[i] = gelu_f(s);
    }
}
HD inline void n_cmp_o(long gid, long gsz, const P& p, int l) {
    const float* HID = WSP(float, WS_HID); float* CR = WSP(float, WS_CRAW);
    GSL(i, (long)NB * NCMP * 4 * 64) {
        const int d = (int)(i % 64), kv = (int)((i / 64) % 2); const long grp = i / 64;
        const float* w2 = (kv ? p.cmp_w2_v : p.cmp_w2_k) + (size_t)l * 128 * 64; float s = 0.f;
        for (int j = 0; j < 128; ++j) s += HID[grp * 128 + j] * w2[j * 64 + d];
        CR[i] = s;
    }
}
HD inline void n_cmp_fin(long gid, long gsz, const P& p, int l) {
    const float* CR = WSP(float, WS_CRAW); bf16* KC = WSP(bf16, WS_KC); bf16* VC = WSP(bf16, WS_VC);
    GSL(i, (long)NB * NCMP * 2) {
        const int g = (int)(i % 2), n = (int)((i / 2) % NCMP), b = (int)(i / (2 * NCMP));
        const float* ck = CR + ((size_t)(b * NCMP + n) * 2 + g) * 2 * 64; const float* cv = ck + 64;
        bf16* ko = KC + ((size_t)(b * 2 + g) * (NCMP + 1) + n) * 64; bf16* vo = VC + ((size_t)(b * 2 + g) * (NCMP + 1) + n) * 64;
        float s = 0.f; for (int e = 0; e < 64; ++e) s += ck[e] * ck[e];
        const float r = 1.0f / sqrtf(s / 64.f + EPS); const float* gk = p.nsa_k_norm_g + (l * 3 + 0) * 64; const int pos = p.pos[b * NS + 16 * n + 31];
        for (int e = 0; e < 32; ++e) { const float a = ck[e] * r * gk[e], c2 = ck[e + 32] * r * gk[e + 32]; const float ang = (float)pos * invfreq(e), cs = cosf(ang), sn = sinf(ang);
            ko[e] = f2bf(a * cs - c2 * sn); ko[e + 32] = f2bf(a * sn + c2 * cs); }
        for (int e = 0; e < 64; ++e) vo[e] = f2bf(cv[e]);
    }
}
HD inline void n_ret(long gid, long gsz, const P& p, int l) {
    const bf16* Z = WSP(bf16, WS_Z); bf16* MIX = WSP(bf16, WS_MIX);
    GSL(i, (long)M * 4) {
        const int h = (int)(i % 4); const long m = i / 4; const int t = (int)(m % NS); const long m0 = m - t;
        const float lg = log1pf(-exp2f(-5.f - (float)h));
        float o[64];
#pragma unroll
        for (int e = 0; e < 64; ++e) o[e] = 0.f;
        const bf16* q = Z + m * ZW + C_RQ + 64 * h;
        for (int mm = 0; mm <= t; ++mm) {
            const bf16* k = Z + (m0 + mm) * ZW + C_RK + 64 * h; const bf16* v = Z + (m0 + mm) * ZW + C_RV + 64 * h;
            float s = 0.f;
#pragma unroll
            for (int e = 0; e < 64; ++e) s += bf2f(q[e]) * bf2f(k[e]);
            s *= expf((float)(t - mm) * lg);
#pragma unroll
            for (int e = 0; e < 64; ++e) o[e] += s * bf2f(v[e]);
        }
        float ss = 0.f;
#pragma unroll
        for (int e = 0; e < 64; ++e) ss += o[e] * o[e];
        const float r = 1.0f / sqrtf(ss / 64.f + EPS);
#pragma unroll
        for (int e = 0; e < 64; ++e) MIX[m * D + 64 * h + e] = f2bf(o[e] * r * p.ret_norm_g[(l * 4 + h) * 64 + e] * bf2f(Z[m * ZW + C_RG + 64 * h + e]));
    }
}
HD inline void n_gmlp(long gid, long gsz, const P& p, int l) {
    const bf16* Z = WSP(bf16, WS_Z); bf16* MIX = WSP(bf16, WS_MIX);
    GSL(i, (long)M * 256) {
        const int c = (int)(i % 256), g = c / 64; const long m = i / 256; const int tl = (int)(m % 128); const long mc = m - tl;
        const float* w = p.gmlp_ws + ((size_t)(l * 4 + g) * 128 + tl) * 128;
        float s = p.gmlp_b[(l * 4 + g) * 128 + tl];
        for (int s2 = 0; s2 <= tl; ++s2) s += w[s2] * bf2f(Z[(mc + s2) * ZW + C_GV + c]);
        MIX[m * D + 256 + c] = f2bf(bf2f(Z[m * ZW + C_GU + c]) * s);
    }
}
HD inline void n_nsa_cmp(long gid, long gsz, const P& p, int l) {
    const bf16* Z = WSP(bf16, WS_Z); const bf16* KC = WSP(bf16, WS_KC); const bf16* VC = WSP(bf16, WS_VC);
    float* YN = WSP(float, WS_YN); float* PB = WSP(float, WS_PB); const float* GL = WSP(float, WS_GL);
    GSL(i, (long)M * 2) {
        const int g = (int)(i % 2); const long m = i / 2; const int t = (int)(m % NS), b = (int)(m / NS);
        const int nvis = (t >= 31) ? ((t - 31) / 16 + 1) : 0;
        const bf16* kc = KC + (size_t)(b * 2 + g) * (NCMP + 1) * 64; const bf16* vc = VC + (size_t)(b * 2 + g) * (NCMP + 1) * 64;
        float* pb = PB + (m * 2 + g) * 128;
        for (int n = 0; n < 128; ++n) pb[n] = 0.f;
        for (int r = 0; r < 4; ++r) {
            const int h = g * 4 + r; const bf16* q = Z + m * ZW + C_NQ + 64 * h;
            float mx = -3e38f;
            for (int n = 0; n < nvis; ++n) { float s = 0.f; for (int e = 0; e < 64; ++e) s += bf2f(q[e]) * bf2f(kc[n * 64 + e]); mx = fmaxf(mx, s); }
            float den = 0.f;
            for (int n = 0; n < nvis; ++n) { float s = 0.f; for (int e = 0; e < 64; ++e) s += bf2f(q[e]) * bf2f(kc[n * 64 + e]); den += expf(s - mx); }
            float o[64];
#pragma unroll
            for (int e = 0; e < 64; ++e) o[e] = 0.f;
            for (int n = 0; n < nvis; ++n) { float s = 0.f;
#pragma unroll
                for (int e = 0; e < 64; ++e) s += bf2f(q[e]) * bf2f(kc[n * 64 + e]);
                const float pr = expf(s - mx) / den; pb[n] += pr;
#pragma unroll
                for (int e = 0; e < 64; ++e) o[e] += pr * bf2f(vc[n * 64 + e]); }
            const float gate = sigm_f(GL[m * 24 + h * 3 + 0]);
#pragma unroll
            for (int e = 0; e < 64; ++e) YN[m * 512 + 64 * h + e] = gate * o[e];
        }
    }
}
HD inline void n_nsa_select(long gid, long gsz, const P& p) {
    const float* PB = WSP(float, WS_PB); int* SEL = WSP(int, WS_SEL);
    GSL(i, (long)M * 2) {
        const long m = i / 2; const int t = (int)(m % NS), cur = t / 64; const float* pb = PB + i * 128;
        unsigned chosen = 0u; const int topn = NSEL < 8 ? NSEL : 8;
        for (int k = 0; k < topn; ++k) {
            float best = -3e38f; int bj = 0;
            for (int j = 0; j < NSEL; ++j) {
                if ((chosen >> j) & 1u) continue;
                float sc;
                if (j == 0 || j == cur || j == cur - 1) sc = 1e4f;
                else if (64 * j <= t) { sc = 0.f; for (int n = 4 * j - 1; n <= 4 * j + 3; ++n) if (n >= 0 && n < NCMP) sc += pb[n]; }
                else sc = -1.f;
                if (sc > best) { best = sc; bj = j; }
            }
            chosen |= 1u << bj; SEL[i * 8 + k] = bj;
        }
    }
}
HD inline void n_nsa_sel(long gid, long gsz, const P& p, int l) {
    const bf16* Z = WSP(bf16, WS_Z); float* YN = WSP(float, WS_YN); const float* GL = WSP(float, WS_GL); const int* SEL = WSP(int, WS_SEL);
    GSL(i, (long)M * 8) {
        const int h = (int)(i % 8), g = h / 4; const long m = i / 8; const int t = (int)(m % NS); const long m0 = m - t;
        const bf16* q = Z + m * ZW + C_NQ + 64 * h; const int topn = NSEL < 8 ? NSEL : 8;
        float mx = -3e38f, den = 0.f, o[64];
#pragma unroll
        for (int e = 0; e < 64; ++e) o[e] = 0.f;
        for (int k = 0; k < topn; ++k) { const int blk = SEL[(m * 2 + g) * 8 + k];
            for (int jj = 0; jj < 64; ++jj) { const int tok = blk * 64 + jj; if (tok > t) continue;
                const bf16* kk = Z + (m0 + tok) * ZW + C_KS + 64 * g; const bf16* vv = Z + (m0 + tok) * ZW + C_VS + 64 * g;
                float s = 0.f;
#pragma unroll
                for (int e = 0; e < 64; ++e) s += bf2f(q[e]) * bf2f(kk[e]);
                const float nm = fmaxf(mx, s), corr = expf(mx - nm), pr = expf(s - nm);
                den = den * corr + pr; mx = nm;
#pragma unroll
                for (int e = 0; e < 64; ++e) o[e] = o[e] * corr + pr * bf2f(vv[e]); } }
        const float gate = sigm_f(GL[m * 24 + h * 3 + 1]) / den;
#pragma unroll
        for (int e = 0; e < 64; ++e) YN[m * 512 + 64 * h + e] += gate * o[e];
    }
}
HD inline void n_nsa_win(long gid, long gsz, const P& p, int l) {
    const bf16* Z = WSP(bf16, WS_Z); float* YN = WSP(float, WS_YN); const float* GL = WSP(float, WS_GL); bf16* MIX = WSP(bf16, WS_MIX);
    GSL(i, (long)M * 8) {
        const int h = (int)(i % 8), g = h / 4; const long m = i / 8; const int t = (int)(m % NS); const long m0 = m - t;
        const bf16* q = Z + m * ZW + C_NQ + 64 * h;
        float mx = -3e38f, den = 0.f, o[64];
#pragma unroll
        for (int e = 0; e < 64; ++e) o[e] = 0.f;
        for (int tok = (t - 511 > 0 ? t - 511 : 0); tok <= t; ++tok) {
            const bf16* kk = Z + (m0 + tok) * ZW + C_KW + 64 * g; const bf16* vv = Z + (m0 + tok) * ZW + C_VW + 64 * g;
            float s = 0.f;
#pragma unroll
            for (int e = 0; e < 64; ++e) s += bf2f(q[e]) * bf2f(kk[e]);
            const float nm = fmaxf(mx, s), corr = expf(mx - nm), pr = expf(s - nm);
            den = den * corr + pr; mx = nm;
#pragma unroll
            for (int e = 0; e < 64; ++e) o[e] = o[e] * corr + pr * bf2f(vv[e]); }
        const float gate = sigm_f(GL[m * 24 + h * 3 + 2]) / den;
#pragma unroll
        for (int e = 0; e < 64; ++e) MIX[m * D + 512 + 64 * h + e] = f2bf(YN[m * 512 + 64 * h + e] + gate * o[e]);
    }
}
HD inline void n_gemm2(long gid, long gsz, const P& p, const float* xs, int l) {
    const bf16* MIX = WSP(bf16, WS_MIX); const float* W = p.w_out + (size_t)l * D * D;
    GSL(i, (long)M * D) {
        const long m = i / D; const int n = (int)(i % D);
        float s = 0.f; for (int k = 0; k < D; ++k) s += bf2f(MIX[m * D + k]) * W[(size_t)k * D + n];
        p.out[i] = xs[i] + WSP(float, WS_MOD)[((size_t)l * NB + m / NS) * 6144 + 2048 + n] * s;
    }
}
HD inline void n_router_logits(long gid, long gsz, const P& p, int l) {
    float* LOG = WSP(float, WS_LOG);
    GSL(i, (long)M * 16) { const long m = i / 16; const int e = (int)(i % 16); float s = 0.f;
        for (int k = 0; k < D; ++k) s += normed(p, p.out, l, 1, m, k) * p.router_w[k * 16 + e];
        LOG[i] = s; }
}
HD inline void n_route(long gid, long gsz, const P& p) {
    const float* LOG = WSP(float, WS_LOG); Rout* R = WSP(Rout, WS_ROUT);
    GSL(m, M) { const float* lg = LOG + m * 16;
        float mx = lg[0]; for (int e = 1; e < 16; ++e) mx = fmaxf(mx, lg[e]);
        float den = 0.f; for (int e = 0; e < 16; ++e) den += expf(lg[e] - mx);
        float bestg = -3e38f; int bg = 0;
        for (int g = 0; g < 4; ++g) { float a = -3e38f, b2 = -3e38f;
            for (int j = 0; j < 4; ++j) { const float s = expf(lg[g * 4 + j] - mx) / den + p.router_b[g * 4 + j]; if (s > a) { b2 = a; a = s; } else if (s > b2) b2 = s; }
            if (a + b2 > bestg) { bestg = a + b2; bg = g; } }
        float a = -3e38f, b2 = -3e38f; int ia = 0, ib = 0;
        for (int j = 0; j < 4; ++j) { const float s = expf(lg[bg * 4 + j] - mx) / den + p.router_b[bg * 4 + j];
            if (s > a) { b2 = a; ib = ia; a = s; ia = j; } else if (s > b2) { b2 = s; ib = j; } }
        const float p0 = expf(lg[bg * 4 + ia] - mx) / den, p1 = expf(lg[bg * 4 + ib] - mx) / den;
        Rout r; r.e0 = bg * 4 + ia; r.e1 = bg * 4 + ib; r.w0 = p0 / (p0 + p1); r.w1 = p1 / (p0 + p1); R[m] = r; }
}
HD inline void n_moe_a(long gid, long gsz, const P& p, int l) {
    const bf16* H = WSP(bf16, WS_H); const Rout* R = WSP(Rout, WS_ROUT); bf16* ACT = WSP(bf16, WS_ACTN);
    GSL(i, (long)M * 1024) { const long m = i / 1024; const int k = (int)((i / 512) % 2), j = (int)(i % 512);
        const Rout r = R[m]; const int e = k ? r.e1 : r.e0; const float w = k ? r.w1 : r.w0;
        const float* wg = p.moe_w_gate + ((size_t)(l * 16 + e) * D) * 512 + j; const float* wu = p.moe_w_up + ((size_t)(l * 16 + e) * D) * 512 + j;
        float sg = 0.f, su = 0.f;
        for (int kk = 0; kk < D; ++kk) { const float hv = bf2f(H[m * D + kk]); sg += hv * wg[(size_t)kk * 512]; su += hv * wu[(size_t)kk * 512]; }
        ACT[i] = f2bf(w * silu_f(sg) * su); }
}
HD inline void n_moe_b(long gid, long gsz, const P& p, int l) {
    const Rout* R = WSP(Rout, WS_ROUT); const bf16* ACT = WSP(bf16, WS_ACTN);
    GSL(i, (long)M * D) { const long m = i / D; const int n = (int)(i % D); const Rout r = R[m]; float s = 0.f;
        for (int k = 0; k < 2; ++k) { const int e = k ? r.e1 : r.e0; const float* wd = p.moe_w_down + ((size_t)(l * 16 + e) * 512) * D + n;
            for (int j = 0; j < 512; ++j) s += bf2f(ACT[(m * 2 + k) * 512 + j]) * wd[(size_t)j * D]; }
        p.out[i] += WSP(float, WS_MOD)[((size_t)l * NB + m / NS) * 6144 + 5120 + n] * s; }
}
#define XB_TMO      128
#define XB_XCNT(j)  (256  + 64 * (j))
#define XB_XSUB(j)  (1280 + 64 * (j))
#define XB_XGEN(j)  (2304 + 64 * (j))
#define XB_TOP      3328
#define XB_TOPGEN   3392
#define XCD_BAR_WORDS 3456
#ifndef XB_SPIN_CAP
#define XB_SPIN_CAP (1u << 15)
#endif
#define LAS __attribute__((address_space(3)))
__device__ __forceinline__ unsigned xb_ld(unsigned* p)              { return __hip_atomic_load(p, __ATOMIC_RELAXED, __HIP_MEMORY_SCOPE_AGENT); }
__device__ __forceinline__ unsigned xb_add(unsigned* p, unsigned v) { return __hip_atomic_fetch_add(p, v, __ATOMIC_RELAXED, __HIP_MEMORY_SCOPE_AGENT); }
__device__ __forceinline__ unsigned xb_xcc_id() { return (unsigned)__builtin_amdgcn_s_getreg((3 << 11) | 20) & 0xFu; }
#define XB_SPIN(cond, bar) do { unsigned _sp = 0; while (cond) { __builtin_amdgcn_s_sleep(1); \
    if ((++_sp & 255u) == 0u) { if (xb_ld(&(bar)[XB_TMO])) break; if (_sp > XB_SPIN_CAP) { atomicAdd(&(bar)[XB_TMO], 1u); break; } } } } while (0)
struct XcdBarrier { unsigned* bar; unsigned x; volatile LAS unsigned* st; };
__device__ __forceinline__ XcdBarrier xcd_barrier_post(unsigned* bar, volatile LAS unsigned* st) {
    XcdBarrier b; b.bar = bar; b.x = xb_xcc_id(); b.st = st;
    if (threadIdx.x == 0) (void)xb_add(&bar[XB_XCNT(b.x)], 1u);
    return b;
}
__device__ __forceinline__ void xcd_barrier_complete(unsigned* bar, unsigned x, unsigned& nloc, unsigned& nx) {
    const unsigned G = gridDim.x * gridDim.y * gridDim.z;
    unsigned sum, cnt, mine, sp = 0u;
    for (;;) {
        sum = 0u; cnt = 0u; mine = 0u;
#pragma unroll
        for (unsigned j = 0; j < 16; ++j) { const unsigned c = xb_ld(&bar[XB_XCNT(j)]); sum += c; cnt += (c > 0u) ? 1u : 0u; mine = (j == x) ? c : mine; }
        if (sum == G) break;
        __builtin_amdgcn_s_sleep(1);
        if ((++sp & 255u) == 0u) { if (xb_ld(&bar[XB_TMO])) break; if (sp > XB_SPIN_CAP) { atomicAdd(&bar[XB_TMO], 1u); break; } }
    }
    nloc = mine > 0u ? mine : 1u; nx = cnt > 0u ? cnt : 1u;
}
__device__ __forceinline__ void xcd_barrier(const XcdBarrier& b) {
    asm volatile("s_waitcnt vmcnt(0)" ::: "memory");
    __syncthreads();
    if (threadIdx.x == 0) {
        unsigned* bar = b.bar;
        __builtin_amdgcn_s_waitcnt(0);
        unsigned nloc = b.st[0], nx = b.st[1];
        if (nloc == 0u) { xcd_barrier_complete(bar, b.x, nloc, nx); b.st[0] = nloc; b.st[1] = nx; }
        const unsigned old = xb_add(&bar[XB_XSUB(b.x)], 1u);
        const unsigned gen = old / nloc;
        if (old + 1u == (gen + 1u) * nloc) {
            __builtin_amdgcn_fence(__ATOMIC_RELEASE, "agent");
            asm volatile("s_waitcnt vmcnt(0)" ::: "memory");
            const unsigned og = xb_add(&bar[XB_TOP], 1u);
            const unsigned tg = og / nx;
            if (og + 1u == (tg + 1u) * nx) xb_add(&bar[XB_TOPGEN], 1u);
            else XB_SPIN(xb_ld(&bar[XB_TOPGEN]) == tg, bar);
            __builtin_amdgcn_fence(__ATOMIC_ACQUIRE, "agent");
            xb_add(&bar[XB_XGEN(b.x)], 1u);
            asm volatile("s_waitcnt vmcnt(0)" ::: "memory");
        } else {
            XB_SPIN(xb_ld(&bar[XB_XGEN(b.x)]) == gen, bar);
            __builtin_amdgcn_fence(__ATOMIC_ACQUIRE, "agent");
            asm volatile("s_waitcnt vmcnt(0)" ::: "memory");
        }
    }
    __syncthreads();
}
namespace pg8 {
#define PG8_LAS __attribute__((address_space(3)))
typedef short bf16x8 __attribute__((ext_vector_type(8)));
typedef float f32x4 __attribute__((ext_vector_type(4)));
typedef float f32x2 __attribute__((ext_vector_type(2)));
typedef unsigned u32x4 __attribute__((ext_vector_type(4)));
typedef unsigned u32x2 __attribute__((ext_vector_type(2)));
constexpr int BM = 256, BK = 64, HALF = 128, HTB = HALF * BK * 2, STAGE_BYTES = 8 * HTB, NXCD = 8, WGM = 8;
__device__ __forceinline__ int lds_byte(int r, int c) { const int st = (r >> 4) * 2 + (c >> 5), rr = r & 15, cc = c & 31, ob = rr * 64 + cc * 2; return st * 1024 + (ob ^ (((ob >> 9) & 1) << 5)); }
__device__ __forceinline__ void stage_rc(int b, int& R, int& C) { const int st = b / 1024, sb = b % 1024, swz = sb ^ (((sb >> 9) & 1) << 5); R = (st >> 1) * 16 + swz / 64; C = (st & 1) * 32 + (swz % 64) / 2; }
__device__ __forceinline__ int perm32(int rho) { const int n = rho >> 4, i = rho & 15; return 8 * (i >> 2) + 4 * n + (i & 3); }
__device__ __forceinline__ unsigned cvt_pk_bf16(float lo, float hi) { unsigned r; asm volatile("v_cvt_pk_bf16_f32 %0, %1, %2" : "=v"(r) : "v"(lo), "v"(hi)); return r; }

struct Unit { int pm, pn, aux, half; };
__device__ __forceinline__ bool deal_unit(int i, int G, int c, int U, int& L, int& half) {
    const int F = (U / G) * G, R = U - F; const long Li = (long)i * G + c; half = 0;
    if (Li < F) { L = (int)Li; return true; }
    if (R == 0 || i > U / G) return false;
    if (2 * R <= G) { if (c >= 2 * R) return false; L = F + (c >> 1); half = 1 + (c & 1); return true; }
    if (Li >= U) return false; L = (int)Li; return true; }
struct StaticSched {
    static constexpr bool GATHER = false; static constexpr int GOFF_LDS = 0;
    const char* A; const char* Bt; int K, nM, nN, nwg, G, c;
    __device__ void init(const void* A_, const void* Bt_, int M_, int N_, int K_, int G_, int c_) { A = (const char*)A_; Bt = (const char*)Bt_; K = K_; nM = M_ / BM; nN = N_ / BM; nwg = nM * nN; G = G_; c = c_; }
    __device__ __forceinline__ bool next(int i, Unit& u) const {
        int L, hf; if (!deal_unit(i, G, c, nwg, L, hf)) return false; u.half = hf;
        int wgid = L; { const int q = nwg / NXCD, r = nwg % NXCD, xcd = wgid % NXCD, off = wgid / NXCD; wgid = (xcd < r ? xcd * (q + 1) : r * (q + 1) + (xcd - r) * q) + off; }
        const int nig = WGM * nN, gid = wgid / nig, fm = gid * WGM, gsz = (nM - fm) < WGM ? (nM - fm) : WGM;
        u.pm = fm + ((wgid % nig) % gsz); u.pn = (wgid % nig) / gsz; u.aux = 0; return true;
    }
    __device__ __forceinline__ int ktiles() const { return K / BK; }
    __device__ __forceinline__ const char* a_base() const { return A; }
    __device__ __forceinline__ size_t a_kstep() const { return BK * 2; }
    __device__ __forceinline__ unsigned a_off(const Unit& u, int row, int C) const { return (unsigned)((u.pm * BM + row) * K + C) * 2u; }
    __device__ __forceinline__ unsigned b_ld() const { return (unsigned)K * 2u; }
    __device__ __forceinline__ const char* b_tile(const Unit& u, int t) const { return Bt + (size_t)u.pn * BM * K * 2 + (size_t)t * (BK * 2); }
};

#ifndef PG8_SP2
#define PG8_SP2 true
#endif
#ifndef PG8_ALIGN
#define PG8_ALIGN true
#endif
template <class Epi, class Sched, bool SP2 = PG8_SP2, bool ALIGN_EPI = PG8_ALIGN>
__device__ __forceinline__ void gemm_phase(PG8_LAS unsigned char* lds, const Sched& S, const Epi& E) {
    const int tid = tid_fresh(), wid = __builtin_amdgcn_readfirstlane(tid >> 6), lane = tid & 63, wr = wid >> 2, wc = wid & 3, fr = lane & 15, fq = lane >> 4;
    const int nt = S.ktiles();
    unsigned voffB[2];
    const unsigned ldb = S.b_ld();
#pragma unroll
    for (int i = 0; i < 2; ++i) { int R, C; stage_rc(tid * 16 + i * 8192, R, C); const int Rb = Epi::PERM ? ((R & ~31) + perm32(R & 31)) : R; voffB[i] = (unsigned)Rb * ldb + (unsigned)C * 2u; }
    const unsigned hstepB = (unsigned)HALF * ldb;
    const unsigned ldsw = (unsigned)wid * 1024u;
    const int aoff = lds_byte(wr * 64 + fr, fq * 8), boff = lds_byte(wc * 32 + fr, fq * 8);
    const char* gA = S.a_base(); const size_t akst = S.a_kstep();
#define PG8_SA(b, h) (((b) * 2 + (h)) * HTB)
#define PG8_SB(b, h) ((4 + (b) * 2 + (h)) * HTB)
#define PG8_STAGE_A(bufoff, offarr, h, tt) do { _Pragma("unroll") for (int _i = 0; _i < 2; ++_i) \
        __builtin_amdgcn_global_load_lds((const unsigned*)(gA + (size_t)(tt) * akst + (offarr)[h][_i]), (PG8_LAS unsigned*)(lds + (bufoff) + ldsw + _i * 8192), 16, 0, 0); } while (0)
#define PG8_STAGE_B(bufoff, bptr, h) do { _Pragma("unroll") for (int _i = 0; _i < 2; ++_i) \
        __builtin_amdgcn_global_load_lds((const unsigned*)((bptr) + (h) * hstepB + voffB[_i]), (PG8_LAS unsigned*)(lds + (bufoff) + ldsw + _i * 8192), 16, 0, 0); } while (0)
#define PG8_LDA(dst, b, h) do { _Pragma("unroll") for (int m = 0; m < 4; ++m) _Pragma("unroll") for (int k = 0; k < 2; ++k) dst[m][k] = *(const PG8_LAS bf16x8*)(lds + PG8_SA(b, h) + aoff + m * 2048 + k * 1024); } while (0)
#define PG8_LDB(dst, b, h) do { _Pragma("unroll") for (int n = 0; n < 2; ++n) _Pragma("unroll") for (int k = 0; k < 2; ++k) dst[n][k] = *(const PG8_LAS bf16x8*)(lds + PG8_SB(b, h) + boff + n * 2048 + k * 1024); } while (0)
#define PG8_MMA(ai, bj, At, Bt) do { __builtin_amdgcn_s_setprio(1); _Pragma("unroll") for (int m = 0; m < 4; ++m) _Pragma("unroll") for (int n = 0; n < 2; ++n) _Pragma("unroll") for (int k = 0; k < 2; ++k) \
        acc[ai][bj][m][n] = __builtin_amdgcn_mfma_f32_16x16x32_bf16(Bt[n][k], At[m][k], acc[ai][bj][m][n], 0, 0, 0); __builtin_amdgcn_s_setprio(0); } while (0)
#define PG8_WAIT_V(n) asm volatile("s_waitcnt vmcnt(" #n ")" ::: "memory")
#define PG8_WAIT_L(n) asm volatile("s_waitcnt lgkmcnt(" #n ")" ::: "memory")
#define PG8_BAR __builtin_amdgcn_s_barrier()
#define PG8_SCHED __builtin_amdgcn_sched_barrier(0)
#define PG8_AOFFS(dst, u) do { _Pragma("unroll") for (int _i = 0; _i < 2; ++_i) { int _R, _C; stage_rc(tid * 16 + _i * 8192, _R, _C); _Pragma("unroll") for (int _h = 0; _h < 2; ++_h) dst[_h][_i] = S.a_off(u, ((u).half ? ((u).half == 2 ? HALF : 0) : _h * HALF) + _R, _C); } } while (0)
#define PG8_NOFF_PUT() do { *(PG8_LAS u32x4*)(lds + Sched::GOFF_LDS + tid * 16) = (u32x4){noff[0][0], noff[0][1], noff[1][0], noff[1][1]}; } while (0)
#define PG8_NOFF_GET(dst) do { const u32x4 _v = *(const PG8_LAS u32x4*)(lds + Sched::GOFF_LDS + tid * 16); dst[0][0] = _v.x; dst[0][1] = _v.y; dst[1][0] = _v.z; dst[1][1] = _v.w; } while (0)
    Unit cur, nxt; int ui = 0;
    if (!S.next(0, cur)) return;
    f32x4 acc[2][2][4][2];
#pragma unroll
    for (int a = 0; a < 2; ++a)
#pragma unroll
        for (int b = 0; b < 2; ++b)
#pragma unroll
            for (int m = 0; m < 4; ++m)
#pragma unroll
                for (int n = 0; n < 2; ++n) acc[a][b][m][n] = (f32x4){0.f, 0.f, 0.f, 0.f};
    bf16x8 At[4][2], B0[2][2], B1[2][2];
    constexpr bool GATHER = Sched::GATHER;
    unsigned coff[2][2], noff[2][2];
    PG8_AOFFS(coff, cur);
    { const char* b0 = S.b_tile(cur, 0); const char* b1 = S.b_tile(cur, 1);
      if constexpr (SP2) {
      PG8_STAGE_B(PG8_SB(0, 0), b0, 0); PG8_STAGE_B(PG8_SB(0, 1), b0, 1); PG8_STAGE_A(PG8_SA(0, 0), coff, 0, 0); PG8_STAGE_A(PG8_SA(0, 1), coff, 1, 0);
      if (wr == 1) PG8_BAR;
      PG8_WAIT_V(2); PG8_BAR;
      PG8_STAGE_B(PG8_SB(1, 0), b1, 0); PG8_STAGE_A(PG8_SA(1, 0), coff, 0, 1); PG8_STAGE_B(PG8_SB(1, 1), b1, 1);
      PG8_WAIT_V(6); PG8_BAR;
      } else {
      PG8_STAGE_B(PG8_SB(0, 0), b0, 0); PG8_STAGE_A(PG8_SA(0, 0), coff, 0, 0); PG8_STAGE_B(PG8_SB(0, 1), b0, 1); PG8_STAGE_A(PG8_SA(0, 1), coff, 1, 0);
      if (wr == 1) PG8_BAR;
      PG8_WAIT_V(4); PG8_BAR;
      PG8_STAGE_B(PG8_SB(1, 0), b1, 0); PG8_STAGE_A(PG8_SA(1, 0), coff, 0, 1); PG8_STAGE_B(PG8_SB(1, 1), b1, 1);
      PG8_WAIT_V(6); PG8_BAR; } }
    for (;;) {
        const bool has_next = S.next(ui + 1, nxt);
        if (has_next) { if constexpr (GATHER) { PG8_AOFFS(noff, nxt); PG8_NOFF_PUT(); } }
        else { nxt = cur;
#pragma unroll
            for (int _h = 0; _h < 2; ++_h)
#pragma unroll
                for (int _i = 0; _i < 2; ++_i) if constexpr (GATHER) noff[_h][_i] = coff[_h][_i]; if constexpr (GATHER) PG8_NOFF_PUT(); }
        for (int t = 0; t < nt; t += 2) {
            const bool last = (t == nt - 2);
            const int t2 = last ? 0 : t + 2, t3 = t2 + 1;
            const char* b2 = last ? S.b_tile(nxt, 0) : S.b_tile(cur, t + 2);
            const char* b3 = last ? S.b_tile(nxt, 1) : S.b_tile(cur, t + 3);
            unsigned o2[2][2];
            if constexpr (GATHER) {
#pragma unroll
                for (int _h = 0; _h < 2; ++_h)
#pragma unroll
                    for (int _i = 0; _i < 2; ++_i) o2[_h][_i] = coff[_h][_i];
                if (last) PG8_NOFF_GET(o2); }
            else { if (last) PG8_AOFFS(o2, nxt); else PG8_AOFFS(o2, cur); PG8_AOFFS(coff, cur); }
            if constexpr (SP2) {
            PG8_LDB(B0, 0, 0); PG8_LDB(B1, 0, 1); PG8_SCHED; PG8_LDA(At, 0, 0); PG8_STAGE_A(PG8_SA(1, 1), coff, 1, t + 1);
            PG8_WAIT_V(8); PG8_WAIT_L(0); PG8_BAR; PG8_MMA(0, 0, At, B0); PG8_MMA(0, 1, At, B1); PG8_BAR; PG8_SCHED;
            PG8_LDA(At, 0, 1); PG8_STAGE_B(PG8_SB(0, 0), b2, 0); PG8_STAGE_B(PG8_SB(0, 1), b2, 1); PG8_STAGE_A(PG8_SA(0, 0), o2, 0, t2);
            PG8_WAIT_V(8); PG8_WAIT_L(0); PG8_BAR; if (!cur.half) { PG8_MMA(1, 0, At, B0); PG8_MMA(1, 1, At, B1); } PG8_BAR; PG8_SCHED;
            PG8_LDB(B0, 1, 0); PG8_LDB(B1, 1, 1); PG8_SCHED; PG8_LDA(At, 1, 0); PG8_STAGE_A(PG8_SA(0, 1), o2, 1, t2);
            PG8_WAIT_V(8); PG8_WAIT_L(0); PG8_BAR; PG8_MMA(0, 0, At, B0); PG8_MMA(0, 1, At, B1); PG8_BAR; PG8_SCHED;
            PG8_LDA(At, 1, 1); PG8_STAGE_B(PG8_SB(1, 0), b3, 0); PG8_STAGE_B(PG8_SB(1, 1), b3, 1); PG8_STAGE_A(PG8_SA(1, 0), o2, 0, t3);
            PG8_WAIT_V(8); PG8_WAIT_L(0); PG8_BAR; if (!cur.half) { PG8_MMA(1, 0, At, B0); PG8_MMA(1, 1, At, B1); } PG8_BAR; PG8_SCHED;
            } else {
            PG8_LDB(B0, 0, 0); PG8_SCHED; PG8_LDA(At, 0, 0); PG8_STAGE_A(PG8_SA(1, 1), coff, 1, t + 1);
            PG8_WAIT_L(8); PG8_BAR; PG8_WAIT_L(0); PG8_MMA(0, 0, At, B0); PG8_BAR; PG8_SCHED;
            PG8_LDB(B1, 0, 1); PG8_STAGE_B(PG8_SB(0, 0), b2, 0);
            PG8_BAR; PG8_WAIT_L(0); PG8_MMA(0, 1, At, B1); PG8_BAR;
            PG8_LDA(At, 0, 1); PG8_STAGE_A(PG8_SA(0, 0), o2, 0, t2);
            PG8_BAR; PG8_WAIT_L(0); PG8_MMA(1, 0, At, B0); PG8_BAR; PG8_SCHED;
            PG8_STAGE_B(PG8_SB(0, 1), b2, 1);
            PG8_WAIT_V(6); PG8_BAR; PG8_MMA(1, 1, At, B1); PG8_BAR;
            PG8_LDB(B0, 1, 0); PG8_SCHED; PG8_LDA(At, 1, 0); PG8_STAGE_A(PG8_SA(0, 1), o2, 1, t2);
            PG8_WAIT_L(8); PG8_BAR; PG8_WAIT_L(0); PG8_MMA(0, 0, At, B0); PG8_BAR; PG8_SCHED;
            PG8_LDB(B1, 1, 1); PG8_STAGE_B(PG8_SB(1, 0), b3, 0);
            PG8_BAR; PG8_WAIT_L(0); PG8_MMA(0, 1, At, B1); PG8_BAR;
            PG8_LDA(At, 1, 1); PG8_STAGE_A(PG8_SA(1, 0), o2, 0, t3);
            PG8_BAR; PG8_WAIT_L(0); PG8_MMA(1, 0, At, B0); PG8_BAR; PG8_SCHED;
            PG8_STAGE_B(PG8_SB(1, 1), b3, 1);
            PG8_WAIT_V(6); PG8_BAR; PG8_MMA(1, 1, At, B1); PG8_BAR;
            }
        }
        if constexpr (ALIGN_EPI) { if (wr == 0) PG8_BAR; }
        if constexpr (!Epi::AFTER_DRAIN) E(acc, cur, wr, wc, fr, fq);
        if (!has_next) break;
#pragma unroll
        for (int a = 0; a < 2; ++a)
#pragma unroll
            for (int b = 0; b < 2; ++b)
#pragma unroll
                for (int m = 0; m < 4; ++m)
#pragma unroll
                    for (int n = 0; n < 2; ++n) acc[a][b][m][n] = (f32x4){0.f, 0.f, 0.f, 0.f};
        cur = nxt; ++ui;
        if constexpr (ALIGN_EPI) { if (wr == 1) PG8_BAR; }
#pragma unroll
        for (int _h = 0; _h < 2; ++_h)
#pragma unroll
            for (int _i = 0; _i < 2; ++_i) if constexpr (GATHER) coff[_h][_i] = 0u;
        if constexpr (GATHER) PG8_NOFF_GET(coff);
    }
    PG8_WAIT_V(0);
    if constexpr (!ALIGN_EPI) { if (wr == 0) PG8_BAR; }
    PG8_BAR;
    if constexpr (Epi::AFTER_DRAIN) E.fused(acc, cur, wr, wc, fr, fq, lds);
#undef PG8_SA
#undef PG8_SB
#undef PG8_STAGE_A
#undef PG8_STAGE_B
#undef PG8_LDA
#undef PG8_LDB
#undef PG8_MMA
#undef PG8_WAIT_V
#undef PG8_WAIT_L
#undef PG8_BAR
#undef PG8_SCHED
#undef PG8_AOFFS
#undef PG8_NOFF_PUT
#undef PG8_NOFF_GET
}

struct EpiBf16Store {
    static constexpr bool PERM = true, AFTER_DRAIN = false;
    bf16* O; int ldc;
    __device__ __forceinline__ void operator()(const f32x4 (&acc)[2][2][4][2], const Unit& u, int wr, int wc, int fr, int fq) const {
        const int row0 = u.pm * BM + wr * 64 + fr + (u.half == 2 ? HALF : 0), col0 = u.pn * BM + wc * 32 + 8 * fq;
#pragma unroll
        for (int ai = 0; ai < 2; ++ai)
#pragma unroll
            for (int m = 0; m < 4; ++m) { if (ai == 1 && u.half) continue; bf16* rowp = O + (size_t)(row0 + ai * HALF + m * 16) * ldc + col0;
#pragma unroll
                for (int bj = 0; bj < 2; ++bj) { const f32x4 v0 = acc[ai][bj][m][0], v1 = acc[ai][bj][m][1];
                    u32x4 w; w.x = cvt_pk_bf16(v0[0], v0[1]); w.y = cvt_pk_bf16(v0[2], v0[3]); w.z = cvt_pk_bf16(v1[0], v1[1]); w.w = cvt_pk_bf16(v1[2], v1[3]);
                    *(u32x4*)(rowp + bj * HALF) = w; } }
    }
};
struct EpiResidual {
    static constexpr bool PERM = true, AFTER_DRAIN = false;
    const void* xs; bool xbf; bf16* out; const float* gate;
    __device__ __forceinline__ void operator()(const f32x4 (&acc)[2][2][4][2], const Unit& u, int wr, int wc, int fr, int fq) const {
        const int row0 = u.pm * BM + wr * 64 + fr + (u.half == 2 ? HALF : 0), col0 = u.pn * BM + wc * 32 + 8 * fq;
        const float* gp = gate + (size_t)((u.pm * BM) / NS) * 6144 + col0;
        f32x4 gv[2][2];
#pragma unroll
        for (int bj = 0; bj < 2; ++bj)
#pragma unroll
            for (int n = 0; n < 2; ++n) gv[bj][n] = *(const f32x4*)(gp + bj * HALF + n * 4);
#pragma unroll
        for (int ai = 0; ai < 2; ++ai) { if (ai == 1 && u.half) continue;
#pragma unroll
          for (int mp = 0; mp < 2; ++mp) {
            f32x4 x0[2][2], x1[2][2];
#pragma unroll
            for (int mm = 0; mm < 2; ++mm) { const size_t ro = (size_t)(row0 + ai * HALF + (2 * mp + mm) * 16) * D + col0;
#pragma unroll
                for (int bj = 0; bj < 2; ++bj) {
                    if (xbf) { const u32x4 w = *(const u32x4*)((const bf16*)xs + ro + bj * HALF);
                        x0[mm][bj] = (f32x4){__builtin_bit_cast(float, w.x << 16), __builtin_bit_cast(float, w.x & 0xffff0000u), __builtin_bit_cast(float, w.y << 16), __builtin_bit_cast(float, w.y & 0xffff0000u)};
                        x1[mm][bj] = (f32x4){__builtin_bit_cast(float, w.z << 16), __builtin_bit_cast(float, w.z & 0xffff0000u), __builtin_bit_cast(float, w.w << 16), __builtin_bit_cast(float, w.w & 0xffff0000u)}; }
                    else { x0[mm][bj] = *(const f32x4*)((const float*)xs + ro + bj * HALF); x1[mm][bj] = *(const f32x4*)((const float*)xs + ro + bj * HALF + 4); } } }
#pragma unroll
            for (int mm = 0; mm < 2; ++mm) { const int m = 2 * mp + mm; const size_t ro = (size_t)(row0 + ai * HALF + m * 16) * D + col0;
#pragma unroll
                for (int bj = 0; bj < 2; ++bj) { const f32x4 y0 = x0[mm][bj] + gv[bj][0] * acc[ai][bj][m][0], y1 = x1[mm][bj] + gv[bj][1] * acc[ai][bj][m][1];
                    u32x4 o; o.x = cvt_pk_bf16(y0[0], y0[1]); o.y = cvt_pk_bf16(y0[2], y0[3]); o.z = cvt_pk_bf16(y1[0], y1[1]); o.w = cvt_pk_bf16(y1[2], y1[3]);
                    *(u32x4*)(out + ro + bj * HALF) = o; } } } }
    }
};
}
constexpr int NTH = 512;
typedef float f32x4_t __attribute__((ext_vector_type(4)));
typedef unsigned u32x4_t __attribute__((ext_vector_type(4)));
typedef unsigned u32x2_t __attribute__((ext_vector_type(2)));
typedef short s16x8_t __attribute__((ext_vector_type(8)));
#define LDSP(T, off) ((LAS T*)(lds + (off)))
__device__ __forceinline__ float wave_sum(float v) {
#pragma unroll
    for (int o = 1; o < 64; o <<= 1) v += __shfl_xor(v, o);
    return v;
}
__device__ __forceinline__ unsigned pk_bf16(float lo, float hi) { return pg8::cvt_pk_bf16(lo, hi); }

constexpr int CVT_WIN = 2 * 16 * 44, CVT_WOUT = 2 * 16 * 16, CVT_G = 32 * 16 * 8, CVT_U = CVT_G, CVT_D = 32 * 8 * 16, CVT_C1 = 4 * 32 * 2, CVT_C2 = 4 * 2;
constexpr int CVT_TOTAL = CVT_WIN + CVT_WOUT + CVT_G + CVT_U + CVT_D + CVT_C1 + CVT_C2;
__device__ __forceinline__ void cvt_job(const P& p, int T, const float*& src, size_t& lds_, bf16*& dst, size_t& ldd, bool& perm) {
    perm = false;
    if (T < CVT_WIN) { const int l = T / 704, r = T % 704, kt = r / 44, nt = r % 44;
        src = p.w_in + (size_t)l * D * NIN + (size_t)kt * 64 * NIN + nt * 64; lds_ = NIN; dst = WSP(bf16, WS_WIN_T) + (size_t)l * ZW * D + (size_t)((nt / 4) * 256 + (nt % 4) * 32) * D + kt * 64; ldd = D; perm = true; return; }
    T -= CVT_WIN;
    if (T < CVT_WOUT) { const int l = T / 256, r = T % 256, kt = r / 16, nt = r % 16;
        src = p.w_out + (size_t)l * D * D + (size_t)kt * 64 * D + nt * 64; lds_ = D; dst = WSP(bf16, WS_WOUT_T) + (size_t)l * D * D + (size_t)nt * 64 * D + kt * 64; ldd = D; return; }
    T -= CVT_WOUT;
    if (T < CVT_G + CVT_U) { const int up = T >= CVT_G; if (up) T -= CVT_G; const int le = T / 128, r = T % 128, kt = r / 8, nt = r % 8;
        src = (up ? p.moe_w_up : p.moe_w_gate) + (size_t)le * D * 512 + (size_t)kt * 64 * 512 + nt * 64; lds_ = 512;
        const int row0 = 256 * (nt / 2) + 64 * (nt % 2) + (up ? 128 : 0);
        dst = WSP(bf16, WS_WGU_T) + (size_t)le * 1024 * D + (size_t)row0 * D + kt * 64; ldd = D; return; }
    T -= CVT_G + CVT_U;
    if (T < CVT_D) { const int le = T / 128, r = T % 128, kt = r / 16, nt = r % 16;
        src = p.moe_w_down + (size_t)le * 512 * D + (size_t)kt * 64 * D + nt * 64; lds_ = D; dst = WSP(bf16, WS_WD_T) + (size_t)le * D * 512 + (size_t)nt * 64 * 512 + kt * 64; ldd = 512; return; }
    T -= CVT_D;
    if (T < CVT_C1) { const int lk = T / 64, l = lk / 2, kv = lk % 2, r = T % 64, kt = r / 2, nt = r % 2;
        src = (kv ? p.cmp_w1_v : p.cmp_w1_k) + (size_t)l * 2048 * 128 + (size_t)kt * 64 * 128 + nt * 64; lds_ = 128; dst = WSP(bf16, WS_CW1_T) + (size_t)lk * 256 * 1024 + (size_t)((kt >= 16 ? 128 : 0) + nt * 64) * 1024 + (kt & 15) * 64; ldd = 1024; return; }
    T -= CVT_C1;
    { const int lk = T / 2, l = lk / 2, kv = lk % 2, kt = T % 2;
        src = (kv ? p.cmp_w2_v : p.cmp_w2_k) + (size_t)l * 128 * 64 + (size_t)kt * 64 * 64; lds_ = 64; dst = WSP(bf16, WS_CW2_T) + (size_t)lk * 64 * 128 + kt * 64; ldd = 128; }
}
__device__ __forceinline__ void p0_prologue(const P& p, LAS unsigned char* lds) {
    const int tid = tid_fresh();
    if (bid_fresh() < 192) {
        LAS float* sc = LDSP(float, 0);
        LAS float* red = LDSP(float, 65536);
        for (int i = tid; i < NB * D; i += NTH) sc[i] = silu_f(p.c[i]);
        __syncthreads();
        const int lane = tid & 63, wv_ = tid >> 6, col = bid_fresh() * 64 + lane, l = col / 6144, n = col % 6144;
        float acc[NB];
#pragma unroll
        for (int b = 0; b < NB; ++b) acc[b] = 0.f;
        const float* w = p.ada_w + (size_t)l * D * 6144 + n;
        for (int k = wv_ * 128; k < wv_ * 128 + 128; k += 16) { float wv[16];
#pragma unroll
            for (int u = 0; u < 16; ++u) wv[u] = w[(size_t)(k + u) * 6144];
#pragma unroll
            for (int u = 0; u < 16; ++u)
#pragma unroll
                for (int b = 0; b < NB; ++b) acc[b] += sc[b * D + k + u] * wv[u]; }
#pragma unroll
        for (int b = 0; b < NB; ++b) red[(wv_ * NB + b) * 64 + lane] = acc[b];
        __syncthreads();
        for (int i = tid; i < NB * 64; i += NTH) { const int b = i >> 6, c = i & 63, cc = bid_fresh() * 64 + c, ll = cc / 6144, nn = cc % 6144; float s = p.ada_b[ll * 6144 + nn];
#pragma unroll
            for (int q = 0; q < 8; ++q) s += red[(q * NB + b) * 64 + c];
            WSP(float, WS_MOD)[((size_t)ll * NB + b) * 6144 + nn] = s; }
        __syncthreads();
    }
    { constexpr int TP = 8; const int G = grid_fresh(), bx = bid_fresh();
      for (int T0 = bx * TP; T0 < CVT_TOTAL; T0 += G * TP) {
        f32x4_t va[TP], vb[TP]; bf16* dst[TP]; size_t ld[TP]; bool perm[TP];
        const int k = tid >> 3, ns = (tid & 7) * 8;
#pragma unroll
        for (int q = 0; q < TP; ++q) { const int T = T0 + q < CVT_TOTAL ? T0 + q : CVT_TOTAL - 1; const float* src; size_t ls; cvt_job(p, T, src, ls, dst[q], ld[q], perm[q]);
            va[q] = *(const f32x4_t*)(src + (size_t)k * ls + ns); vb[q] = *(const f32x4_t*)(src + (size_t)k * ls + ns + 4); }
#pragma unroll
        for (int q = 0; q < TP; ++q) { LAS float* tile = LDSP(float, q * 64 * 65 * 4);
#pragma unroll
            for (int j = 0; j < 4; ++j) { tile[k * 65 + ns + j] = va[q][j]; tile[k * 65 + ns + 4 + j] = vb[q][j]; } }
        __syncthreads();
#pragma unroll
        for (int q = 0; q < TP; ++q) { if (T0 + q < CVT_TOTAL) { LAS float* tile = LDSP(float, q * 64 * 65 * 4); const int n = tid >> 3, ks = (tid & 7) * 8; u32x4_t w;
            w.x = pk_bf16(tile[(ks + 0) * 65 + n], tile[(ks + 1) * 65 + n]); w.y = pk_bf16(tile[(ks + 2) * 65 + n], tile[(ks + 3) * 65 + n]);
            w.z = pk_bf16(tile[(ks + 4) * 65 + n], tile[(ks + 5) * 65 + n]); w.w = pk_bf16(tile[(ks + 6) * 65 + n], tile[(ks + 7) * 65 + n]);
            const int nrow = perm[q] ? 128 * (n >> 5) + (n & 31) : n;
            *(u32x4_t*)(dst[q] + (size_t)nrow * ld[q] + ks) = w; } }
        __syncthreads();
      } }
    const long gid = (long)bid_fresh() * NTH + tid, gsz = (long)grid_fresh() * NTH;
    for (long i = gid; i < 2L * 32 * D; i += gsz) { const int k = (int)(i % D), j = (int)((i / D) % 32), l = (int)(i / (32 * D));
        WSP(bf16, WS_WGL_T)[i] = j < 24 ? f2bf(p.w_in[(size_t)l * D * NIN + (size_t)k * NIN + ZW + j]) : (bf16)0; }
    { const int lane = tid & 63, gw = (int)(gid >> 6), nw = (int)(gsz >> 6);
      for (int o = gw; o < 2 * 2 * 128; o += nw) { const int j = o % 128, kv = (o / 128) % 2, l = o / 256;
        const float* pe = (kv ? p.cmp_pe_v : p.cmp_pe_k) + (size_t)l * 2048; const float* w1 = (kv ? p.cmp_w1_v : p.cmp_w1_k) + (size_t)l * 2048 * 128 + j; float sacc = 0.f;
#pragma unroll 8
        for (int k = lane; k < 2048; k += 64) sacc += pe[k] * w1[(size_t)k * 128];
        sacc = wave_sum(sacc); if (lane == 0) WSP(float, WS_PEB)[o] = sacc; } }
    if (gid < 6) { const int l = (int)gid / 3, br = (int)gid % 3; float mq = 0.f, mk = 0.f;
        for (int e = 0; e < 64; ++e) { mq = fmaxf(mq, fabsf(p.nsa_q_norm_g[l * 64 + e])); mk = fmaxf(mk, fabsf(p.nsa_k_norm_g[(l * 3 + br) * 64 + e])); }
        WSP(float, WS_BND)[gid] = 8.f * mq * mk * 1.4426950408889634f; }
    for (long i = gid; i < 2L * 4 * 128 * 128; i += gsz) { const int s = (int)(i % 128), t = (int)((i / 128) % 128); WSP(bf16, WS_GWS)[i] = s <= t ? f2bf(p.gmlp_ws[i]) : (bf16)0; }
    for (long i = gid; i < (long)M * 32; i += gsz) { const long m = i / 32; const int j = (int)(i % 32); const float ang = (float)p.pos[m] * invfreq(j);
        const float cv = cosf(ang), sv = sinf(ang); WSP(float, WS_CS)[m * 64 + j] = cv; WSP(float, WS_CS)[m * 64 + 32 + j] = sv; WSP(bf16, WS_CSB)[m * 64 + j] = f2bf(cv); WSP(bf16, WS_CSB)[m * 64 + 32 + j] = f2bf(sv); }
}

__device__ __forceinline__ f32x4_t ld4x(const void* base, size_t idx, bool isbf) {
    if (isbf) { const u32x2_t w = *(const u32x2_t*)((const bf16*)base + idx); return (f32x4_t){__builtin_bit_cast(float, w.x << 16), __builtin_bit_cast(float, w.x & 0xffff0000u), __builtin_bit_cast(float, w.y << 16), __builtin_bit_cast(float, w.y & 0xffff0000u)}; }
    return *(const f32x4_t*)((const float*)base + idx); }
__device__ __forceinline__ void norm_phase(const P& p, LAS unsigned char* lds, const void* xs, bool xbf, int l, int which, int cbank = -1) {
    if (cbank < 0) cbank = l;
    const int tid = tid_fresh(), lane = tid & 63, wave = tid >> 6;
    const float* g = (which ? p.norm_ffn_g : p.norm_mix_g) + l * D;
    bf16* H = WSP(bf16, WS_H);
    LAS float* wr_l = LDSP(float, 0);
    LAS float* lg_l = LDSP(float, 65536);
    LAS int* lcnt = LDSP(int, 65536 + 8192);
    LAS float* red_l = LDSP(float, 65536 + 8192 + 256);
    LAS float* rs_l = LDSP(float, 65536 + 8192 + 256 + 2048);
    for (int rb = bid_fresh(); rb < M / 128; rb += grid_fresh()) {
        const int b = (rb * 128) / NS; const float* mod = WSP(float, WS_MOD) + ((size_t)l * NB + b) * 6144 + which * 3072;
        if (which) {
            __syncthreads();
            if (tid < 48) lcnt[tid] = 0;
            for (int i = tid; i < D * 16; i += NTH) { const int k = i >> 4, e = i & 15; wr_l[(k >> 4) * 256 + ((k >> 2) & 3) * 64 + e * 4 + (k & 3)] = g[k] * (1.f + mod[1024 + k]) * p.router_w[i]; }
            if (tid < 256) { const int e = tid & 15, part = tid >> 4; float s = 0.f; for (int k = part * 64; k < part * 64 + 64; ++k) s += mod[k] * p.router_w[k * 16 + e]; red_l[part * 16 + e] = s; }
            __syncthreads();
            if (tid < 16) { float s = 0.f;
#pragma unroll
                for (int q = 0; q < 16; ++q) s += red_l[q * 16 + tid]; red_l[256 + tid] = s; }
            __syncthreads();
            const int r = lane & 15, kq = lane >> 4; const size_t xr = (size_t)((long)rb * 128 + wave * 16 + r) * D + 4 * kq;
            f32x4_t acc = {0.f, 0.f, 0.f, 0.f}; float ss = 0.f;
#pragma unroll 8
            for (int t = 0; t < 64; ++t) { const f32x4_t xv = ld4x(xs, xr + 16 * t, xbf); const f32x4_t av = *(const LAS f32x4_t*)(wr_l + t * 256 + kq * 64 + r * 4);
                ss += xv[0] * xv[0] + xv[1] * xv[1] + xv[2] * xv[2] + xv[3] * xv[3];
                acc = __builtin_amdgcn_mfma_f32_16x16x4f32(av[0], xv[0], acc, 0, 0, 0); acc = __builtin_amdgcn_mfma_f32_16x16x4f32(av[1], xv[1], acc, 0, 0, 0);
                acc = __builtin_amdgcn_mfma_f32_16x16x4f32(av[2], xv[2], acc, 0, 0, 0); acc = __builtin_amdgcn_mfma_f32_16x16x4f32(av[3], xv[3], acc, 0, 0, 0); }
            ss += __shfl_xor(ss, 16); ss += __shfl_xor(ss, 32);
            const float rs = 1.0f / sqrtf(ss * (1.f / D) + EPS);
            if (kq == 0) rs_l[wave * 16 + r] = rs;
#pragma unroll
            for (int reg = 0; reg < 4; ++reg) lg_l[(wave * 16 + r) * 16 + 4 * kq + reg] = rs * acc[reg] + red_l[256 + 4 * kq + reg];
        }
        f32x4_t gmv[4], shv[4];
#pragma unroll
        for (int i = 0; i < 4; ++i) { const int k0 = 256 * i + 4 * lane; const f32x4_t gv = *(const f32x4_t*)(g + k0), sc = *(const f32x4_t*)(mod + 1024 + k0); shv[i] = *(const f32x4_t*)(mod + k0);
#pragma unroll
            for (int j = 0; j < 4; ++j) gmv[i][j] = gv[j] * (1.f + sc[j]); }
        f32x4_t hn[4][4];
#pragma unroll
        for (int r = 0; r < 4; ++r)
#pragma unroll
            for (int i = 0; i < 4; ++i) hn[r][i] = ld4x(xs, (size_t)((long)rb * 128 + wave * 16 + r) * D + 256 * i + 4 * lane, xbf);
#pragma unroll
        for (int grp = 0; grp < 4; ++grp) {
            const long row0 = (long)rb * 128 + wave * 16 + grp * 4;
            f32x4_t hv[4][4]; float ss[4];
#pragma unroll
            for (int r = 0; r < 4; ++r) { ss[r] = 0.f;
#pragma unroll
                for (int i = 0; i < 4; ++i) { hv[r][i] = hn[r][i]; if (!which) ss[r] += hv[r][i][0] * hv[r][i][0] + hv[r][i][1] * hv[r][i][1] + hv[r][i][2] * hv[r][i][2] + hv[r][i][3] * hv[r][i][3]; } }
            if (grp < 3) {
#pragma unroll
                for (int r = 0; r < 4; ++r)
#pragma unroll
                    for (int i = 0; i < 4; ++i) hn[r][i] = ld4x(xs, (size_t)(row0 + 4 + r) * D + 256 * i + 4 * lane, xbf); }
#pragma unroll
            for (int r = 0; r < 4; ++r) ss[r] = which ? rs_l[wave * 16 + grp * 4 + r] : 1.0f / sqrtf(wave_sum(ss[r]) * (1.f / D) + EPS);
#pragma unroll
            for (int i = 0; i < 4; ++i) { const int k0 = 256 * i + 4 * lane;
#pragma unroll
                for (int r = 0; r < 4; ++r) { hv[r][i] = hv[r][i] * ss[r] * gmv[i] + shv[i];
                    u32x2_t w; w.x = pk_bf16(hv[r][i][0], hv[r][i][1]); w.y = pk_bf16(hv[r][i][2], hv[r][i][3]); *(u32x2_t*)(H + (row0 + r) * D + k0) = w; } }
        }
        if (which) {
            int cls = -1, rank = 0; float wa = 0.f, wb = 0.f; const long row = (long)rb * 128 + wave * 16 + lane;
            __builtin_amdgcn_s_waitcnt(0);
            if (lane < 16) {
                const LAS float* q = lg_l + (wave * 16 + lane) * 16;
                float mx = q[0];
#pragma unroll
                for (int e = 1; e < 16; ++e) mx = fmaxf(mx, q[e]);
                float den = 0.f;
#pragma unroll
                for (int e = 0; e < 16; ++e) den += expf(q[e] - mx);
                float bestg = -3e38f; int bg = 0;
#pragma unroll
                for (int gI = 0; gI < 4; ++gI) { float a = -3e38f, b2 = -3e38f;
#pragma unroll
                    for (int j = 0; j < 4; ++j) { const float s = expf(q[gI * 4 + j] - mx) / den + p.router_b[gI * 4 + j]; if (s > a) { b2 = a; a = s; } else if (s > b2) b2 = s; }
                    if (a + b2 > bestg) { bestg = a + b2; bg = gI; } }
                float a = -3e38f, b2 = -3e38f; int ia = 0, ib = 0;
#pragma unroll
                for (int j = 0; j < 4; ++j) { const float s = expf(q[bg * 4 + j] - mx) / den + p.router_b[bg * 4 + j];
                    if (s > a) { b2 = a; ib = ia; a = s; ia = j; } else if (s > b2) { b2 = s; ib = j; } }
                const float p0 = expf(q[bg * 4 + ia] - mx) / den, p1 = expf(q[bg * 4 + ib] - mx) / den;
                const float w0 = p0 / (p0 + p1), w1 = p1 / (p0 + p1);
                const int lo = ia < ib ? ia : ib, hi = ia < ib ? ib : ia;
                wa = ia < ib ? w0 : w1; wb = ia < ib ? w1 : w0;
                const int pairidx = lo == 0 ? hi - 1 : (lo == 1 ? hi + 1 : 5);
                cls = bg * 6 + pairidx;
                rank = atomicAdd((int*)&lcnt[cls], 1);
                Rout r; r.e0 = bg * 4 + ia; r.e1 = bg * 4 + ib; r.w0 = w0; r.w1 = w1; WSP(Rout, WS_ROUT)[row] = r;
            }
            __syncthreads();
            if (tid < 24) { const int c = lcnt[tid]; lcnt[24 + tid] = c ? atomicAdd(WSP(int, WS_CTL) + CW_CNT + cbank * 64 + tid, c) : 0; }
            __syncthreads();
            if (lane < 16) { const int slot = lcnt[24 + cls] + rank; WSP(int, WS_CTOK)[(size_t)cls * M + slot] = (int)row; float* wp = WSP(float, WS_CWT) + ((size_t)cls * M + slot) * 2; wp[0] = wa; wp[1] = wb; }
            __syncthreads();
            if (tid < 24) lcnt[tid] = 0;
            __syncthreads();
        }
    }
}

__device__ __forceinline__ void gl_tail(const P& p, int l) {
    const int tid = tid_fresh(), lane = tid & 63, wave = tid >> 6, fr = lane & 15, fq = lane >> 4;
    const bf16* H = WSP(bf16, WS_H); const bf16* W = WSP(bf16, WS_WGL_T) + (size_t)l * 32 * D; float* GL = WSP(float, WS_GL);
    for (int rt = bid_fresh() * 8 + wave; rt < M / 16; rt += grid_fresh() * 8) {
        pg8::f32x4 acc0 = {0.f, 0.f, 0.f, 0.f}, acc1 = {0.f, 0.f, 0.f, 0.f};
        const bf16* ap = H + (size_t)(rt * 16 + fr) * D + fq * 8; const bf16* bp0 = W + (size_t)fr * D + fq * 8; const bf16* bp1 = W + (size_t)(16 + fr) * D + fq * 8;
#pragma unroll 8
        for (int s = 0; s < 32; ++s) { const s16x8_t a = *(const s16x8_t*)(ap + s * 32), b0 = *(const s16x8_t*)(bp0 + s * 32), b1 = *(const s16x8_t*)(bp1 + s * 32);
            acc0 = __builtin_amdgcn_mfma_f32_16x16x32_bf16(a, b0, acc0, 0, 0, 0); acc1 = __builtin_amdgcn_mfma_f32_16x16x32_bf16(a, b1, acc1, 0, 0, 0); }
#pragma unroll
        for (int r = 0; r < 4; ++r) { const long m = (long)rt * 16 + 4 * fq + r; GL[m * 24 + fr] = acc0[r]; if (fr < 8) GL[m * 24 + 16 + fr] = acc1[r]; }
    }
}

struct EpiZ {
    static constexpr bool PERM = true, AFTER_DRAIN = false;
    const P* pp; int l;
    __device__ __forceinline__ void operator()(const pg8::f32x4 (&acc)[2][2][4][2], const pg8::Unit& u, int wr, int wc, int fr, int fq) const {
        const P& p = *pp; bf16* Z = WSP(bf16, WS_Z); const bf16* CSB = WSP(bf16, WS_CSB);
        const int pn = u.pn;
        int mode = 0; float scale = 1.f; const float* gain = nullptr;
        if (pn == 0) mode = 1; else if (pn == 1) { mode = 1; scale = 0.125f; } else if (pn == 3) mode = 3; else if (pn == 4 || pn == 5) mode = 4;
        else if (pn == 6 || pn == 7) { mode = 2; scale = 0.125f; gain = p.nsa_q_norm_g + l * 64; }
        else if (pn == 9 && wc < 2) { mode = 2; gain = p.nsa_k_norm_g + (l * 3 + 1) * 64; }
        else if (pn == 10 && wc < 2) { mode = 2; gain = p.nsa_k_norm_g + (l * 3 + 2) * 64; }
        float g0[8], g1[8];
        if (mode == 2) {
#pragma unroll
            for (int j = 0; j < 8; ++j) { g0[j] = gain[8 * fq + j] * scale; g1[j] = gain[32 + 8 * fq + j] * scale; } }
        else {
#pragma unroll
            for (int j = 0; j < 8; ++j) { g0[j] = scale; g1[j] = scale; } }
        const int row0 = u.pm * 256 + wr * 64 + fr + (u.half == 2 ? 128 : 0), col0 = pn * 256 + wc * 64 + 8 * fq;
        float posf[2][4], frq[8];
        if (mode == 1 || mode == 2) {
#pragma unroll
            for (int ai = 0; ai < 2; ++ai)
#pragma unroll
                for (int m = 0; m < 4; ++m) posf[ai][m] = (float)p.pos[row0 + (u.half ? 0 : ai * 128) + m * 16];
#pragma unroll
            for (int j = 0; j < 8; ++j) frq[j] = invfreq(8 * fq + j) * 0.15915494309189535f; }
#pragma unroll
        for (int ai = 0; ai < 2; ++ai) { if (ai == 1 && u.half) continue;
#pragma unroll
         for (int mp = 0; mp < 2; ++mp) {
#pragma unroll
            for (int mm = 0; mm < 2; ++mm) { const int m = 2 * mp + mm; const long row = row0 + ai * 128 + m * 16;
                float a[8], b[8];
#pragma unroll
                for (int j = 0; j < 4; ++j) { a[j] = acc[ai][0][m][0][j]; a[4 + j] = acc[ai][0][m][1][j]; b[j] = acc[ai][1][m][0][j]; b[4 + j] = acc[ai][1][m][1][j]; }
                if (mode == 1 || mode == 2) {
                    float r = 1.f;
                    if (mode == 2) { float ss = 0.f;
#pragma unroll
                        for (int j = 0; j < 8; ++j) ss += a[j] * a[j] + b[j] * b[j];
                        ss += __shfl_xor(ss, 16); ss += __shfl_xor(ss, 32); r = __builtin_amdgcn_rsqf(ss * (1.f / 64.f) + EPS); }
#pragma unroll
                    for (int j = 0; j < 8; ++j) { const float tr = __builtin_amdgcn_fractf(posf[ai][m] * frq[j]); const float cs = __builtin_amdgcn_cosf(tr), sn = __builtin_amdgcn_sinf(tr);
                        const float x1 = a[j] * r * g0[j], x2 = b[j] * r * g1[j];
                        a[j] = x1 * cs - x2 * sn; b[j] = x1 * sn + x2 * cs; } }
                else if (mode == 3) {
#pragma unroll
                    for (int j = 0; j < 8; ++j) { a[j] = silu_fast(a[j]); b[j] = silu_fast(b[j]); } }
                else if (mode == 4) {
#pragma unroll
                    for (int j = 0; j < 8; ++j) { a[j] = gelu_fast(a[j]); b[j] = gelu_fast(b[j]); } }
                pg8::u32x4 wa, wb;
                wa.x = pk_bf16(a[0], a[1]); wa.y = pk_bf16(a[2], a[3]); wa.z = pk_bf16(a[4], a[5]); wa.w = pk_bf16(a[6], a[7]);
                wb.x = pk_bf16(b[0], b[1]); wb.y = pk_bf16(b[2], b[3]); wb.z = pk_bf16(b[4], b[5]); wb.w = pk_bf16(b[6], b[7]);
                *(pg8::u32x4*)(Z + row * ZW + col0) = wa; *(pg8::u32x4*)(Z + row * ZW + col0 + 32) = wb; } } }
    }
};
typedef short s16x4_t __attribute__((ext_vector_type(4)));
typedef float f32x4m __attribute__((ext_vector_type(4)));
#define MFMA16(a, b, c) __builtin_amdgcn_mfma_f32_16x16x32_bf16((a), (b), (c), 0, 0, 0)
constexpr int LP = 144;
__device__ __forceinline__ s16x4_t lds_tr4(LAS const unsigned char* p) { return __builtin_bit_cast(s16x4_t, __builtin_amdgcn_ds_read_tr16_b64_v4i16((LAS s16x4_t*)p)); }
__device__ __forceinline__ s16x8_t tr_frag(LAS const unsigned char* X, int P, int k0, int c0, int lane) {
    const int fq = lane >> 4, q = (lane & 15) >> 2, pp = lane & 3;
    LAS const unsigned char* a = X + (k0 + 8 * fq + q) * P + (c0 + 4 * pp) * 2;
    const s16x4_t lo = lds_tr4(a), hi = lds_tr4(a + 4 * P);
    return (s16x8_t){lo[0], lo[1], lo[2], lo[3], hi[0], hi[1], hi[2], hi[3]};
}
__device__ __forceinline__ s16x8_t tr_frag_perm(LAS const unsigned char* X, int P, int k0, int c0, int lane) {
    const int fq = lane >> 4, q = (lane & 15) >> 2, pp = lane & 3;
    LAS const unsigned char* a = X + (k0 + 4 * fq + q) * P + (c0 + 4 * pp) * 2;
    const s16x4_t lo = lds_tr4(a), hi = lds_tr4(a + 16 * P);
    return (s16x8_t){lo[0], lo[1], lo[2], lo[3], hi[0], hi[1], hi[2], hi[3]};
}
__device__ __forceinline__ s16x8_t pack8(const f32x4m& a, const f32x4m& b) {
    const unsigned w0 = pk_bf16(a[0], a[1]), w1 = pk_bf16(a[2], a[3]), w2 = pk_bf16(b[0], b[1]), w3 = pk_bf16(b[2], b[3]);
    return __builtin_bit_cast(s16x8_t, (u32x4_t){w0, w1, w2, w3});
}
__device__ __forceinline__ float bflo(unsigned u) { return __builtin_bit_cast(float, u << 16); }
__device__ __forceinline__ float bfhi(unsigned u) { return __builtin_bit_cast(float, u & 0xffff0000u); }

struct CmpSched {
    static constexpr bool GATHER = false; static constexpr int GOFF_LDS = 0;
    const P* pp; int l, c;
    __device__ __forceinline__ bool next(int i, pg8::Unit& u) const { if (i > 0 || c >= 32) return false; u.pm = c & 7; u.pn = 0; u.aux = c >> 3; u.half = 0; return true; }
    __device__ __forceinline__ int ktiles() const { return 16; }
    __device__ __forceinline__ const char* a_base() const { return (const char*)(pp->ws + WS_Z); }
    __device__ __forceinline__ size_t a_kstep() const { return (size_t)ZW * 2; }
    __device__ __forceinline__ unsigned a_off(const pg8::Unit& u, int row, int C) const {
        const int R = u.pm * 256 + row, kv = u.aux & 1, g = u.aux >> 1;
        return (unsigned)(((size_t)R * 16 * ZW + (kv ? C_VC : C_KC) + g * 64 + C) * 2); }
    __device__ __forceinline__ unsigned b_ld() const { return 1024 * 2u; }
    __device__ __forceinline__ const char* b_tile(const pg8::Unit& u, int t) const { return (const char*)(pp->ws + WS_CW1_T) + (size_t)(l * 2 + (u.aux & 1)) * 256 * 1024 * 2 + (size_t)t * 128; }
};
struct EpiCmp {
    static constexpr bool PERM = false, AFTER_DRAIN = true;
    const P* pp; int l;
    __device__ __forceinline__ void operator()(const pg8::f32x4 (&)[2][2][4][2], const pg8::Unit&, int, int, int, int) const {}
    __device__ __forceinline__ void fused(const pg8::f32x4 (&acc)[2][2][4][2], const pg8::Unit& u, int wr, int wc, int fr, int fq, LAS unsigned char* lds) const {
        const P& p = *pp; const int kv = u.aux & 1, g = u.aux >> 1, lane = tid_fresh() & 63, w = tid_fresh() >> 6;
        constexpr int HP = 272;
        constexpr int HOFF = 257 * HP;
        const float* bias = WSP(float, WS_PEB) + (l * 2 + kv) * 128;
#pragma unroll
        for (int n = 0; n < 2; ++n) { const int c = 32 * wc + 16 * n + 4 * fq;
#pragma unroll
            for (int ai = 0; ai < 2; ++ai)
#pragma unroll
                for (int m = 0; m < 4; ++m) { const int r = 128 * ai + 64 * wr + 16 * m + fr; const f32x4m v = acc[ai][1][m][n];
                    u32x2_t o; o.x = pk_bf16(v[0], v[1]); o.y = pk_bf16(v[2], v[3]); *(LAS u32x2_t*)(lds + r * HP + c * 2) = o; } }
        if (tid_fresh() < 32) { unsigned zz = 0u; asm volatile("" : "+v"(zz)); *(LAS u32x2_t*)(lds + 256 * HP + tid_fresh() * 8) = (u32x2_t){zz, zz}; }
        __syncthreads();
#pragma unroll
        for (int n = 0; n < 2; ++n) { const int c = 32 * wc + 16 * n + 4 * fq; const f32x4m bv = *(const f32x4m*)(bias + c);
#pragma unroll
            for (int ai = 0; ai < 2; ++ai)
#pragma unroll
                for (int m = 0; m < 4; ++m) { const int r = 128 * ai + 64 * wr + 16 * m + fr; const u32x2_t u1 = *(const LAS u32x2_t*)(lds + (r + 1) * HP + c * 2);
                    const f32x4m v = acc[ai][0][m][n] + bv + (f32x4m){bflo(u1.x), bfhi(u1.x), bflo(u1.y), bfhi(u1.y)};
                    u32x2_t o; o.x = pk_bf16(gelu_fast(v[0]), gelu_fast(v[1])); o.y = pk_bf16(gelu_fast(v[2]), gelu_fast(v[3])); *(LAS u32x2_t*)(lds + HOFF + r * HP + c * 2) = o; } }
        __syncthreads();
        const bf16* W2 = WSP(bf16, WS_CW2_T) + (size_t)(l * 2 + kv) * 64 * 128;
        const float* gk = p.nsa_k_norm_g + (l * 3 + 0) * 64;
#pragma unroll
        for (int rt = 0; rt < 2; ++rt) {
            f32x4m o[4];
#pragma unroll
            for (int ct = 0; ct < 4; ++ct) o[ct] = (f32x4m){0.f, 0.f, 0.f, 0.f};
#pragma unroll
            for (int s = 0; s < 4; ++s) { const s16x8_t a = *(const LAS s16x8_t*)(lds + HOFF + (32 * w + 16 * rt + fr) * HP + (32 * s + 8 * fq) * 2);
#pragma unroll
                for (int ct = 0; ct < 4; ++ct) { const s16x8_t b = *(const s16x8_t*)(W2 + (16 * ct + fr) * 128 + 32 * s + 8 * fq); o[ct] = MFMA16(a, b, o[ct]); } }
            float csv[4][4];
            if (kv == 0) {
#pragma unroll
                for (int reg = 0; reg < 4; ++reg) { const int R = u.pm * 256 + 32 * w + 16 * rt + 4 * fq + reg, b = R >> 7, n = R & 127, nn = n < NCMP ? n : NCMP - 1;
                    const float* cs = WSP(float, WS_CS) + ((size_t)b * NS + 16 * nn + 31) * 64; csv[reg][0] = cs[fr]; csv[reg][1] = cs[32 + fr]; csv[reg][2] = cs[16 + fr]; csv[reg][3] = cs[48 + fr]; } }
#pragma unroll
            for (int reg = 0; reg < 4; ++reg) { const int R = u.pm * 256 + 32 * w + 16 * rt + 4 * fq + reg, b = R >> 7, n = R & 127;
                float v0 = o[0][reg], v1 = o[1][reg], v2 = o[2][reg], v3 = o[3][reg];
                if (kv == 0) { float ss = v0 * v0 + v1 * v1 + v2 * v2 + v3 * v3;
                    ss += __shfl_xor(ss, 1); ss += __shfl_xor(ss, 2); ss += __shfl_xor(ss, 4); ss += __shfl_xor(ss, 8);
                    const float r = 1.0f / sqrtf(ss * (1.f / 64.f) + EPS);
                    v0 *= r * gk[fr]; v1 *= r * gk[16 + fr]; v2 *= r * gk[32 + fr]; v3 *= r * gk[48 + fr];
                    const float c0 = csv[reg][0], s0 = csv[reg][1], c1 = csv[reg][2], s1 = csv[reg][3];
                    const float a0 = v0 * c0 - v2 * s0, a2 = v0 * s0 + v2 * c0, a1 = v1 * c1 - v3 * s1, a3 = v1 * s1 + v3 * c1; v0 = a0; v1 = a1; v2 = a2; v3 = a3; }
                { if (n >= NCMP) { v0 = 0.f; v1 = 0.f; v2 = 0.f; v3 = 0.f; }
                    bf16* dst = (kv ? WSP(bf16, WS_VC) : WSP(bf16, WS_KC)) + ((size_t)(b * 2 + g) * (NCMP + 1) + n) * 64;
                    dst[fr] = f2bf(v0); dst[16 + fr] = f2bf(v1); dst[32 + fr] = f2bf(v2); dst[48 + fr] = f2bf(v3); } }
        }
        __syncthreads();
    }
};
__device__ __forceinline__ void ret_kv_unit(const P& p, LAS unsigned char* lds, int l, int unit) {
    const int tid = tid_fresh(), lane = tid & 63, w = tid >> 6, fr = lane & 15, fq = lane >> 4;
    const int c = unit % NCH, h = (unit / NCH) % 4, b = unit / (NCH * 4);
    const bf16* Z = WSP(bf16, WS_Z); const size_t m0 = (size_t)b * NS + (size_t)c * 128;
    const float lg2 = log2f(1.f - exp2f(-5.f - (float)h));
    LAS unsigned char* KL = lds; LAS unsigned char* VL = lds + 128 * LP;
#pragma unroll
    for (int i = 0; i < 2; ++i) { const int pc = tid + i * NTH, r = pc >> 3, q = pc & 7;
        const u32x4_t kw = *(const u32x4_t*)(Z + (m0 + r) * ZW + C_RK + 64 * h + q * 8), vw = *(const u32x4_t*)(Z + (m0 + r) * ZW + C_RV + 64 * h + q * 8);
        const float dk = exp2f((float)(127 - r) * lg2); u32x4_t ko;
#pragma unroll
        for (int j = 0; j < 4; ++j) ko[j] = pk_bf16(bflo(kw[j]) * dk, bfhi(kw[j]) * dk);
        *(LAS u32x4_t*)(KL + r * LP + q * 16) = ko; *(LAS u32x4_t*)(VL + r * LP + q * 16) = vw; }
    __syncthreads();
    const int et = w >> 1, d0 = 2 * (w & 1);
    f32x4m a0 = {0.f, 0.f, 0.f, 0.f}, a1 = {0.f, 0.f, 0.f, 0.f};
#pragma unroll
    for (int ks = 0; ks < 4; ++ks) { const s16x8_t va = tr_frag(VL, LP, 32 * ks, 16 * et, lane);
        a0 = MFMA16(va, tr_frag(KL, LP, 32 * ks, 16 * d0, lane), a0); a1 = MFMA16(va, tr_frag(KL, LP, 32 * ks, 16 * (d0 + 1), lane), a1); }
    float* KV = WSP(float, WS_KVS) + (size_t)unit * 4096;
#pragma unroll
    for (int reg = 0; reg < 4; ++reg) { const int e = 16 * et + 4 * fq + reg; KV[e * 64 + 16 * d0 + fr] = a0[reg]; KV[e * 64 + 16 * (d0 + 1) + fr] = a1[reg]; }
    __syncthreads();
}

__device__ __forceinline__ void ret_out_unit(const P& p, LAS unsigned char* lds, int l, int unit) {
    const int tid = tid_fresh(), lane = tid & 63, w = tid >> 6, fr = lane & 15, fq = lane >> 4;
    const int c = unit % NCH, h = (unit / NCH) % 4, b = unit / (NCH * 4);
    const bf16* Z = WSP(bf16, WS_Z); bf16* MIX = WSP(bf16, WS_MIX); const size_t m0 = (size_t)b * NS + (size_t)c * 128;
    const float lg2 = log2f(1.f - exp2f(-5.f - (float)h));
    LAS unsigned char* KL = lds; LAS unsigned char* VL = lds + 128 * LP; LAS unsigned char* ST = lds + 256 * LP;
#pragma unroll
    for (int i = 0; i < 2; ++i) { const int pc = tid + i * NTH, r = pc >> 3, q = pc & 7;
        *(LAS u32x4_t*)(KL + r * LP + q * 16) = *(const u32x4_t*)(Z + (m0 + r) * ZW + C_RK + 64 * h + q * 8);
        *(LAS u32x4_t*)(VL + r * LP + q * 16) = *(const u32x4_t*)(Z + (m0 + r) * ZW + C_RV + 64 * h + q * 8); }
    {
        const float lgc = 128.f * lg2; const float* KV = WSP(float, WS_KVS) + (size_t)(unit - c) * 4096 + tid * 8;
        f32x4m s0 = {0.f, 0.f, 0.f, 0.f}, s1 = {0.f, 0.f, 0.f, 0.f};
        f32x4m ld0[NCH - 1], ld1[NCH - 1];
#pragma unroll
        for (int cc = 0; cc < NCH - 1; ++cc) { ld0[cc] = *(const f32x4m*)(KV + (size_t)cc * 4096); ld1[cc] = *(const f32x4m*)(KV + (size_t)cc * 4096 + 4); }
#pragma unroll
        for (int cc = 0; cc < NCH - 1; ++cc) { const float wgt = cc < c ? __builtin_amdgcn_exp2f((float)(c - 1 - cc) * lgc) : 0.f; s0 += ld0[cc] * wgt; s1 += ld1[cc] * wgt; }
        const int e = tid >> 3, d = (tid & 7) * 8; u32x4_t o; o.x = pk_bf16(s0[0], s0[1]); o.y = pk_bf16(s0[2], s0[3]); o.z = pk_bf16(s1[0], s1[1]); o.w = pk_bf16(s1[2], s1[3]);
        *(LAS u32x4_t*)(ST + e * LP + d * 2) = o; }
    __syncthreads();
    const size_t mq = m0 + 16 * w + fr; const int nq = 16 * w + fr;
    s16x8_t qf[2];
#pragma unroll
    for (int s = 0; s < 2; ++s) qf[s] = *(const s16x8_t*)(Z + mq * ZW + C_RQ + 64 * h + 32 * s + 8 * fq);
    f32x4m O[4];
#pragma unroll
    for (int dt = 0; dt < 4; ++dt) O[dt] = (f32x4m){0.f, 0.f, 0.f, 0.f};
    for (int ks = 0; ks <= (w >> 1); ++ks) {
        f32x4m S2[2];
#pragma unroll
        for (int t = 0; t < 2; ++t) { const int kt = 2 * ks + t; f32x4m sacc = {0.f, 0.f, 0.f, 0.f};
#pragma unroll
            for (int s = 0; s < 2; ++s) sacc = MFMA16(*(const LAS s16x8_t*)(KL + (16 * kt + fr) * LP + (32 * s + 8 * fq) * 2), qf[s], sacc);
#pragma unroll
            for (int reg = 0; reg < 4; ++reg) { const int kk = 16 * kt + 4 * fq + reg; sacc[reg] = kk <= nq ? sacc[reg] * __builtin_amdgcn_exp2f((float)(nq - kk) * lg2) : 0.f; }
            S2[t] = sacc; }
        const s16x8_t pf = pack8(S2[0], S2[1]);
#pragma unroll
        for (int dt = 0; dt < 4; ++dt) O[dt] = MFMA16(tr_frag_perm(VL, LP, 32 * ks, 16 * dt, lane), pf, O[dt]);
    }
    { const float dq = exp2f((float)(nq + 1) * lg2);
#pragma unroll
      for (int dt = 0; dt < 4; ++dt) { f32x4m t = {0.f, 0.f, 0.f, 0.f};
#pragma unroll
          for (int s = 0; s < 2; ++s) t = MFMA16(*(const LAS s16x8_t*)(ST + (16 * dt + fr) * LP + (32 * s + 8 * fq) * 2), qf[s], t);
          O[dt] += t * dq; } }
    float ss = 0.f;
#pragma unroll
    for (int dt = 0; dt < 4; ++dt) ss += O[dt][0] * O[dt][0] + O[dt][1] * O[dt][1] + O[dt][2] * O[dt][2] + O[dt][3] * O[dt][3];
    ss += __shfl_xor(ss, 16); ss += __shfl_xor(ss, 32);
    const float r = 1.0f / sqrtf(ss * (1.f / 64.f) + EPS);
    f32x4m gnv[4]; u32x2_t rgv[4];
#pragma unroll
    for (int dt = 0; dt < 4; ++dt) { const int e = 16 * dt + 4 * fq; gnv[dt] = *(const f32x4m*)(p.ret_norm_g + (l * 4 + h) * 64 + e); rgv[dt] = *(const u32x2_t*)(Z + mq * ZW + C_RG + 64 * h + e); }
#pragma unroll
    for (int dt = 0; dt < 4; ++dt) { const int e = 16 * dt + 4 * fq; const f32x4m gn = gnv[dt];
        const u32x2_t rg = rgv[dt];
        u32x2_t o; o.x = pk_bf16(O[dt][0] * r * gn[0] * bflo(rg.x), O[dt][1] * r * gn[1] * bfhi(rg.x)); o.y = pk_bf16(O[dt][2] * r * gn[2] * bflo(rg.y), O[dt][3] * r * gn[3] * bfhi(rg.y));
        *(u32x2_t*)(MIX + mq * D + 64 * h + e) = o; }
    __syncthreads();
}
__device__ __forceinline__ void gmlp_unit(const P& p, LAS unsigned char* lds, int l, int unit) {
    const int tid = tid_fresh(), lane = tid & 63, w = tid >> 6, fr = lane & 15, fq = lane >> 4;
    const bf16* Z = WSP(bf16, WS_Z); bf16* MIX = WSP(bf16, WS_MIX); const size_t m0 = (size_t)unit * 128;
    constexpr int VP = 528;
    { const int r = tid >> 2, q = tid & 3; const bf16* src = Z + (m0 + r) * ZW + C_GV + q * 64;
      u32x4_t v[8]; float s = 0.f;
#pragma unroll
      for (int i = 0; i < 8; ++i) { v[i] = *(const u32x4_t*)(src + i * 8);
#pragma unroll
          for (int j = 0; j < 4; ++j) s += bflo(v[i][j]) + bfhi(v[i][j]); }
      s += __shfl_xor(s, 1); s += __shfl_xor(s, 2); const float mu = s * (1.f / 256.f); float s2 = 0.f;
#pragma unroll
      for (int i = 0; i < 8; ++i)
#pragma unroll
          for (int j = 0; j < 4; ++j) { const float a = bflo(v[i][j]) - mu, b2 = bfhi(v[i][j]) - mu; s2 += a * a + b2 * b2; }
      s2 += __shfl_xor(s2, 1); s2 += __shfl_xor(s2, 2); const float rstd = 1.0f / sqrtf(s2 * (1.f / 256.f) + EPS);
      const float* gl = p.gmlp_ln_g + l * 256 + q * 64;
#pragma unroll
      for (int i = 0; i < 8; ++i) { u32x4_t o;
#pragma unroll
          for (int j = 0; j < 4; ++j) o[j] = pk_bf16((bflo(v[i][j]) - mu) * rstd * gl[i * 8 + 2 * j], (bfhi(v[i][j]) - mu) * rstd * gl[i * 8 + 2 * j + 1]);
          *(LAS u32x4_t*)(lds + r * VP + (q * 64 + i * 8) * 2) = o; } }
    __syncthreads();
    const int t0 = 16 * w, nks = (w >> 1) + 1;
    constexpr int SOFF = 128 * VP;
    LAS unsigned char* ST = lds + SOFF + w * 16 * VP;
    s16x8_t wf[4][4];
#pragma unroll
    for (int g = 0; g < 4; ++g)
#pragma unroll
        for (int ks = 0; ks < 4; ++ks) wf[g][ks] = ks < nks ? *(const s16x8_t*)(WSP(bf16, WS_GWS) + (size_t)(l * 4 + g) * 128 * 128 + (t0 + fr) * 128 + 32 * ks + 8 * fq) : (s16x8_t){0, 0, 0, 0, 0, 0, 0, 0};
    float bsv[4][4];
#pragma unroll
    for (int g = 0; g < 4; ++g)
#pragma unroll
        for (int reg = 0; reg < 4; ++reg) bsv[g][reg] = p.gmlp_b[(l * 4 + g) * 128 + t0 + 4 * fq + reg];
    const int orow = lane >> 2, oseg = lane & 3; u32x4_t uv[8];
#pragma unroll
    for (int k = 0; k < 8; ++k) uv[k] = *(const u32x4_t*)(Z + (m0 + t0 + orow) * ZW + C_GU + 64 * oseg + 8 * k);
#pragma unroll
    for (int g = 0; g < 4; ++g) {
        f32x4m acc[4];
#pragma unroll
        for (int ct = 0; ct < 4; ++ct) acc[ct] = (f32x4m){0.f, 0.f, 0.f, 0.f};
#pragma unroll
        for (int ks = 0; ks < 4; ++ks) { if (ks < nks) {
#pragma unroll
            for (int ct = 0; ct < 4; ++ct) acc[ct] = MFMA16(wf[g][ks], tr_frag(lds, VP, 32 * ks, 64 * g + 16 * ct, lane), acc[ct]); } }
#pragma unroll
        for (int reg = 0; reg < 4; ++reg)
#pragma unroll
            for (int ct = 0; ct < 4; ++ct) *(LAS bf16*)(ST + (4 * fq + reg) * VP + (64 * g + 16 * ct + fr) * 2) = f2bf(acc[ct][reg] + bsv[g][reg]);
    }
#pragma unroll
    for (int k = 0; k < 8; ++k) { const u32x4_t sv = *(const LAS u32x4_t*)(ST + orow * VP + (64 * oseg + 8 * k) * 2); u32x4_t o;
#pragma unroll
        for (int q = 0; q < 4; ++q) o[q] = pk_bf16(bflo(uv[k][q]) * bflo(sv[q]), bfhi(uv[k][q]) * bfhi(sv[q]));
        *(u32x4_t*)(MIX + (m0 + t0 + orow) * D + 256 + 64 * oseg + 8 * k) = o; }
    __syncthreads();
}
__device__ __forceinline__ void premix_phase(const P& p, LAS unsigned char* lds, int l, int PM_ONLY = 0) {
    if (PM_ONLY != 2) { CmpSched S; S.pp = &p; S.l = l; S.c = bid_fresh(); EpiCmp E{&p, l}; pg8::gemm_phase(lds, S, E); }
    const int G = grid_fresh(), bx = bid_fresh();
    if (PM_ONLY == 1) return;
    if (G > 64) { if (bx >= 32) { for (int u = bx - 32; u < NB * 4 * NCH; u += G - 32) ret_kv_unit(p, lds, l, u); for (int u = bx - 32; u < NB * NCH; u += G - 32) gmlp_unit(p, lds, l, u); } }
    else { for (int u = bx; u < NB * 4 * NCH; u += G) ret_kv_unit(p, lds, l, u); for (int u = bx; u < NB * NCH; u += G) gmlp_unit(p, lds, l, u); }
}

__device__ __forceinline__ s16x8_t tr_frag_perm_swz(LAS const unsigned char* X, int k0, int c0, int lane) {
    const int fq = lane >> 4, q = (lane & 15) >> 2, pp = lane & 3, row = k0 + 4 * fq + q, col = c0 + 4 * pp;
    LAS const unsigned char* a = X + row * 128 + ((((col >> 3) ^ (row & 7))) << 4) + (col & 7) * 2;
    const s16x4_t lo = lds_tr4(a), hi = lds_tr4(a + 16 * 128);
    return (s16x8_t){lo[0], lo[1], lo[2], lo[3], hi[0], hi[1], hi[2], hi[3]};
}
constexpr int NSA_KV = 2 * 64 * 128;
constexpr int NSA_IMP = 4 * NSA_KV, NSA_INVL = NSA_IMP + 8 * 8192, NSA_SELM = NSA_INVL + 64 * 4 * 4;
static_assert(NSA_SELM + 256 <= 147456 - 64, "NSA LDS map");
template <int VAR = 0>
__device__ __forceinline__ void nsa_unit(const P& p, LAS unsigned char* lds, int l, int b, int g, int i) {
    const int tid = tid_fresh(), lane = tid & 63, w = tid >> 6, fr = lane & 15, fq = lane >> 4;
    const bf16* Z = WSP(bf16, WS_Z); bf16* MIX = VAR ? WSP(bf16, WS_H) : WSP(bf16, WS_MIX); const float* GL = WSP(float, WS_GL);
    const size_t mb = (size_t)b * NS;
    const int nc = (i >= 16) ? 2 : 1, wlo = i > 8 ? i - 8 : 0, nblk = nc + (i + 1) + (i - wlo + 1);
    LAS float* IMPH = (LAS float*)(lds + NSA_IMP + w * 8192); LAS float* INVL = (LAS float*)(lds + NSA_INVL); LAS unsigned* SELM = (LAS unsigned*)(lds + NSA_SELM);
    LAS f32x4m* OFL = (LAS f32x4m*)(lds + NSA_IMP + w * 8192 + lane * 16);
    int tok[2]; s16x8_t qf[2][2];
#pragma unroll
    for (int qt = 0; qt < 2; ++qt) { tok[qt] = 8 * w + 4 * qt + (fr >> 2);
#pragma unroll
        for (int s = 0; s < 2; ++s) qf[qt][s] = *(const s16x8_t*)(Z + (mb + 64 * i + tok[qt]) * ZW + C_NQ + 64 * (4 * g + (fr & 3)) + 32 * s + 8 * fq); }
    f32x4m O[2][4]; float lsum[2] = {0.f, 0.f}; float carry[2] = {0.f, 0.f}; unsigned selm[2] = {0u, 0u};
#pragma unroll
    for (int qt = 0; qt < 2; ++qt)
#pragma unroll
        for (int dt = 0; dt < 4; ++dt) O[qt][dt] = (f32x4m){0.f, 0.f, 0.f, 0.f};
    const int skey = tid >> 3, spx = (tid & 7) ^ (skey & 7);
    auto kv_ptrs = [&](int it, const bf16*& kp, const bf16*& vp) {
        if (it < nc) { const size_t o = ((size_t)(b * 2 + g) * (NCMP + 1) + 64 * it + skey) * 64 + spx * 8; kp = WSP(bf16, WS_KC) + o; vp = WSP(bf16, WS_VC) + o; }
        else if (it < nc + i + 1) { const size_t o = (mb + 64 * (it - nc) + skey) * ZW + 64 * g + spx * 8; kp = Z + o + C_KS; vp = Z + o + C_VS; }
        else { const size_t o = (mb + 64 * (wlo + it - nc - i - 1) + skey) * ZW + 64 * g + spx * 8; kp = Z + o + C_KW; vp = Z + o + C_VW; } };
    asm volatile("" : "+v"(qf[0][0]), "+v"(qf[0][1]), "+v"(qf[1][0]), "+v"(qf[1][1]));
    float bnd_c = WSP(float, WS_BND)[l * 3 + 0], bnd_s = WSP(float, WS_BND)[l * 3 + 1], bnd_w = WSP(float, WS_BND)[l * 3 + 2];
    asm volatile("" : "+v"(bnd_c), "+v"(bnd_s), "+v"(bnd_w));
#define NSA_DMA(IT, BUF) do { const bf16 *kp_, *vp_; kv_ptrs((IT), kp_, vp_); \
        const unsigned lb_ = (unsigned)__builtin_amdgcn_readfirstlane((int)((unsigned)(size_t)lds + (unsigned)((BUF) * NSA_KV) + (unsigned)w * 1024u)); unsigned sv_; \
        asm volatile("s_mov_b32 %0, m0\n\ts_mov_b32 m0, %3\n\ts_nop 0\n\tglobal_load_lds_dwordx4 %1, off\n\ts_add_u32 m0, m0, 0x2000\n\ts_nop 0\n\tglobal_load_lds_dwordx4 %2, off\n\ts_mov_b32 m0, %0" \
                     : "=&s"(sv_) : "v"(kp_), "v"(vp_), "s"(lb_) : "memory"); } while (0)
    __syncthreads();
    NSA_DMA(0, 0);
    if (nblk > 1) NSA_DMA(1, 1);
    asm volatile("s_waitcnt vmcnt(0)" ::: "memory");
    __builtin_amdgcn_s_barrier(); asm volatile("" ::: "memory");
#pragma unroll 1
    for (int it = 0; it < nblk; ++it) {
        const int bufc = it & 3;
        if ((it & 1) == 0) { if (it + 2 < nblk) NSA_DMA(it + 2, (it + 2) & 3); if (it + 3 < nblk) NSA_DMA(it + 3, (it + 3) & 3); }
        LAS const unsigned char* Kb = lds + bufc * NSA_KV; LAS const unsigned char* Vb = Kb + 8192;
        const int br = it < nc ? 0 : (it < nc + i + 1 ? 1 : 2);
        const int j = br == 0 ? it : (br == 1 ? it - nc : wlo + it - nc - i - 1);
        const float bnd = br == 0 ? bnd_c : (br == 1 ? bnd_s : bnd_w);
        const bool needmask = (br == 0) || (j == i) || (br == 2 && j == i - 8);
        const bool lower = (br == 2 && j == i - 8);
        bool rowok[2]; int thr[2]; float oa[2], ob[2];
#pragma unroll
        for (int qt = 0; qt < 2; ++qt) {
            rowok[qt] = (br == 1) ? (((selm[qt] >> j) & 1u) != 0u) : true;
            thr[qt] = (br == 0) ? ((64 * i + tok[qt] - 31) >> 4) - 64 * j : tok[qt];
            const float on = rowok[qt] ? bnd : 1e30f;
            oa[qt] = lower ? 1e30f : on; ob[qt] = lower ? on : 1e30f; }
        const bool act0 = __ballot(rowok[0]) != 0ull, act1 = __ballot(rowok[1]) != 0ull;
        if ((act0 || act1) && VAR != 3) {
            f32x4m pv[2][4];
#pragma unroll
            for (int qt = 0; qt < 2; ++qt)
#pragma unroll
                for (int kt = 0; kt < 4; ++kt) pv[qt][kt] = (f32x4m){0.f, 0.f, 0.f, 0.f};
#pragma unroll
            for (int sI = 0; sI < 2; ++sI) { s16x8_t kf[4];
#pragma unroll
                for (int kt = 0; kt < 4; ++kt) kf[kt] = *(const LAS s16x8_t*)(Kb + (16 * kt + fr) * 128 + (((4 * sI + fq) ^ (fr & 7)) << 4));
#pragma unroll
                for (int kt = 0; kt < 4; ++kt)
#pragma unroll
                    for (int qt = 0; qt < 2; ++qt) { if (VAR != 4) pv[qt][kt] = MFMA16(kf[kt], qf[qt][sI], pv[qt][kt]); else pv[qt][kt][0] += __builtin_bit_cast(float, (int)kf[kt][0]); } }
            s16x8_t vf[2][4];
#pragma unroll
            for (int ks = 0; ks < 2; ++ks)
#pragma unroll
                for (int dt = 0; dt < 4; ++dt) vf[ks][dt] = tr_frag_perm_swz(Vb, 32 * ks, 16 * dt, lane);
#pragma unroll
            for (int qt = 0; qt < 2; ++qt) {
                if (needmask) {
#pragma unroll
                    for (int kt = 0; kt < 4; ++kt)
#pragma unroll
                        for (int reg = 0; reg < 4; ++reg) { const int kk = 16 * kt + 4 * fq + reg; const float off = kk <= thr[qt] ? oa[qt] : ob[qt];
                            pv[qt][kt][reg] = __builtin_amdgcn_exp2f(pv[qt][kt][reg] * 1.4426950408889634f - off); lsum[qt] += pv[qt][kt][reg]; } }
                else {
#pragma unroll
                    for (int kt = 0; kt < 4; ++kt)
#pragma unroll
                        for (int reg = 0; reg < 4; ++reg) { pv[qt][kt][reg] = __builtin_amdgcn_exp2f(pv[qt][kt][reg] * 1.4426950408889634f - oa[qt]); lsum[qt] += pv[qt][kt][reg]; } }
                if (br == 0) {
                    const int src = (lane + 48) & 63;
#pragma unroll
                    for (int kt = 0; kt < 4; ++kt) { const float a4 = pv[qt][kt][0] + pv[qt][kt][1] + pv[qt][kt][2] + pv[qt][kt][3];
                        const float xs = __shfl(pv[qt][kt][3], src), xp = __shfl(kt == 0 ? carry[qt] : pv[qt][kt > 0 ? kt - 1 : 0][3], src);
                        IMPH[((4 * qt + (fr >> 2)) * 4 + (fr & 3)) * 32 + 16 * j + 4 * kt + fq] = a4 + (fq == 0 ? xp : xs); }
                    carry[qt] = pv[qt][3][3]; }
                const s16x8_t pfa = pack8(pv[qt][0], pv[qt][1]), pfb = pack8(pv[qt][2], pv[qt][3]);
#pragma unroll
                for (int dt = 0; dt < 4; ++dt) O[qt][dt] = MFMA16(vf[0][dt], pfa, O[qt][dt]);
#pragma unroll
                for (int dt = 0; dt < 4; ++dt) O[qt][dt] = MFMA16(vf[1][dt], pfb, O[qt][dt]);
                __builtin_amdgcn_sched_barrier(0);
            }
        }
        const bool bend = (it == nc - 1) || (it == nc + i) || (it == nblk - 1);
        if (bend) {
            float scl[2];
#pragma unroll
            for (int qt = 0; qt < 2; ++qt) { float ls = lsum[qt]; ls += __shfl_xor(ls, 16); ls += __shfl_xor(ls, 32);
                const float inv = ls > 0.f ? 1.0f / ls : 0.f;
                const float gate = 1.0f / (1.0f + __expf(-GL[(mb + 64 * i + tok[qt]) * 24 + (4 * g + (fr & 3)) * 3 + br]));
                scl[qt] = gate * inv; lsum[qt] = 0.f;
                if (br == 0 && fq == 0) INVL[tok[qt] * 4 + (fr & 3)] = inv; }
            if (br == 0) {
#pragma unroll 1
                for (int rnd = 0; rnd < 4; ++rnd) { const int tk = 8 * w + 2 * rnd + (lane >> 5), jj = lane & 31;
                    const bool forced = (jj == 0) || (jj == i) || (jj == i - 1);
                    float sc = -1.f;
                    if (jj <= i) { sc = 0.f;
#pragma unroll
                        for (int r = 0; r < 4; ++r) sc += IMPH[((2 * rnd + (lane >> 5)) * 4 + r) * 32 + jj] * INVL[tk * 4 + r]; }
                    if (forced) sc = 1e4f;
                    int rank = 0;
#pragma unroll
                    for (int d = 1; d < 32; ++d) { const int oj = (jj + d) & 31; const float o = __shfl(sc, (lane & 32) | oj); rank += (o > sc || (o == sc && oj < jj)) ? 1 : 0; }
                    const unsigned long long bal = __ballot(rank < 8);
                    if (lane == 0) { SELM[8 * w + 2 * rnd] = (unsigned)bal; SELM[8 * w + 2 * rnd + 1] = (unsigned)(bal >> 32); } }
                selm[0] = SELM[tok[0]]; selm[1] = SELM[tok[1]];
            }
#pragma unroll
            for (int qt = 0; qt < 2; ++qt)
#pragma unroll
                for (int dt = 0; dt < 4; ++dt) { const f32x4m prev = br == 0 ? (f32x4m){0.f, 0.f, 0.f, 0.f} : OFL[(qt * 4 + dt) * 64]; OFL[(qt * 4 + dt) * 64] = prev + O[qt][dt] * scl[qt]; O[qt][dt] = (f32x4m){0.f, 0.f, 0.f, 0.f}; }
        }
        if ((it & 1) || it + 1 == nblk) {
            asm volatile("s_waitcnt vmcnt(0) ; NSA_LOOP_WAIT" ::: "memory");
            asm volatile("s_waitcnt lgkmcnt(0)" ::: "memory");
            __builtin_amdgcn_s_barrier(); asm volatile("" ::: "memory"); }
    }
#undef NSA_DMA
#pragma unroll
    for (int qt = 0; qt < 2; ++qt)
#pragma unroll
        for (int dt = 0; dt < 4; ++dt) { const f32x4m of = OFL[(qt * 4 + dt) * 64]; u32x2_t o; o.x = pk_bf16(of[0], of[1]); o.y = pk_bf16(of[2], of[3]);
            *(u32x2_t*)(MIX + (mb + 64 * i + tok[qt]) * D + 512 + 64 * (4 * g + (fr & 3)) + 16 * dt + 4 * fq) = o; }
}
template <int VAR = 0>
__device__ __forceinline__ void nsa_units(const P& p, LAS unsigned char* lds, int l, int vcu, int G) {
    for (int u = vcu; u < NB * 2 * NSEL; u += G) { const int k = u >> 8, v = u & 255, bg = v >> 3, r8 = v & 7;
        const int i = k == 0 ? 31 - r8 : (k == 1 ? 16 + r8 : (k == 2 ? 15 - r8 : r8));
        nsa_unit<VAR>(p, lds, l, bg >> 1, bg & 1, i); }
}
constexpr int MOE_TAB = 131072;
constexpr size_t WS_ACT = WS_Z;
static_assert((size_t)(M + 24 * 256) * 1024 * 2 <= (size_t)M * ZW * 2, "ACT must fit inside Z");
__device__ __forceinline__ void moe_table(const P& p, LAS unsigned char* lds, int l) {
    LAS int* tab = LDSP(int, MOE_TAB);
    if (tid_fresh() == 0) { int acc = 0; for (int c = 0; c < 24; ++c) { const int n = WSP(int, WS_CTL)[CW_CNT + l * 64 + c]; tab[c] = acc; tab[25 + c] = n; acc += (n + 255) >> 8; } tab[24] = acc; }
    __syncthreads();
}
__device__ __forceinline__ void pair_experts(int cls, int& ea, int& eb) { const int g = cls / 6, pr = cls % 6; const int lo = pr < 3 ? 0 : (pr < 5 ? 1 : 2), hi = pr < 3 ? pr + 1 : (pr < 5 ? pr - 1 : 3); ea = g * 4 + lo; eb = g * 4 + hi; }
template <int NPN> struct MoeSchedBase {
    const P* pp; LAS int* tab; int l, G, c;
    __device__ __forceinline__ bool next(int i, pg8::Unit& u) const {
        int L, hf; if (!pg8::deal_unit(i, G, c, tab[24] * NPN, L, hf)) return false; u.half = hf;
        const int rt = L / NPN; int cls = 0;
        for (int k = 1; k < 24; ++k) cls = (tab[k] <= rt) ? k : cls;
        while (tab[25 + cls] == 0 && cls > 0) --cls;
        u.pm = rt; u.pn = L % NPN; u.aux = cls | ((rt - tab[cls]) << 8); return true;
    }
};
struct MoeSchedA : MoeSchedBase<8> {
    static constexpr bool GATHER = true; static constexpr int GOFF_LDS = MOE_TAB + 1024;
    __device__ __forceinline__ int ktiles() const { return D / 64; }
    __device__ __forceinline__ size_t a_kstep() const { return 128; }
    __device__ __forceinline__ const char* a_base() const { return (const char*)(pp->ws + WS_H); }
    __device__ __forceinline__ unsigned a_off(const pg8::Unit& u, int row, int C) const {
        const P& p = *pp; const int cls = u.aux & 255, slot = (u.aux >> 8) * 256 + row, n = tab[25 + cls];
        const int tok = WSP(int, WS_CTOK)[(size_t)cls * M + (slot < n ? slot : 0)];
        return (unsigned)(tok * D + C) * 2u; }
    __device__ __forceinline__ unsigned b_ld() const { return D * 2u; }
    __device__ __forceinline__ const char* b_tile(const pg8::Unit& u, int t) const {
        int ea, eb; pair_experts(u.aux & 255, ea, eb); const int e = u.pn < 4 ? ea : eb;
        return (const char*)(pp->ws + WS_WGU_T) + ((size_t)(l * 16 + e) * 1024 + (size_t)(u.pn & 3) * 256) * D * 2 + (size_t)t * 128; }
};
struct MoeSchedB : MoeSchedBase<4> {
    static constexpr bool GATHER = false; static constexpr int GOFF_LDS = 0;
    __device__ __forceinline__ int ktiles() const { return 16; }
    __device__ __forceinline__ size_t a_kstep() const { return 128; }
    __device__ __forceinline__ const char* a_base() const { return (const char*)(pp->ws + WS_ACT); }
    __device__ __forceinline__ unsigned a_off(const pg8::Unit& u, int row, int C) const { return (unsigned)((u.pm * 256 + row) * 1024 + C) * 2u; }
    __device__ __forceinline__ unsigned b_ld() const { return 512 * 2u; }
    __device__ __forceinline__ const char* b_tile(const pg8::Unit& u, int t) const {
        int ea, eb; pair_experts(u.aux & 255, ea, eb); const int e = t < 8 ? ea : eb;
        return (const char*)(pp->ws + WS_WD_T) + ((size_t)(l * 16 + e) * D + (size_t)u.pn * 256) * 512 * 2 + (size_t)(t & 7) * 128; }
};
struct EpiMoeA {
    static constexpr bool PERM = true, AFTER_DRAIN = false;
    const P* pp; LAS int* tab;
    __device__ __forceinline__ void operator()(const pg8::f32x4 (&acc)[2][2][4][2], const pg8::Unit& u, int wr, int wc, int fr, int fq) const {
        const P& p = *pp; const int cls = u.aux & 255, s0 = (u.aux >> 8) * 256, n = tab[25 + cls], which = u.pn >> 2;
        bf16* O = WSP(bf16, WS_ACT);
        float wts[2][4];
#pragma unroll
        for (int ai = 0; ai < 2; ++ai)
#pragma unroll
            for (int m = 0; m < 4; ++m) { const int slot = s0 + (u.half ? 0 : ai * 128) + wr * 64 + m * 16 + fr + (u.half == 2 ? 128 : 0); wts[ai][m] = slot < n ? WSP(float, WS_CWT)[((size_t)cls * M + slot) * 2 + which] : 0.f; }
#pragma unroll
        for (int ai = 0; ai < 2; ++ai)
#pragma unroll
            for (int m = 0; m < 4; ++m) { if (ai == 1 && u.half) continue; const int r = ai * 128 + wr * 64 + m * 16 + fr + (u.half == 2 ? 128 : 0);
                const float w = wts[ai][m];
                const pg8::f32x4 g0 = acc[ai][0][m][0], g1 = acc[ai][0][m][1], u0 = acc[ai][1][m][0], u1 = acc[ai][1][m][1];
                float v[8];
#pragma unroll
                for (int j = 0; j < 4; ++j) { v[j] = w * silu_fast(g0[j]) * u0[j]; v[4 + j] = w * silu_fast(g1[j]) * u1[j]; }
                pg8::u32x4 o; o.x = pk_bf16(v[0], v[1]); o.y = pk_bf16(v[2], v[3]); o.z = pk_bf16(v[4], v[5]); o.w = pk_bf16(v[6], v[7]);
                *(pg8::u32x4*)(O + (size_t)(u.pm * 256 + r) * 1024 + u.pn * 128 + wc * 32 + 8 * fq) = o; }
    }
};
struct EpiMoeB {
    static constexpr bool PERM = true, AFTER_DRAIN = false;
    const P* pp; LAS int* tab; int l; bool dry; const bf16* xin; void* xout; bool obf;
    __device__ __forceinline__ void operator()(const pg8::f32x4 (&acc)[2][2][4][2], const pg8::Unit& u, int wr, int wc, int fr, int fq) const {
        const P& p = *pp; const int cls = u.aux & 255, s0 = (u.aux >> 8) * 256, n = dry ? 0 : tab[25 + cls], col0 = u.pn * 256 + wc * 32 + 8 * fq;
        int toks[2][4];
#pragma unroll
        for (int ai = 0; ai < 2; ++ai)
#pragma unroll
            for (int m = 0; m < 4; ++m) { const int slot = s0 + (u.half ? 0 : ai * 128) + wr * 64 + m * 16 + fr + (u.half == 2 ? 128 : 0); toks[ai][m] = slot < n ? WSP(int, WS_CTOK)[(size_t)cls * M + slot] : -1; }
#pragma unroll
        for (int ai = 0; ai < 2; ++ai) { if (ai == 1 && u.half) continue;
#pragma unroll
            for (int mp = 0; mp < 2; ++mp) {
                pg8::u32x4 xw[2][2]; pg8::f32x4 ga[2][2], gb[2][2];
#pragma unroll
                for (int mm = 0; mm < 2; ++mm) { const int tok = toks[ai][2 * mp + mm], tk = tok < 0 ? 0 : tok;
                    const float* gp = WSP(float, WS_MOD) + ((size_t)l * NB + tk / NS) * 6144 + 5120 + col0; const size_t ro = (size_t)tk * D + col0;
#pragma unroll
                    for (int bj = 0; bj < 2; ++bj) { xw[mm][bj] = *(const pg8::u32x4*)(xin + ro + bj * 128); ga[mm][bj] = *(const pg8::f32x4*)(gp + bj * 128); gb[mm][bj] = *(const pg8::f32x4*)(gp + bj * 128 + 4); } }
#pragma unroll
                for (int mm = 0; mm < 2; ++mm) { const int m = 2 * mp + mm, tok = toks[ai][m]; if (tok < 0) continue; const size_t ro = (size_t)tok * D + col0;
#pragma unroll
                    for (int bj = 0; bj < 2; ++bj) { const pg8::u32x4 w = xw[mm][bj];
                        pg8::f32x4 x0 = {__builtin_bit_cast(float, w.x << 16), __builtin_bit_cast(float, w.x & 0xffff0000u), __builtin_bit_cast(float, w.y << 16), __builtin_bit_cast(float, w.y & 0xffff0000u)};
                        pg8::f32x4 x1 = {__builtin_bit_cast(float, w.z << 16), __builtin_bit_cast(float, w.z & 0xffff0000u), __builtin_bit_cast(float, w.w << 16), __builtin_bit_cast(float, w.w & 0xffff0000u)};
                        x0 += ga[mm][bj] * acc[ai][bj][m][0]; x1 += gb[mm][bj] * acc[ai][bj][m][1];
                        if (obf) { pg8::u32x4 o; o.x = pk_bf16(x0[0], x0[1]); o.y = pk_bf16(x0[2], x0[3]); o.z = pk_bf16(x1[0], x1[1]); o.w = pk_bf16(x1[2], x1[3]); *(pg8::u32x4*)((bf16*)xout + ro + bj * 128) = o; }
                        else { *(pg8::f32x4*)((float*)xout + ro + bj * 128) = x0; *(pg8::f32x4*)((float*)xout + ro + bj * 128 + 4) = x1; } } } } }
    }
};
__device__ __forceinline__ void moe_a_phase(const P& p, LAS unsigned char* lds, int l) {
    moe_table(p, lds, l);
    MoeSchedA S; S.pp = &p; S.tab = LDSP(int, MOE_TAB); S.l = l; S.G = grid_fresh(); S.c = bid_fresh();
    EpiMoeA E{&p, LDSP(int, MOE_TAB)}; pg8::gemm_phase(lds, S, E);
}
__device__ __forceinline__ void moe_b_phase(const P& p, LAS unsigned char* lds, int l, bool dry = false, void* xout = nullptr, int obf = -1) {
    if (!xout) xout = p.out;
    if (obf < 0) obf = (l + 1 < NL);
    moe_table(p, lds, l);
    MoeSchedB S; S.pp = &p; S.tab = LDSP(int, MOE_TAB); S.l = l; S.G = grid_fresh(); S.c = bid_fresh();
    EpiMoeB E{&p, LDSP(int, MOE_TAB), l, dry, WSP(bf16, WS_XB), xout, obf != 0}; pg8::gemm_phase(lds, S, E);
}
constexpr int LDS_BYTES = 147456;
struct Args { P p; };
typedef const __attribute__((address_space(4))) P* KargP;
__device__ __forceinline__ KargP p_fresh() { KargP k = (KargP)__builtin_amdgcn_kernarg_segment_ptr(); asm volatile("" : "+s"(k)); return k; }
__device__ __forceinline__ P load_p() { KargP k = p_fresh(); P q; const void* const __attribute__((address_space(4)))* src = (const void* const __attribute__((address_space(4)))*)k; const void** dst = (const void**)&q;
#pragma unroll
    for (int i = 0; i < (int)(sizeof(P) / sizeof(void*)); ++i) dst[i] = src[i];
    return q; }
#ifndef PROBE
#define PROBE 0
#endif
#define REP(k, l) for (int rep_ = 0; rep_ < ((PROBE == (k) && (l) == 0) ? 2 : 1); ++rep_)
#define LAYER_BODY(l) do { \
        REP(2, l) { const P p = load_p(); norm_phase(p, lds, l ? (const void*)p.out : (const void*)p.x, l != 0, l, 0); } \
        GRID_BAR(); \
        if (PROBE == 44 && (l) == 0) { const P p = load_p(); pg8::StaticSched S; S.init(WSP(bf16, WS_H), WSP(bf16, WS_WIN_T) + (size_t)l * ZW * D, M, ZW, D, grid_fresh(), bid_fresh()); pg8::EpiBf16Store E{WSP(bf16, WS_Z), ZW}; pg8::gemm_phase(lds, S, E); } \
        REP(3, l) { const P p = load_p(); pg8::StaticSched S; S.init(WSP(bf16, WS_H), WSP(bf16, WS_WIN_T) + (size_t)l * ZW * D, M, ZW, D, grid_fresh(), bid_fresh()); EpiZ E{&p, l}; pg8::gemm_phase(lds, S, E); gl_tail(p, l); } \
        GRID_BAR(); \
        REP(4, l) { const P p = load_p(); premix_phase(p, lds, l); } \
        if (PROBE == 45 && (l) == 0) { const P p = load_p(); premix_phase(p, lds, l, 1); } \
        if (PROBE == 46 && (l) == 0) { const P p = load_p(); premix_phase(p, lds, l, 2); } \
        GRID_BAR(); \
        REP(5, l) { const P p = load_p(); { const int G_ = grid_fresh(), bx_ = bid_fresh(); nsa_units(p, lds, l, (G_ & 7) == 0 ? (bx_ & 7) * (G_ >> 3) + (bx_ >> 3) : bx_, G_); } }        \
        if (PROBE == 30 && (l) == 0) { const P p = load_p(); nsa_units<1>(p, lds, l, bid_fresh(), grid_fresh()); } \
        if (PROBE == 31 && (l) == 0) { const P p = load_p(); nsa_units<2>(p, lds, l, bid_fresh(), grid_fresh()); } \
        if (PROBE == 33 && (l) == 0) { const P p = load_p(); nsa_units<4>(p, lds, l, bid_fresh(), grid_fresh()); } \
        if (PROBE == 34 && (l) == 0) { const P p = load_p(); nsa_units<5>(p, lds, l, bid_fresh(), grid_fresh()); } \
        if (PROBE == 32 && (l) == 0) { const P p = load_p(); nsa_units<3>(p, lds, l, bid_fresh(), grid_fresh()); } \
        REP(6, l) { const P p = load_p(); for (int u = bid_fresh(); u < NB * 4 * NCH; u += grid_fresh()) ret_out_unit(p, lds, l, u); } \
        GRID_BAR(); \
        REP(8, l) { const P p = load_p(); pg8::StaticSched S; S.init(WSP(bf16, WS_MIX), WSP(bf16, WS_WOUT_T) + (size_t)l * D * D, M, D, D, grid_fresh(), bid_fresh()); \
          pg8::EpiResidual E{l ? (const void*)p.out : (const void*)p.x, l != 0, WSP(bf16, WS_XB), WSP(float, WS_MOD) + (size_t)l * NB * 6144 + 2048}; pg8::gemm_phase(lds, S, E); } \
        GRID_BAR(); \
        REP(10, l) { const P p = load_p(); norm_phase(p, lds, WSP(bf16, WS_XB), true, l, 1, l + 2 * rep_ + cb_extra); } \
        GRID_BAR(); \
        REP(9, l) { const P p = load_p(); moe_a_phase(p, lds, l); } \
        GRID_BAR(); \
        REP(11, l) { const P p = load_p(); if (mb_dummy) moe_b_phase(p, lds, l, false, (void*)(p.ws + WS_Z + 152 * MiB), 1); else moe_b_phase(p, lds, l, rep_ != 0); } \
        if (PROBE == 12 && (l) == 0) { const P p = load_p(); moe_b_phase(p, lds, l, false, (void*)(p.ws + WS_Z + 152 * MiB), 1); } \
} while (0)
__global__ void __launch_bounds__(NTH, 2) fwd_kernel(Args a) {
    extern __shared__ __attribute__((aligned(16))) unsigned char lds_raw[];
    LAS unsigned char* lds = (LAS unsigned char*)lds_raw;
    volatile LAS unsigned* MISC = (volatile LAS unsigned*)(lds + LDS_BYTES - 64);
    if (threadIdx.x < 16) MISC[threadIdx.x] = 0u;
    __syncthreads();
    (void)xcd_barrier_post((unsigned*)(a.p.ws + WS_CTL) + CW_BAR, MISC);
#define GRID_BAR() do { XcdBarrier bar_; bar_.bar = (unsigned*)(load_p().ws + WS_CTL) + CW_BAR; bar_.x = xb_xcc_id(); bar_.st = (volatile LAS unsigned*)(lds + LDS_BYTES - 64); xcd_barrier(bar_); } while (0)
    REP(1, 0) { const P p = load_p(); p0_prologue(p, lds); }
    GRID_BAR();
    int cb_extra = 0; bool mb_dummy = false;
    if (PROBE == 40) { cb_extra = 2; LAYER_BODY(0); GRID_BAR(); cb_extra = 0; }
    LAYER_BODY(0);
    GRID_BAR();
    if (PROBE == 20) { GRID_BAR(); GRID_BAR(); GRID_BAR(); GRID_BAR(); GRID_BAR(); GRID_BAR(); GRID_BAR(); GRID_BAR(); }
    if (PROBE == 42) { cb_extra = 2; mb_dummy = true; LAYER_BODY(1); GRID_BAR(); cb_extra = 0; mb_dummy = false; }
    LAYER_BODY(1);
    if (PROBE == 41) { GRID_BAR(); const P p = load_p(); p0_prologue(p, lds); }
}
extern "C" void kernel_launch(void* const* d_in, const int* in_sizes, int n_in, void* d_out, int out_size, void* d_ws, size_t ws_size, hipStream_t stream) {
    static int grid = 0;
    if (grid == 0) {
        int dev = 0, cus = 0, per_cu = 0;
        if (n_in != 26 || out_size != M * D || ws_size < WS_END) { fprintf(stderr, "kernel_launch: unexpected shapes (n_in %d out %d ws %zu need %zu)\n", n_in, out_size, ws_size, (size_t)WS_END); grid = -1; return; }
        if (hipGetDevice(&dev) != hipSuccess || hipDeviceGetAttribute(&cus, hipDeviceAttributeMultiprocessorCount, dev) != hipSuccess) { grid = -1; return; }
        if (hipFuncSetAttribute((const void*)fwd_kernel, hipFuncAttributeMaxDynamicSharedMemorySize, LDS_BYTES) != hipSuccess) { fprintf(stderr, "kernel_launch: hipFuncSetAttribute failed\n"); grid = -1; return; }
        if (hipOccupancyMaxActiveBlocksPerMultiprocessor(&per_cu, (const void*)fwd_kernel, NTH, LDS_BYTES) != hipSuccess || per_cu < 1) { fprintf(stderr, "kernel_launch: occupancy query reports %d workgroups per CU\n", per_cu); per_cu = 1; }
        (void)hipGetLastError();
        grid = cus;
    }
    if (grid < 0) return;
    (void)hipMemsetAsync((char*)d_ws + WS_CTL, 0, 1u << 20, stream);
    Args a{};
    const void** pp = (const void**)&a.p;
    for (int i = 0; i < 26; ++i) pp[i] = d_in[i];
    a.p.out = (float*)d_out; a.p.ws = (unsigned char*)d_ws;
    hipLaunchKernelGGL(fwd_kernel, dim3(grid), dim3(NTH), LDS_BYTES, stream, a);
}
```

```cpp
#include <hip/hip_runtime.h>
#include <cstdio>
#include <cstdint>
#define HD __device__ __attribute__((always_inline))
__device__ __forceinline__ int tid_fresh() { int t = threadIdx.x; asm volatile("" : "+v"(t)); return t; }
__device__ __forceinline__ int bid_fresh() { int t = blockIdx.x; asm volatile("" : "+s"(t)); return t; }
__device__ __forceinline__ int grid_fresh() { int t = gridDim.x; asm volatile("" : "+s"(t)); return t; }
#ifndef CFG_B
#define CFG_B 16
#endif
#ifndef CFG_S
#define CFG_S 2048
#endif
constexpr int NB = CFG_B, NS = CFG_S, M = NB * NS, D = 1024, NIN = 2840, ZW = 2816, NL = 2;
constexpr int C_RQ = 0, C_RK = 256, C_RV = 512, C_RG = 768, C_GU = 1024, C_GV = 1280, C_NQ = 1536, C_KC = 2048, C_VC = 2176,
              C_KS = 2304, C_VS = 2432, C_KW = 2560, C_VW = 2688;
constexpr int NCMP = NS / 16 - 1, NSEL = NS / 64, NCH = NS / 128;
constexpr float EPS = 1e-6f;

typedef unsigned short bf16;
HD inline bf16 f2bf(float f) { unsigned u = __builtin_bit_cast(unsigned, f); u += 0x7FFFu + ((u >> 16) & 1u); return (bf16)(u >> 16); }
HD inline float bf2f(bf16 b) { return __builtin_bit_cast(float, ((unsigned)b) << 16); }
HD inline float silu_f(float x) { return x / (1.f + expf(-x)); }
HD inline float sigm_f(float x) { return 1.f / (1.f + expf(-x)); }
HD inline float gelu_f(float x) { return 0.5f * x * (1.f + tanhf(0.7978845608028654f * (x + 0.044715f * x * x * x))); }
#ifndef HOST_EMU
__device__ __forceinline__ float gelu_fast(float x) { const float u = 1.5957691216057308f * (x + 0.044715f * x * x * x); return x * __builtin_amdgcn_rcpf(1.f + __expf(-u)); }
__device__ __forceinline__ float silu_fast(float x) { return x * __builtin_amdgcn_rcpf(1.f + __expf(-x)); }
#endif
HD inline float invfreq(int i) { return exp2f(-(float)i * (13.287712379549449f / 32.f)); }

constexpr size_t MiB = 1u << 20;
constexpr size_t al(size_t x) { return (x + 255) & ~(size_t)255; }
constexpr size_t WS_CTL = 0;
constexpr int CW_BAR = 4096, CW_CNT = 16384;
constexpr size_t WS_MOD = 1 * MiB;
constexpr size_t WS_RS = WS_MOD + al((size_t)NL * NB * 6144 * 4);
constexpr size_t WS_GL = WS_RS + al((size_t)M * 4);
constexpr size_t WS_LOG = WS_GL + al((size_t)M * 24 * 4);
constexpr size_t WS_ROUT = WS_LOG + al((size_t)M * 16 * 4);
constexpr size_t WS_KC = WS_ROUT + al((size_t)M * 16);
constexpr size_t WS_VC = WS_KC + al((size_t)NB * 2 * (NCMP + 1) * 64 * 2);
constexpr size_t WS_HID = WS_VC + al((size_t)NB * 2 * (NCMP + 1) * 64 * 2);
constexpr size_t WS_CRAW = WS_HID + al((size_t)NB * NCMP * 4 * 128 * 4);
constexpr size_t WS_SEL = WS_CRAW + al((size_t)NB * NCMP * 4 * 64 * 4);
constexpr size_t WS_CS = WS_SEL + al((size_t)M * 16 * 4);
constexpr size_t WS_CSB = WS_CS + al((size_t)M * 64 * 4);
constexpr size_t WS_PEB = WS_CSB + al((size_t)M * 64 * 2);
constexpr size_t WS_BND = WS_PEB + 4096;
constexpr size_t WS_KVS = WS_BND + 256;
constexpr size_t WS_CTOK = WS_KVS + al((size_t)NB * 4 * NCH * 4096 * 4);
constexpr size_t WS_CWT = WS_CTOK + al((size_t)24 * M * 4);
constexpr size_t WS_WIN_T = WS_CWT + al((size_t)24 * M * 8);
constexpr size_t WS_WGL_T = WS_WIN_T + al((size_t)NL * ZW * D * 2);
constexpr size_t WS_WOUT_T = WS_WGL_T + al((size_t)NL * 32 * D * 2);
constexpr size_t WS_WGU_T = WS_WOUT_T + al((size_t)NL * D * D * 2);
constexpr size_t WS_WD_T = WS_WGU_T + al((size_t)NL * 16 * 1024 * D * 2);
constexpr size_t WS_CW1_T = WS_WD_T + al((size_t)NL * 16 * D * 512 * 2);
constexpr size_t WS_CW2_T = WS_CW1_T + al((size_t)NL * 2 * 256 * 1024 * 2);
constexpr size_t WS_GWS = WS_CW2_T + al((size_t)NL * 2 * 64 * 128 * 2);
constexpr size_t WS_H = al(WS_GWS + (size_t)NL * 4 * 128 * 128 * 2);
constexpr size_t WS_Z = WS_H + al((size_t)M * D * 2);
constexpr size_t WS_XB = WS_Z + 88 * MiB;
constexpr size_t WS_MIX = WS_Z + al((size_t)M * ZW * 2);
constexpr size_t WS_END = WS_MIX + al((size_t)M * D * 2);
constexpr size_t WS_PB = WS_END;
constexpr size_t WS_END_NAIVE = WS_PB + al((size_t)M * 2 * 128 * 4);
constexpr size_t WS_YN = WS_H;
constexpr size_t WS_ACTN = WS_Z;
static_assert(WS_XB + (size_t)M * D * 2 <= WS_Z + (size_t)M * ZW * 2, "XB must fit in Z above ACT");
static_assert(CFG_B != 16 || CFG_S != 2048 || WS_END <= 512 * MiB, "workspace map exceeds 512 MiB");

struct P {
    const float *x, *c; const int* pos;
    const float *ada_w, *ada_b, *norm_mix_g, *norm_ffn_g, *w_in, *w_out, *ret_norm_g, *gmlp_ln_g, *gmlp_ws, *gmlp_b, *nsa_q_norm_g, *nsa_k_norm_g,
        *cmp_pe_k, *cmp_pe_v, *cmp_w1_k, *cmp_w2_k, *cmp_w1_v, *cmp_w2_v, *router_w, *router_b, *moe_w_gate, *moe_w_up, *moe_w_down;
    float* out; unsigned char* ws;
};
struct Rout { int e0, e1; float w0, w1; };

#define WSP(T, off) ((T*)(p.ws + (off)))

#define XB_TMO      128
#define XB_XCNT(j)  (256  + 64 * (j))
#define XB_XSUB(j)  (1280 + 64 * (j))
#define XB_XGEN(j)  (2304 + 64 * (j))
#define XB_TOP      3328
#define XB_TOPGEN   3392
#define XCD_BAR_WORDS 3456
#ifndef XB_SPIN_CAP
#define XB_SPIN_CAP (1u << 15)
#endif
#define LAS __attribute__((address_space(3)))
__device__ __forceinline__ unsigned xb_ld(unsigned* p)              { return __hip_atomic_load(p, __ATOMIC_RELAXED, __HIP_MEMORY_SCOPE_AGENT); }
__device__ __forceinline__ unsigned xb_add(unsigned* p, unsigned v) { return __hip_atomic_fetch_add(p, v, __ATOMIC_RELAXED, __HIP_MEMORY_SCOPE_AGENT); }
__device__ __forceinline__ unsigned xb_xcc_id() { return (unsigned)__builtin_amdgcn_s_getreg((3 << 11) | 20) & 0xFu; }
#define XB_SPIN(cond, bar) do { unsigned _sp = 0; while (cond) { __builtin_amdgcn_s_sleep(1); \
    if ((++_sp & 255u) == 0u) { if (xb_ld(&(bar)[XB_TMO])) break; if (_sp > XB_SPIN_CAP) { atomicAdd(&(bar)[XB_TMO], 1u); break; } } } } while (0)
struct XcdBarrier { unsigned* bar; unsigned x; volatile LAS unsigned* st; };
__device__ __forceinline__ XcdBarrier xcd_barrier_post(unsigned* bar, volatile LAS unsigned* st) {
    XcdBarrier b; b.bar = bar; b.x = xb_xcc_id(); b.st = st;
    if (threadIdx.x == 0) (void)xb_add(&bar[XB_XCNT(b.x)], 1u);
    return b;
}
__device__ __forceinline__ void xcd_barrier_complete(unsigned* bar, unsigned x, unsigned& nloc, unsigned& nx) {
    const unsigned G = gridDim.x * gridDim.y * gridDim.z;
    unsigned sum, cnt, mine, sp = 0u;
    for (;;) {
        sum = 0u; cnt = 0u; mine = 0u;
#pragma unroll
        for (unsigned j = 0; j < 16; ++j) { const unsigned c = xb_ld(&bar[XB_XCNT(j)]); sum += c; cnt += (c > 0u) ? 1u : 0u; mine = (j == x) ? c : mine; }
        if (sum == G) break;
        __builtin_amdgcn_s_sleep(1);
        if ((++sp & 255u) == 0u) { if (xb_ld(&bar[XB_TMO])) break; if (sp > XB_SPIN_CAP) { atomicAdd(&bar[XB_TMO], 1u); break; } }
    }
    nloc = mine > 0u ? mine : 1u; nx = cnt > 0u ? cnt : 1u;
}
__device__ __forceinline__ void xcd_barrier(const XcdBarrier& b) {
    asm volatile("s_waitcnt vmcnt(0)" ::: "memory");
    __syncthreads();
    if (threadIdx.x == 0) {
        unsigned* bar = b.bar;
        __builtin_amdgcn_s_waitcnt(0);
        unsigned nloc = b.st[0], nx = b.st[1];
        if (nloc == 0u) { xcd_barrier_complete(bar, b.x, nloc, nx); b.st[0] = nloc; b.st[1] = nx; }
        const unsigned old = xb_add(&bar[XB_XSUB(b.x)], 1u);
        const unsigned gen = old / nloc;
        if (old + 1u == (gen + 1u) * nloc) {
            __builtin_amdgcn_fence(__ATOMIC_RELEASE, "agent");
            asm volatile("s_waitcnt vmcnt(0)" ::: "memory");
            const unsigned og = xb_add(&bar[XB_TOP], 1u);
            const unsigned tg = og / nx;
            if (og + 1u == (tg + 1u) * nx) xb_add(&bar[XB_TOPGEN], 1u);
            else XB_SPIN(xb_ld(&bar[XB_TOPGEN]) == tg, bar);
            __builtin_amdgcn_fence(__ATOMIC_ACQUIRE, "agent");
            xb_add(&bar[XB_XGEN(b.x)], 1u);
            asm volatile("s_waitcnt vmcnt(0)" ::: "memory");
        } else {
            XB_SPIN(xb_ld(&bar[XB_XGEN(b.x)]) == gen, bar);
            __builtin_amdgcn_fence(__ATOMIC_ACQUIRE, "agent");
            asm volatile("s_waitcnt vmcnt(0)" ::: "memory");
        }
    }
    __syncthreads();
}
namespace pg8 {
#define PG8_LAS __attribute__((address_space(3)))
typedef short bf16x8 __attribute__((ext_vector_type(8)));
typedef float f32x4 __attribute__((ext_vector_type(4)));
typedef float f32x2 __attribute__((ext_vector_type(2)));
typedef unsigned u32x4 __attribute__((ext_vector_type(4)));
typedef unsigned u32x2 __attribute__((ext_vector_type(2)));
constexpr int BM = 256, BK = 64, HALF = 128, HTB = HALF * BK * 2, STAGE_BYTES = 8 * HTB, NXCD = 8, WGM = 8;
__device__ __forceinline__ int lds_byte(int r, int c) { const int st = (r >> 4) * 2 + (c >> 5), rr = r & 15, cc = c & 31, ob = rr * 64 + cc * 2; return st * 1024 + (ob ^ (((ob >> 9) & 1) << 5)); }
__device__ __forceinline__ void stage_rc(int b, int& R, int& C) { const int st = b / 1024, sb = b % 1024, swz = sb ^ (((sb >> 9) & 1) << 5); R = (st >> 1) * 16 + swz / 64; C = (st & 1) * 32 + (swz % 64) / 2; }
__device__ __forceinline__ int perm32(int rho) { const int n = rho >> 4, i = rho & 15; return 8 * (i >> 2) + 4 * n + (i & 3); }
__device__ __forceinline__ unsigned cvt_pk_bf16(float lo, float hi) { unsigned r; asm volatile("v_cvt_pk_bf16_f32 %0, %1, %2" : "=v"(r) : "v"(lo), "v"(hi)); return r; }

struct Unit { int pm, pn, aux, half; };
__device__ __forceinline__ bool deal_unit(int i, int G, int c, int U, int& L, int& half) {
    const int F = (U / G) * G, R = U - F; const long Li = (long)i * G + c; half = 0;
    if (Li < F) { L = (int)Li; return true; }
    if (R == 0 || i > U / G) return false;
    if (2 * R <= G) { if (c >= 2 * R) return false; L = F + (c >> 1); half = 1 + (c & 1); return true; }
    if (Li >= U) return false; L = (int)Li; return true; }
struct StaticSched {
    static constexpr bool GATHER = false; static constexpr int GOFF_LDS = 0;
    const char* A; const char* Bt; int K, nM, nN, nwg, G, c;
    __device__ void init(const void* A_, const void* Bt_, int M_, int N_, int K_, int G_, int c_) { A = (const char*)A_; Bt = (const char*)Bt_; K = K_; nM = M_ / BM; nN = N_ / BM; nwg = nM * nN; G = G_; c = c_; }
    __device__ __forceinline__ bool next(int i, Unit& u) const {
        int L, hf; if (!deal_unit(i, G, c, nwg, L, hf)) return false; u.half = hf;
        int wgid = L; { const int q = nwg / NXCD, r = nwg % NXCD, xcd = wgid % NXCD, off = wgid / NXCD; wgid = (xcd < r ? xcd * (q + 1) : r * (q + 1) + (xcd - r) * q) + off; }
        const int nig = WGM * nN, gid = wgid / nig, fm = gid * WGM, gsz = (nM - fm) < WGM ? (nM - fm) : WGM;
        u.pm = fm + ((wgid % nig) % gsz); u.pn = (wgid % nig) / gsz; u.aux = 0; return true;
    }
    __device__ __forceinline__ int ktiles() const { return K / BK; }
    __device__ __forceinline__ const char* a_base() const { return A; }
    __device__ __forceinline__ size_t a_kstep() const { return BK * 2; }
    __device__ __forceinline__ unsigned a_off(const Unit& u, int row, int C) const { return (unsigned)((u.pm * BM + row) * K + C) * 2u; }
    __device__ __forceinline__ unsigned b_ld() const { return (unsigned)K * 2u; }
    __device__ __forceinline__ const char* b_tile(const Unit& u, int t) const { return Bt + (size_t)u.pn * BM * K * 2 + (size_t)t * (BK * 2); }
};

#ifndef PG8_SP2
#define PG8_SP2 true
#endif
#ifndef PG8_ALIGN
#define PG8_ALIGN true
#endif
template <class Epi, class Sched, bool SP2 = PG8_SP2, bool ALIGN_EPI = PG8_ALIGN>
__device__ __forceinline__ void gemm_phase(PG8_LAS unsigned char* lds, const Sched& S, const Epi& E) {
    const int tid = tid_fresh(), wid = __builtin_amdgcn_readfirstlane(tid >> 6), lane = tid & 63, wr = wid >> 2, wc = wid & 3, fr = lane & 15, fq = lane >> 4;
    const int nt = S.ktiles();
    unsigned voffB[2];
    const unsigned ldb = S.b_ld();
#pragma unroll
    for (int i = 0; i < 2; ++i) { int R, C; stage_rc(tid * 16 + i * 8192, R, C); const int Rb = Epi::PERM ? ((R & ~31) + perm32(R & 31)) : R; voffB[i] = (unsigned)Rb * ldb + (unsigned)C * 2u; }
    const unsigned hstepB = (unsigned)HALF * ldb;
    const unsigned ldsw = (unsigned)wid * 1024u;
    const int aoff = lds_byte(wr * 64 + fr, fq * 8), boff = lds_byte(wc * 32 + fr, fq * 8);
    const char* gA = S.a_base(); const size_t akst = S.a_kstep();
#define PG8_SA(b, h) (((b) * 2 + (h)) * HTB)
#define PG8_SB(b, h) ((4 + (b) * 2 + (h)) * HTB)
#define PG8_STAGE_A(bufoff, offarr, h, tt) do { _Pragma("unroll") for (int _i = 0; _i < 2; ++_i) \
        __builtin_amdgcn_global_load_lds((const unsigned*)(gA + (size_t)(tt) * akst + (offarr)[h][_i]), (PG8_LAS unsigned*)(lds + (bufoff) + ldsw + _i * 8192), 16, 0, 0); } while (0)
#define PG8_STAGE_B(bufoff, bptr, h) do { _Pragma("unroll") for (int _i = 0; _i < 2; ++_i) \
        __builtin_amdgcn_global_load_lds((const unsigned*)((bptr) + (h) * hstepB + voffB[_i]), (PG8_LAS unsigned*)(lds + (bufoff) + ldsw + _i * 8192), 16, 0, 0); } while (0)
#define PG8_LDA(dst, b, h) do { _Pragma("unroll") for (int m = 0; m < 4; ++m) _Pragma("unroll") for (int k = 0; k < 2; ++k) dst[m][k] = *(const PG8_LAS bf16x8*)(lds + PG8_SA(b, h) + aoff + m * 2048 + k * 1024); } while (0)
#define PG8_LDB(dst, b, h) do { _Pragma("unroll") for (int n = 0; n < 2; ++n) _Pragma("unroll") for (int k = 0; k < 2; ++k) dst[n][k] = *(const PG8_LAS bf16x8*)(lds + PG8_SB(b, h) + boff + n * 2048 + k * 1024); } while (0)
#define PG8_MMA(ai, bj, At, Bt) do { __builtin_amdgcn_s_setprio(1); _Pragma("unroll") for (int m = 0; m < 4; ++m) _Pragma("unroll") for (int n = 0; n < 2; ++n) _Pragma("unroll") for (int k = 0; k < 2; ++k) \
        acc[ai][bj][m][n] = __builtin_amdgcn_mfma_f32_16x16x32_bf16(Bt[n][k], At[m][k], acc[ai][bj][m][n], 0, 0, 0); __builtin_amdgcn_s_setprio(0); } while (0)
#define PG8_WAIT_V(n) asm volatile("s_waitcnt vmcnt(" #n ")" ::: "memory")
#define PG8_WAIT_L(n) asm volatile("s_waitcnt lgkmcnt(" #n ")" ::: "memory")
#define PG8_BAR __builtin_amdgcn_s_barrier()
#define PG8_SCHED __builtin_amdgcn_sched_barrier(0)
#define PG8_AOFFS(dst, u) do { _Pragma("unroll") for (int _i = 0; _i < 2; ++_i) { int _R, _C; stage_rc(tid * 16 + _i * 8192, _R, _C); _Pragma("unroll") for (int _h = 0; _h < 2; ++_h) dst[_h][_i] = S.a_off(u, ((u).half ? ((u).half == 2 ? HALF : 0) : _h * HALF) + _R, _C); } } while (0)
#define PG8_NOFF_PUT() do { *(PG8_LAS u32x4*)(lds + Sched::GOFF_LDS + tid * 16) = (u32x4){noff[0][0], noff[0][1], noff[1][0], noff[1][1]}; } while (0)
#define PG8_NOFF_GET(dst) do { const u32x4 _v = *(const PG8_LAS u32x4*)(lds + Sched::GOFF_LDS + tid * 16); dst[0][0] = _v.x; dst[0][1] = _v.y; dst[1][0] = _v.z; dst[1][1] = _v.w; } while (0)
    Unit cur, nxt; int ui = 0;
    if (!S.next(0, cur)) return;
    f32x4 acc[2][2][4][2];
#pragma unroll
    for (int a = 0; a < 2; ++a)
#pragma unroll
        for (int b = 0; b < 2; ++b)
#pragma unroll
            for (int m = 0; m < 4; ++m)
#pragma unroll
                for (int n = 0; n < 2; ++n) acc[a][b][m][n] = (f32x4){0.f, 0.f, 0.f, 0.f};
    bf16x8 At[4][2], B0[2][2], B1[2][2];
    constexpr bool GATHER = Sched::GATHER;
    unsigned coff[2][2], noff[2][2];
    PG8_AOFFS(coff, cur);
    { const char* b0 = S.b_tile(cur, 0); const char* b1 = S.b_tile(cur, 1);
      if constexpr (SP2) {
      PG8_STAGE_B(PG8_SB(0, 0), b0, 0); PG8_STAGE_B(PG8_SB(0, 1), b0, 1); PG8_STAGE_A(PG8_SA(0, 0), coff, 0, 0); PG8_STAGE_A(PG8_SA(0, 1), coff, 1, 0);
      if (wr == 1) PG8_BAR;
      PG8_WAIT_V(2); PG8_BAR;
      PG8_STAGE_B(PG8_SB(1, 0), b1, 0); PG8_STAGE_A(PG8_SA(1, 0), coff, 0, 1); PG8_STAGE_B(PG8_SB(1, 1), b1, 1);
      PG8_WAIT_V(6); PG8_BAR;
      } else {
      PG8_STAGE_B(PG8_SB(0, 0), b0, 0); PG8_STAGE_A(PG8_SA(0, 0), coff, 0, 0); PG8_STAGE_B(PG8_SB(0, 1), b0, 1); PG8_STAGE_A(PG8_SA(0, 1), coff, 1, 0);
      if (wr == 1) PG8_BAR;
      PG8_WAIT_V(4); PG8_BAR;
      PG8_STAGE_B(PG8_SB(1, 0), b1, 0); PG8_STAGE_A(PG8_SA(1, 0), coff, 0, 1); PG8_STAGE_B(PG8_SB(1, 1), b1, 1);
      PG8_WAIT_V(6); PG8_BAR; } }
    for (;;) {
        const bool has_next = S.next(ui + 1, nxt);
        if (has_next) { if constexpr (GATHER) { PG8_AOFFS(noff, nxt); PG8_NOFF_PUT(); } }
        else { nxt = cur;
#pragma unroll
            for (int _h = 0; _h < 2; ++_h)
#pragma unroll
                for (int _i = 0; _i < 2; ++_i) if constexpr (GATHER) noff[_h][_i] = coff[_h][_i]; if constexpr (GATHER) PG8_NOFF_PUT(); }
        for (int t = 0; t < nt; t += 2) {
            const bool last = (t == nt - 2);
            const int t2 = last ? 0 : t + 2, t3 = t2 + 1;
            const char* b2 = last ? S.b_tile(nxt, 0) : S.b_tile(cur, t + 2);
            const char* b3 = last ? S.b_tile(nxt, 1) : S.b_tile(cur, t + 3);
            unsigned o2[2][2];
            if constexpr (GATHER) {
#pragma unroll
                for (int _h = 0; _h < 2; ++_h)
#pragma unroll
                    for (int _i = 0; _i < 2; ++_i) o2[_h][_i] = coff[_h][_i];
                if (last) PG8_NOFF_GET(o2); }
            else { if (last) PG8_AOFFS(o2, nxt); else PG8_AOFFS(o2, cur); PG8_AOFFS(coff, cur); }
            if constexpr (SP2) {
            PG8_LDB(B0, 0, 0); PG8_LDB(B1, 0, 1); PG8_SCHED; PG8_LDA(At, 0, 0); PG8_STAGE_A(PG8_SA(1, 1), coff, 1, t + 1);
            PG8_WAIT_V(8); PG8_WAIT_L(0); PG8_BAR; PG8_MMA(0, 0, At, B0); PG8_MMA(0, 1, At, B1); PG8_BAR; PG8_SCHED;
            PG8_LDA(At, 0, 1); PG8_STAGE_B(PG8_SB(0, 0), b2, 0); PG8_STAGE_B(PG8_SB(0, 1), b2, 1); PG8_STAGE_A(PG8_SA(0, 0), o2, 0, t2);
            PG8_WAIT_V(8); PG8_WAIT_L(0); PG8_BAR; if (!cur.half) { PG8_MMA(1, 0, At, B0); PG8_MMA(1, 1, At, B1); } PG8_BAR; PG8_SCHED;
            PG8_LDB(B0, 1, 0); PG8_LDB(B1, 1, 1); PG8_SCHED; PG8_LDA(At, 1, 0); PG8_STAGE_A(PG8_SA(0, 1), o2, 1, t2);
            PG8_WAIT_V(8); PG8_WAIT_L(0); PG8_BAR; PG8_MMA(0, 0, At, B0); PG8_MMA(0, 1, At, B1); PG8_BAR; PG8_SCHED;
            PG8_LDA(At, 1, 1); PG8_STAGE_B(PG8_SB(1, 0), b3, 0); PG8_STAGE_B(PG8_SB(1, 1), b3, 1); PG8_STAGE_A(PG8_SA(1, 0), o2, 0, t3);
            PG8_WAIT_V(8); PG8_WAIT_L(0); PG8_BAR; if (!cur.half) { PG8_MMA(1, 0, At, B0); PG8_MMA(1, 1, At, B1); } PG8_BAR; PG8_SCHED;
            } else {
            PG8_LDB(B0, 0, 0); PG8_SCHED; PG8_LDA(At, 0, 0); PG8_STAGE_A(PG8_SA(1, 1), coff, 1, t + 1);
            PG8_WAIT_L(8); PG8_BAR; PG8_WAIT_L(0); PG8_MMA(0, 0, At, B0); PG8_BAR; PG8_SCHED;
            PG8_LDB(B1, 0, 1); PG8_STAGE_B(PG8_SB(0, 0), b2, 0);
            PG8_BAR; PG8_WAIT_L(0); PG8_MMA(0, 1, At, B1); PG8_BAR;
            PG8_LDA(At, 0, 1); PG8_STAGE_A(PG8_SA(0, 0), o2, 0, t2);
            PG8_BAR; PG8_WAIT_L(0); PG8_MMA(1, 0, At, B0); PG8_BAR; PG8_SCHED;
            PG8_STAGE_B(PG8_SB(0, 1), b2, 1);
            PG8_WAIT_V(6); PG8_BAR; PG8_MMA(1, 1, At, B1); PG8_BAR;
            PG8_LDB(B0, 1, 0); PG8_SCHED; PG8_LDA(At, 1, 0); PG8_STAGE_A(PG8_SA(0, 1), o2, 1, t2);
            PG8_WAIT_L(8); PG8_BAR; PG8_WAIT_L(0); PG8_MMA(0, 0, At, B0); PG8_BAR; PG8_SCHED;
            PG8_LDB(B1, 1, 1); PG8_STAGE_B(PG8_SB(1, 0), b3, 0);
            PG8_BAR; PG8_WAIT_L(0); PG8_MMA(0, 1, At, B1); PG8_BAR;
            PG8_LDA(At, 1, 1); PG8_STAGE_A(PG8_SA(1, 0), o2, 0, t3);
            PG8_BAR; PG8_WAIT_L(0); PG8_MMA(1, 0, At, B0); PG8_BAR; PG8_SCHED;
            PG8_STAGE_B(PG8_SB(1, 1), b3, 1);
            PG8_WAIT_V(6); PG8_BAR; PG8_MMA(1, 1, At, B1); PG8_BAR;
            }
        }
        if constexpr (ALIGN_EPI) { if (wr == 0) PG8_BAR; }
        if constexpr (!Epi::AFTER_DRAIN) E(acc, cur, wr, wc, fr, fq);
        if (!has_next) break;
#pragma unroll
        for (int a = 0; a < 2; ++a)
#pragma unroll
            for (int b = 0; b < 2; ++b)
#pragma unroll
                for (int m = 0; m < 4; ++m)
#pragma unroll
                    for (int n = 0; n < 2; ++n) acc[a][b][m][n] = (f32x4){0.f, 0.f, 0.f, 0.f};
        cur = nxt; ++ui;
        if constexpr (ALIGN_EPI) { if (wr == 1) PG8_BAR; }
#pragma unroll
        for (int _h = 0; _h < 2; ++_h)
#pragma unroll
            for (int _i = 0; _i < 2; ++_i) if constexpr (GATHER) coff[_h][_i] = 0u;
        if constexpr (GATHER) PG8_NOFF_GET(coff);
    }
    PG8_WAIT_V(0);
    if constexpr (!ALIGN_EPI) { if (wr == 0) PG8_BAR; }
    PG8_BAR;
    if constexpr (Epi::AFTER_DRAIN) E.fused(acc, cur, wr, wc, fr, fq, lds);
#undef PG8_SA
#undef PG8_SB
#undef PG8_STAGE_A
#undef PG8_STAGE_B
#undef PG8_LDA
#undef PG8_LDB
#undef PG8_MMA
#undef PG8_WAIT_V
#undef PG8_WAIT_L
#undef PG8_BAR
#undef PG8_SCHED
#undef PG8_AOFFS
#undef PG8_NOFF_PUT
#undef PG8_NOFF_GET
}

struct EpiBf16Store {
    static constexpr bool PERM = true, AFTER_DRAIN = false;
    bf16* O; int ldc;
    __device__ __forceinline__ void operator()(const f32x4 (&acc)[2][2][4][2], const Unit& u, int wr, int wc, int fr, int fq) const {
        const int row0 = u.pm * BM + wr * 64 + fr + (u.half == 2 ? HALF : 0), col0 = u.pn * BM + wc * 32 + 8 * fq;
#pragma unroll
        for (int ai = 0; ai < 2; ++ai)
#pragma unroll
            for (int m = 0; m < 4; ++m) { if (ai == 1 && u.half) continue; bf16* rowp = O + (size_t)(row0 + ai * HALF + m * 16) * ldc + col0;
#pragma unroll
                for (int bj = 0; bj < 2; ++bj) { const f32x4 v0 = acc[ai][bj][m][0], v1 = acc[ai][bj][m][1];
                    u32x4 w; w.x = cvt_pk_bf16(v0[0], v0[1]); w.y = cvt_pk_bf16(v0[2], v0[3]); w.z = cvt_pk_bf16(v1[0], v1[1]); w.w = cvt_pk_bf16(v1[2], v1[3]);
                    *(u32x4*)(rowp + bj * HALF) = w; } }
    }
};
struct EpiResidual {
    static constexpr bool PERM = true, AFTER_DRAIN = false;
    const void* xs; bool xbf; bf16* out; const float* gate;
    __device__ __forceinline__ void operator()(const f32x4 (&acc)[2][2][4][2], const Unit& u, int wr, int wc, int fr, int fq) const {
        const int row0 = u.pm * BM + wr * 64 + fr + (u.half == 2 ? HALF : 0), col0 = u.pn * BM + wc * 32 + 8 * fq;
        const float* gp = gate + (size_t)((u.pm * BM) / NS) * 6144 + col0;
        f32x4 gv[2][2];
#pragma unroll
        for (int bj = 0; bj < 2; ++bj)
#pragma unroll
            for (int n = 0; n < 2; ++n) gv[bj][n] = *(const f32x4*)(gp + bj * HALF + n * 4);
#pragma unroll
        for (int ai = 0; ai < 2; ++ai) { if (ai == 1 && u.half) continue;
#pragma unroll
          for (int mp = 0; mp < 2; ++mp) {
            f32x4 x0[2][2], x1[2][2];
#pragma unroll
            for (int mm = 0; mm < 2; ++mm) { const size_t ro = (size_t)(row0 + ai * HALF + (2 * mp + mm) * 16) * D + col0;
#pragma unroll
                for (int bj = 0; bj < 2; ++bj) {
                    if (xbf) { const u32x4 w = *(const u32x4*)((const bf16*)xs + ro + bj * HALF);
                        x0[mm][bj] = (f32x4){__builtin_bit_cast(float, w.x << 16), __builtin_bit_cast(float, w.x & 0xffff0000u), __builtin_bit_cast(float, w.y << 16), __builtin_bit_cast(float, w.y & 0xffff0000u)};
                        x1[mm][bj] = (f32x4){__builtin_bit_cast(float, w.z << 16), __builtin_bit_cast(float, w.z & 0xffff0000u), __builtin_bit_cast(float, w.w << 16), __builtin_bit_cast(float, w.w & 0xffff0000u)}; }
                    else { x0[mm][bj] = *(const f32x4*)((const float*)xs + ro + bj * HALF); x1[mm][bj] = *(const f32x4*)((const float*)xs + ro + bj * HALF + 4); } } }
#pragma unroll
            for (int mm = 0; mm < 2; ++mm) { const int m = 2 * mp + mm; const size_t ro = (size_t)(row0 + ai * HALF + m * 16) * D + col0;
#pragma unroll
                for (int bj = 0; bj < 2; ++bj) { const f32x4 y0 = x0[mm][bj] + gv[bj][0] * acc[ai][bj][m][0], y1 = x1[mm][bj] + gv[bj][1] * acc[ai][bj][m][1];
                    u32x4 o; o.x = cvt_pk_bf16(y0[0], y0[1]); o.y = cvt_pk_bf16(y0[2], y0[3]); o.z = cvt_pk_bf16(y1[0], y1[1]); o.w = cvt_pk_bf16(y1[2], y1[3]);
                    *(u32x4*)(out + ro + bj * HALF) = o; } } } }
    }
};
}
constexpr int NTH = 512;
typedef float f32x4_t __attribute__((ext_vector_type(4)));
typedef unsigned u32x4_t __attribute__((ext_vector_type(4)));
typedef unsigned u32x2_t __attribute__((ext_vector_type(2)));
typedef short s16x8_t __attribute__((ext_vector_type(8)));
#define LDSP(T, off) ((LAS T*)(lds + (off)))
__device__ __forceinline__ float wave_sum(float v) {
#pragma unroll
    for (int o = 1; o < 64; o <<= 1) v += __shfl_xor(v, o);
    return v;
}
__device__ __forceinline__ unsigned pk_bf16(float lo, float hi) { return pg8::cvt_pk_bf16(lo, hi); }

constexpr int CVT_WIN = 2 * 16 * 44, CVT_WOUT = 2 * 16 * 16, CVT_G = 32 * 16 * 8, CVT_U = CVT_G, CVT_D = 32 * 8 * 16, CVT_C1 = 4 * 32 * 2, CVT_C2 = 4 * 2;
constexpr int CVT_TOTAL = CVT_WIN + CVT_WOUT + CVT_G + CVT_U + CVT_D + CVT_C1 + CVT_C2;
__device__ __forceinline__ void cvt_job(const P& p, int T, const float*& src, size_t& lds_, bf16*& dst, size_t& ldd, bool& perm) {
    perm = false;
    if (T < CVT_WIN) { const int l = T / 704, r = T % 704, kt = r / 44, nt = r % 44;
        src = p.w_in + (size_t)l * D * NIN + (size_t)kt * 64 * NIN + nt * 64; lds_ = NIN; dst = WSP(bf16, WS_WIN_T) + (size_t)l * ZW * D + (size_t)((nt / 4) * 256 + (nt % 4) * 32) * D + kt * 64; ldd = D; perm = true; return; }
    T -= CVT_WIN;
    if (T < CVT_WOUT) { const int l = T / 256, r = T % 256, kt = r / 16, nt = r % 16;
        src = p.w_out + (size_t)l * D * D + (size_t)kt * 64 * D + nt * 64; lds_ = D; dst = WSP(bf16, WS_WOUT_T) + (size_t)l * D * D + (size_t)nt * 64 * D + kt * 64; ldd = D; return; }
    T -= CVT_WOUT;
    if (T < CVT_G + CVT_U) { const int up = T >= CVT_G; if (up) T -= CVT_G; const int le = T / 128, r = T % 128, kt = r / 8, nt = r % 8;
        src = (up ? p.moe_w_up : p.moe_w_gate) + (size_t)le * D * 512 + (size_t)kt * 64 * 512 + nt * 64; lds_ = 512;
        const int row0 = 256 * (nt / 2) + 64 * (nt % 2) + (up ? 128 : 0);
        dst = WSP(bf16, WS_WGU_T) + (size_t)le * 1024 * D + (size_t)row0 * D + kt * 64; ldd = D; return; }
    T -= CVT_G + CVT_U;
    if (T < CVT_D) { const int le = T / 128, r = T % 128, kt = r / 16, nt = r % 16;
        src = p.moe_w_down + (size_t)le * 512 * D + (size_t)kt * 64 * D + nt * 64; lds_ = D; dst = WSP(bf16, WS_WD_T) + (size_t)le * D * 512 + (size_t)nt * 64 * 512 + kt * 64; ldd = 512; return; }
    T -= CVT_D;
    if (T < CVT_C1) { const int lk = T / 64, l = lk / 2, kv = lk % 2, r = T % 64, kt = r / 2, nt = r % 2;
        src = (kv ? p.cmp_w1_v : p.cmp_w1_k) + (size_t)l * 2048 * 128 + (size_t)kt * 64 * 128 + nt * 64; lds_ = 128; dst = WSP(bf16, WS_CW1_T) + (size_t)lk * 256 * 1024 + (size_t)((kt >= 16 ? 128 : 0) + nt * 64) * 1024 + (kt & 15) * 64; ldd = 1024; return; }
    T -= CVT_C1;
    { const int lk = T / 2, l = lk / 2, kv = lk % 2, kt = T % 2;
        src = (kv ? p.cmp_w2_v : p.cmp_w2_k) + (size_t)l * 128 * 64 + (size_t)kt * 64 * 64; lds_ = 64; dst = WSP(bf16, WS_CW2_T) + (size_t)lk * 64 * 128 + kt * 64; ldd = 128; }
}
__device__ __forceinline__ void p0_prologue(const P& p, LAS unsigned char* lds) {
    const int tid = tid_fresh();
    if (bid_fresh() < 192) {
        LAS float* sc = LDSP(float, 0);
        LAS float* red = LDSP(float, 65536);
        for (int i = tid; i < NB * D; i += NTH) sc[i] = silu_f(p.c[i]);
        __syncthreads();
        const int lane = tid & 63, wv_ = tid >> 6, col = bid_fresh() * 64 + lane, l = col / 6144, n = col % 6144;
        float acc[NB];
#pragma unroll
        for (int b = 0; b < NB; ++b) acc[b] = 0.f;
        const float* w = p.ada_w + (size_t)l * D * 6144 + n;
        for (int k = wv_ * 128; k < wv_ * 128 + 128; k += 16) { float wv[16];
#pragma unroll
            for (int u = 0; u < 16; ++u) wv[u] = w[(size_t)(k + u) * 6144];
#pragma unroll
            for (int u = 0; u < 16; ++u)
#pragma unroll
                for (int b = 0; b < NB; ++b) acc[b] += sc[b * D + k + u] * wv[u]; }
#pragma unroll
        for (int b = 0; b < NB; ++b) red[(wv_ * NB + b) * 64 + lane] = acc[b];
        __syncthreads();
        for (int i = tid; i < NB * 64; i += NTH) { const int b = i >> 6, c = i & 63, cc = bid_fresh() * 64 + c, ll = cc / 6144, nn = cc % 6144; float s = p.ada_b[ll * 6144 + nn];
#pragma unroll
            for (int q = 0; q < 8; ++q) s += red[(q * NB + b) * 64 + c];
            WSP(float, WS_MOD)[((size_t)ll * NB + b) * 6144 + nn] = s; }
        __syncthreads();
    }
    { constexpr int TP = 8; const int G = grid_fresh(), bx = bid_fresh();
      for (int T0 = bx * TP; T0 < CVT_TOTAL; T0 += G * TP) {
        f32x4_t va[TP], vb[TP]; bf16* dst[TP]; size_t ld[TP]; bool perm[TP];
        const int k = tid >> 3, ns = (tid & 7) * 8;
#pragma unroll
        for (int q = 0; q < TP; ++q) { const int T = T0 + q < CVT_TOTAL ? T0 + q : CVT_TOTAL - 1; const float* src; size_t ls; cvt_job(p, T, src, ls, dst[q], ld[q], perm[q]);
            va[q] = *(const f32x4_t*)(src + (size_t)k * ls + ns); vb[q] = *(const f32x4_t*)(src + (size_t)k * ls + ns + 4); }
#pragma unroll
        for (int q = 0; q < TP; ++q) { LAS float* tile = LDSP(float, q * 64 * 65 * 4);
#pragma unroll
            for (int j = 0; j < 4; ++j) { tile[k * 65 + ns + j] = va[q][j]; tile[k * 65 + ns + 4 + j] = vb[q][j]; } }
        __syncthreads();
#pragma unroll
        for (int q = 0; q < TP; ++q) { if (T0 + q < CVT_TOTAL) { LAS float* tile = LDSP(float, q * 64 * 65 * 4); const int n = tid >> 3, ks = (tid & 7) * 8; u32x4_t w;
            w.x = pk_bf16(tile[(ks + 0) * 65 + n], tile[(ks + 1) * 65 + n]); w.y = pk_bf16(tile[(ks + 2) * 65 + n], tile[(ks + 3) * 65 + n]);
            w.z = pk_bf16(tile[(ks + 4) * 65 + n], tile[(ks + 5) * 65 + n]); w.w = pk_bf16(tile[(ks + 6) * 65 + n], tile[(ks + 7) * 65 + n]);
            const int nrow = perm[q] ? 128 * (n >> 5) + (n & 31) : n;
            *(u32x4_t*)(dst[q] + (size_t)nrow * ld[q] + ks) = w; } }
        __syncthreads();
      } }
    const long gid = (long)bid_fresh() * NTH + tid, gsz = (long)grid_fresh() * NTH;
    for (long i = gid; i < 2L * 32 * D; i += gsz) { const int k = (int)(i % D), j = (int)((i / D) % 32), l = (int)(i / (32 * D));
        WSP(bf16, WS_WGL_T)[i] = j < 24 ? f2bf(p.w_in[(size_t)l * D * NIN + (size_t)k * NIN + ZW + j]) : (bf16)0; }
    { const int lane = tid & 63, gw = (int)(gid >> 6), nw = (int)(gsz >> 6);
      for (int o = gw; o < 2 * 2 * 128; o += nw) { const int j = o % 128, kv = (o / 128) % 2, l = o / 256;
        const float* pe = (kv ? p.cmp_pe_v : p.cmp_pe_k) + (size_t)l * 2048; const float* w1 = (kv ? p.cmp_w1_v : p.cmp_w1_k) + (size_t)l * 2048 * 128 + j; float sacc = 0.f;
#pragma unroll 8
        for (int k = lane; k < 2048; k += 64) sacc += pe[k] * w1[(size_t)k * 128];
        sacc = wave_sum(sacc); if (lane == 0) WSP(float, WS_PEB)[o] = sacc; } }
    if (gid < 6) { const int l = (int)gid / 3, br = (int)gid % 3; float mq = 0.f, mk = 0.f;
        for (int e = 0; e < 64; ++e) { mq = fmaxf(mq, fabsf(p.nsa_q_norm_g[l * 64 + e])); mk = fmaxf(mk, fabsf(p.nsa_k_norm_g[(l * 3 + br) * 64 + e])); }
        WSP(float, WS_BND)[gid] = 8.f * mq * mk * 1.4426950408889634f; }
    for (long i = gid; i < 2L * 4 * 128 * 128; i += gsz) { const int s = (int)(i % 128), t = (int)((i / 128) % 128); WSP(bf16, WS_GWS)[i] = s <= t ? f2bf(p.gmlp_ws[i]) : (bf16)0; }
    for (long i = gid; i < (long)M * 32; i += gsz) { const long m = i / 32; const int j = (int)(i % 32); const float ang = (float)p.pos[m] * invfreq(j);
        const float cv = cosf(ang), sv = sinf(ang); WSP(float, WS_CS)[m * 64 + j] = cv; WSP(float, WS_CS)[m * 64 + 32 + j] = sv; WSP(bf16, WS_CSB)[m * 64 + j] = f2bf(cv); WSP(bf16, WS_CSB)[m * 64 + 32 + j] = f2bf(sv); }
}

__device__ __forceinline__ f32x4_t ld4x(const void* base, size_t idx, bool isbf) {
    if (isbf) { const u32x2_t w = *(const u32x2_t*)((const bf16*)base + idx); return (f32x4_t){__builtin_bit_cast(float, w.x << 16), __builtin_bit_cast(float, w.x & 0xffff0000u), __builtin_bit_cast(float, w.y << 16), __builtin_bit_cast(float, w.y & 0xffff0000u)}; }
    return *(const f32x4_t*)((const float*)base + idx); }
__device__ __forceinline__ void norm_phase(const P& p, LAS unsigned char* lds, const void* xs, bool xbf, int l, int which, int cbank = -1) {
    if (cbank < 0) cbank = l;
    const int tid = tid_fresh(), lane = tid & 63, wave = tid >> 6;
    const float* g = (which ? p.norm_ffn_g : p.norm_mix_g) + l * D;
    bf16* H = WSP(bf16, WS_H);
    LAS float* wr_l = LDSP(float, 0);
    LAS float* lg_l = LDSP(float, 65536);
    LAS int* lcnt = LDSP(int, 65536 + 8192);
    LAS float* red_l = LDSP(float, 65536 + 8192 + 256);
    LAS float* rs_l = LDSP(float, 65536 + 8192 + 256 + 2048);
    for (int rb = bid_fresh(); rb < M / 128; rb += grid_fresh()) {
        const int b = (rb * 128) / NS; const float* mod = WSP(float, WS_MOD) + ((size_t)l * NB + b) * 6144 + which * 3072;
        if (which) {
            __syncthreads();
            if (tid < 48) lcnt[tid] = 0;
            for (int i = tid; i < D * 16; i += NTH) { const int k = i >> 4, e = i & 15; wr_l[(k >> 4) * 256 + ((k >> 2) & 3) * 64 + e * 4 + (k & 3)] = g[k] * (1.f + mod[1024 + k]) * p.router_w[i]; }
            if (tid < 256) { const int e = tid & 15, part = tid >> 4; float s = 0.f; for (int k = part * 64; k < part * 64 + 64; ++k) s += mod[k] * p.router_w[k * 16 + e]; red_l[part * 16 + e] = s; }
            __syncthreads();
            if (tid < 16) { float s = 0.f;
#pragma unroll
                for (int q = 0; q < 16; ++q) s += red_l[q * 16 + tid]; red_l[256 + tid] = s; }
            __syncthreads();
            const int r = lane & 15, kq = lane >> 4; const size_t xr = (size_t)((long)rb * 128 + wave * 16 + r) * D + 4 * kq;
            f32x4_t acc = {0.f, 0.f, 0.f, 0.f}; float ss = 0.f;
#pragma unroll 8
            for (int t = 0; t < 64; ++t) { const f32x4_t xv = ld4x(xs, xr + 16 * t, xbf); const f32x4_t av = *(const LAS f32x4_t*)(wr_l + t * 256 + kq * 64 + r * 4);
                ss += xv[0] * xv[0] + xv[1] * xv[1] + xv[2] * xv[2] + xv[3] * xv[3];
                acc = __builtin_amdgcn_mfma_f32_16x16x4f32(av[0], xv[0], acc, 0, 0, 0); acc = __builtin_amdgcn_mfma_f32_16x16x4f32(av[1], xv[1], acc, 0, 0, 0);
                acc = __builtin_amdgcn_mfma_f32_16x16x4f32(av[2], xv[2], acc, 0, 0, 0); acc = __builtin_amdgcn_mfma_f32_16x16x4f32(av[3], xv[3], acc, 0, 0, 0); }
            ss += __shfl_xor(ss, 16); ss += __shfl_xor(ss, 32);
            const float rs = 1.0f / sqrtf(ss * (1.f / D) + EPS);
            if (kq == 0) rs_l[wave * 16 + r] = rs;
#pragma unroll
            for (int reg = 0; reg < 4; ++reg) lg_l[(wave * 16 + r) * 16 + 4 * kq + reg] = rs * acc[reg] + red_l[256 + 4 * kq + reg];
        }
        f32x4_t gmv[4], shv[4];
#pragma unroll
        for (int i = 0; i < 4; ++i) { const int k0 = 256 * i + 4 * lane; const f32x4_t gv = *(const f32x4_t*)(g + k0), sc = *(const f32x4_t*)(mod + 1024 + k0); shv[i] = *(const f32x4_t*)(mod + k0);
#pragma unroll
            for (int j = 0; j < 4; ++j) gmv[i][j] = gv[j] * (1.f + sc[j]); }
        f32x4_t hn[4][4];
#pragma unroll
        for (int r = 0; r < 4; ++r)
#pragma unroll
            for (int i = 0; i < 4; ++i) hn[r][i] = ld4x(xs, (size_t)((long)rb * 128 + wave * 16 + r) * D + 256 * i + 4 * lane, xbf);
#pragma unroll
        for (int grp = 0; grp < 4; ++grp) {
            const long row0 = (long)rb * 128 + wave * 16 + grp * 4;
            f32x4_t hv[4][4]; float ss[4];
#pragma unroll
            for (int r = 0; r < 4; ++r) { ss[r] = 0.f;
#pragma unroll
                for (int i = 0; i < 4; ++i) { hv[r][i] = hn[r][i]; if (!which) ss[r] += hv[r][i][0] * hv[r][i][0] + hv[r][i][1] * hv[r][i][1] + hv[r][i][2] * hv[r][i][2] + hv[r][i][3] * hv[r][i][3]; } }
            if (grp < 3) {
#pragma unroll
                for (int r = 0; r < 4; ++r)
#pragma unroll
                    for (int i = 0; i < 4; ++i) hn[r][i] = ld4x(xs, (size_t)(row0 + 4 + r) * D + 256 * i + 4 * lane, xbf); }
#pragma unroll
            for (int r = 0; r < 4; ++r) ss[r] = which ? rs_l[wave * 16 + grp * 4 + r] : 1.0f / sqrtf(wave_sum(ss[r]) * (1.f / D) + EPS);
#pragma unroll
            for (int i = 0; i < 4; ++i) { const int k0 = 256 * i + 4 * lane;
#pragma unroll
                for (int r = 0; r < 4; ++r) { hv[r][i] = hv[r][i] * ss[r] * gmv[i] + shv[i];
                    u32x2_t w; w.x = pk_bf16(hv[r][i][0], hv[r][i][1]); w.y = pk_bf16(hv[r][i][2], hv[r][i][3]); *(u32x2_t*)(H + (row0 + r) * D + k0) = w; } }
        }
        if (which) {
            int cls = -1, rank = 0; float wa = 0.f, wb = 0.f; const long row = (long)rb * 128 + wave * 16 + lane;
            __builtin_amdgcn_s_waitcnt(0);
            if (lane < 16) {
                const LAS float* q = lg_l + (wave * 16 + lane) * 16;
                float mx = q[0];
#pragma unroll
                for (int e = 1; e < 16; ++e) mx = fmaxf(mx, q[e]);
                float den = 0.f;
#pragma unroll
                for (int e = 0; e < 16; ++e) den += expf(q[e] - mx);
                float bestg = -3e38f; int bg = 0;
#pragma unroll
                for (int gI = 0; gI < 4; ++gI) { float a = -3e38f, b2 = -3e38f;
#pragma unroll
                    for (int j = 0; j < 4; ++j) { const float s = expf(q[gI * 4 + j] - mx) / den + p.router_b[gI * 4 + j]; if (s > a) { b2 = a; a = s; } else if (s > b2) b2 = s; }
                    if (a + b2 > bestg) { bestg = a + b2; bg = gI; } }
                float a = -3e38f, b2 = -3e38f; int ia = 0, ib = 0;
#pragma unroll
                for (int j = 0; j < 4; ++j) { const float s = expf(q[bg * 4 + j] - mx) / den + p.router_b[bg * 4 + j];
                    if (s > a) { b2 = a; ib = ia; a = s; ia = j; } else if (s > b2) { b2 = s; ib = j; } }
                const float p0 = expf(q[bg * 4 + ia] - mx) / den, p1 = expf(q[bg * 4 + ib] - mx) / den;
                const float w0 = p0 / (p0 + p1), w1 = p1 / (p0 + p1);
                const int lo = ia < ib ? ia : ib, hi = ia < ib ? ib : ia;
                wa = ia < ib ? w0 : w1; wb = ia < ib ? w1 : w0;
                const int pairidx = lo == 0 ? hi - 1 : (lo == 1 ? hi + 1 : 5);
                cls = bg * 6 + pairidx;
                rank = atomicAdd((int*)&lcnt[cls], 1);
                Rout r; r.e0 = bg * 4 + ia; r.e1 = bg * 4 + ib; r.w0 = w0; r.w1 = w1; WSP(Rout, WS_ROUT)[row] = r;
            }
            __syncthreads();
            if (tid < 24) { const int c = lcnt[tid]; lcnt[24 + tid] = c ? atomicAdd(WSP(int, WS_CTL) + CW_CNT + cbank * 64 + tid, c) : 0; }
            __syncthreads();
            if (lane < 16) { const int slot = lcnt[24 + cls] + rank; WSP(int, WS_CTOK)[(size_t)cls * M + slot] = (int)row; float* wp = WSP(float, WS_CWT) + ((size_t)cls * M + slot) * 2; wp[0] = wa; wp[1] = wb; }
            __syncthreads();
            if (tid < 24) lcnt[tid] = 0;
            __syncthreads();
        }
    }
}

__device__ __forceinline__ void gl_tail(const P& p, int l) {
    const int tid = tid_fresh(), lane = tid & 63, wave = tid >> 6, fr = lane & 15, fq = lane >> 4;
    const bf16* H = WSP(bf16, WS_H); const bf16* W = WSP(bf16, WS_WGL_T) + (size_t)l * 32 * D; float* GL = WSP(float, WS_GL);
    for (int rt = bid_fresh() * 8 + wave; rt < M / 16; rt += grid_fresh() * 8) {
        pg8::f32x4 acc0 = {0.f, 0.f, 0.f, 0.f}, acc1 = {0.f, 0.f, 0.f, 0.f};
        const bf16* ap = H + (size_t)(rt * 16 + fr) * D + fq * 8; const bf16* bp0 = W + (size_t)fr * D + fq * 8; const bf16* bp1 = W + (size_t)(16 + fr) * D + fq * 8;
#pragma unroll 8
        for (int s = 0; s < 32; ++s) { const s16x8_t a = *(const s16x8_t*)(ap + s * 32), b0 = *(const s16x8_t*)(bp0 + s * 32), b1 = *(const s16x8_t*)(bp1 + s * 32);
            acc0 = __builtin_amdgcn_mfma_f32_16x16x32_bf16(a, b0, acc0, 0, 0, 0); acc1 = __builtin_amdgcn_mfma_f32_16x16x32_bf16(a, b1, acc1, 0, 0, 0); }
#pragma unroll
        for (int r = 0; r < 4; ++r) { const long m = (long)rt * 16 + 4 * fq + r; GL[m * 24 + fr] = acc0[r]; if (fr < 8) GL[m * 24 + 16 + fr] = acc1[r]; }
    }
}

struct EpiZ {
    static constexpr bool PERM = true, AFTER_DRAIN = false;
    const P* pp; int l;
    __device__ __forceinline__ void operator()(const pg8::f32x4 (&acc)[2][2][4][2], const pg8::Unit& u, int wr, int wc, int fr, int fq) const {
        const P& p = *pp; bf16* Z = WSP(bf16, WS_Z); const bf16* CSB = WSP(bf16, WS_CSB);
        const int pn = u.pn;
        int mode = 0; float scale = 1.f; const float* gain = nullptr;
        if (pn == 0) mode = 1; else if (pn == 1) { mode = 1; scale = 0.125f; } else if (pn == 3) mode = 3; else if (pn == 4 || pn == 5) mode = 4;
        else if (pn == 6 || pn == 7) { mode = 2; scale = 0.125f; gain = p.nsa_q_norm_g + l * 64; }
        else if (pn == 9 && wc < 2) { mode = 2; gain = p.nsa_k_norm_g + (l * 3 + 1) * 64; }
        else if (pn == 10 && wc < 2) { mode = 2; gain = p.nsa_k_norm_g + (l * 3 + 2) * 64; }
        float g0[8], g1[8];
        if (mode == 2) {
#pragma unroll
            for (int j = 0; j < 8; ++j) { g0[j] = gain[8 * fq + j] * scale; g1[j] = gain[32 + 8 * fq + j] * scale; } }
        else {
#pragma unroll
            for (int j = 0; j < 8; ++j) { g0[j] = scale; g1[j] = scale; } }
        const int row0 = u.pm * 256 + wr * 64 + fr + (u.half == 2 ? 128 : 0), col0 = pn * 256 + wc * 64 + 8 * fq;
        float posf[2][4], frq[8];
        if (mode == 1 || mode == 2) {
#pragma unroll
            for (int ai = 0; ai < 2; ++ai)
#pragma unroll
                for (int m = 0; m < 4; ++m) posf[ai][m] = (float)p.pos[row0 + (u.half ? 0 : ai * 128) + m * 16];
#pragma unroll
            for (int j = 0; j < 8; ++j) frq[j] = invfreq(8 * fq + j) * 0.15915494309189535f; }
#pragma unroll
        for (int ai = 0; ai < 2; ++ai) { if (ai == 1 && u.half) continue;
#pragma unroll
         for (int mp = 0; mp < 2; ++mp) {
#pragma unroll
            for (int mm = 0; mm < 2; ++mm) { const int m = 2 * mp + mm; const long row = row0 + ai * 128 + m * 16;
                float a[8], b[8];
#pragma unroll
                for (int j = 0; j < 4; ++j) { a[j] = acc[ai][0][m][0][j]; a[4 + j] = acc[ai][0][m][1][j]; b[j] = acc[ai][1][m][0][j]; b[4 + j] = acc[ai][1][m][1][j]; }
                if (mode == 1 || mode == 2) {
                    float r = 1.f;
                    if (mode == 2) { float ss = 0.f;
#pragma unroll
                        for (int j = 0; j < 8; ++j) ss += a[j] * a[j] + b[j] * b[j];
                        ss += __shfl_xor(ss, 16); ss += __shfl_xor(ss, 32); r = __builtin_amdgcn_rsqf(ss * (1.f / 64.f) + EPS); }
#pragma unroll
                    for (int j = 0; j < 8; ++j) { const float tr = __builtin_amdgcn_fractf(posf[ai][m] * frq[j]); const float cs = __builtin_amdgcn_cosf(tr), sn = __builtin_amdgcn_sinf(tr);
                        const float x1 = a[j] * r * g0[j], x2 = b[j] * r * g1[j];
                        a[j] = x1 * cs - x2 * sn; b[j] = x1 * sn + x2 * cs; } }
                else if (mode == 3) {
#pragma unroll
                    for (int j = 0; j < 8; ++j) { a[j] = silu_fast(a[j]); b[j] = silu_fast(b[j]); } }
                else if (mode == 4) {
#pragma unroll
                    for (int j = 0; j < 8; ++j) { a[j] = gelu_fast(a[j]); b[j] = gelu_fast(b[j]); } }
                pg8::u32x4 wa, wb;
                wa.x = pk_bf16(a[0], a[1]); wa.y = pk_bf16(a[2], a[3]); wa.z = pk_bf16(a[4], a[5]); wa.w = pk_bf16(a[6], a[7]);
                wb.x = pk_bf16(b[0], b[1]); wb.y = pk_bf16(b[2], b[3]); wb.z = pk_bf16(b[4], b[5]); wb.w = pk_bf16(b[6], b[7]);
                *(pg8::u32x4*)(Z + row * ZW + col0) = wa; *(pg8::u32x4*)(Z + row * ZW + col0 + 32) = wb; } } }
    }
};
typedef short s16x4_t __attribute__((ext_vector_type(4)));
typedef float f32x4m __attribute__((ext_vector_type(4)));
#define MFMA16(a, b, c) __builtin_amdgcn_mfma_f32_16x16x32_bf16((a), (b), (c), 0, 0, 0)
constexpr int LP = 144;
__device__ __forceinline__ s16x4_t lds_tr4(LAS const unsigned char* p) { return __builtin_bit_cast(s16x4_t, __builtin_amdgcn_ds_read_tr16_b64_v4i16((LAS s16x4_t*)p)); }
__device__ __forceinline__ s16x8_t tr_frag(LAS const unsigned char* X, int P, int k0, int c0, int lane) {
    const int fq = lane >> 4, q = (lane & 15) >> 2, pp = lane & 3;
    LAS const unsigned char* a = X + (k0 + 8 * fq + q) * P + (c0 + 4 * pp) * 2;
    const s16x4_t lo = lds_tr4(a), hi = lds_tr4(a + 4 * P);
    return (s16x8_t){lo[0], lo[1], lo[2], lo[3], hi[0], hi[1], hi[2], hi[3]};
}
__device__ __forceinline__ s16x8_t tr_frag_perm(LAS const unsigned char* X, int P, int k0, int c0, int lane) {
    const int fq = lane >> 4, q = (lane & 15) >> 2, pp = lane & 3;
    LAS const unsigned char* a = X + (k0 + 4 * fq + q) * P + (c0 + 4 * pp) * 2;
    const s16x4_t lo = lds_tr4(a), hi = lds_tr4(a + 16 * P);
    return (s16x8_t){lo[0], lo[1], lo[2], lo[3], hi[0], hi[1], hi[2], hi[3]};
}
__device__ __forceinline__ s16x8_t pack8(const f32x4m& a, const f32x4m& b) {
    const unsigned w0 = pk_bf16(a[0], a[1]), w1 = pk_bf16(a[2], a[3]), w2 = pk_bf16(b[0], b[1]), w3 = pk_bf16(b[2], b[3]);
    return __builtin_bit_cast(s16x8_t, (u32x4_t){w0, w1, w2, w3});
}
__device__ __forceinline__ float bflo(unsigned u) { return __builtin_bit_cast(float, u << 16); }
__device__ __forceinline__ float bfhi(unsigned u) { return __builtin_bit_cast(float, u & 0xffff0000u); }

struct CmpSched {
    static constexpr bool GATHER = false; static constexpr int GOFF_LDS = 0;
    const P* pp; int l, c;
    __device__ __forceinline__ bool next(int i, pg8::Unit& u) const { if (i > 0 || c >= 32) return false; u.pm = c & 7; u.pn = 0; u.aux = c >> 3; u.half = 0; return true; }
    __device__ __forceinline__ int ktiles() const { return 16; }
    __device__ __forceinline__ const char* a_base() const { return (const char*)(pp->ws + WS_Z); }
    __device__ __forceinline__ size_t a_kstep() const { return (size_t)ZW * 2; }
    __device__ __forceinline__ unsigned a_off(const pg8::Unit& u, int row, int C) const {
        const int R = u.pm * 256 + row, kv = u.aux & 1, g = u.aux >> 1;
        return (unsigned)(((size_t)R * 16 * ZW + (kv ? C_VC : C_KC) + g * 64 + C) * 2); }
    __device__ __forceinline__ unsigned b_ld() const { return 1024 * 2u; }
    __device__ __forceinline__ const char* b_tile(const pg8::Unit& u, int t) const { return (const char*)(pp->ws + WS_CW1_T) + (size_t)(l * 2 + (u.aux & 1)) * 256 * 1024 * 2 + (size_t)t * 128; }
};
struct EpiCmp {
    static constexpr bool PERM = false, AFTER_DRAIN = true;
    const P* pp; int l;
    __device__ __forceinline__ void operator()(const pg8::f32x4 (&)[2][2][4][2], const pg8::Unit&, int, int, int, int) const {}
    __device__ __forceinline__ void fused(const pg8::f32x4 (&acc)[2][2][4][2], const pg8::Unit& u, int wr, int wc, int fr, int fq, LAS unsigned char* lds) const {
        const P& p = *pp; const int kv = u.aux & 1, g = u.aux >> 1, lane = tid_fresh() & 63, w = tid_fresh() >> 6;
        constexpr int HP = 272;
        constexpr int HOFF = 257 * HP;
        const float* bias = WSP(float, WS_PEB) + (l * 2 + kv) * 128;
#pragma unroll
        for (int n = 0; n < 2; ++n) { const int c = 32 * wc + 16 * n + 4 * fq;
#pragma unroll
            for (int ai = 0; ai < 2; ++ai)
#pragma unroll
                for (int m = 0; m < 4; ++m) { const int r = 128 * ai + 64 * wr + 16 * m + fr; const f32x4m v = acc[ai][1][m][n];
                    u32x2_t o; o.x = pk_bf16(v[0], v[1]); o.y = pk_bf16(v[2], v[3]); *(LAS u32x2_t*)(lds + r * HP + c * 2) = o; } }
        if (tid_fresh() < 32) { unsigned zz = 0u; asm volatile("" : "+v"(zz)); *(LAS u32x2_t*)(lds + 256 * HP + tid_fresh() * 8) = (u32x2_t){zz, zz}; }
        __syncthreads();
#pragma unroll
        for (int n = 0; n < 2; ++n) { const int c = 32 * wc + 16 * n + 4 * fq; const f32x4m bv = *(const f32x4m*)(bias + c);
#pragma unroll
            for (int ai = 0; ai < 2; ++ai)
#pragma unroll
                for (int m = 0; m < 4; ++m) { const int r = 128 * ai + 64 * wr + 16 * m + fr; const u32x2_t u1 = *(const LAS u32x2_t*)(lds + (r + 1) * HP + c * 2);
                    const f32x4m v = acc[ai][0][m][n] + bv + (f32x4m){bflo(u1.x), bfhi(u1.x), bflo(u1.y), bfhi(u1.y)};
                    u32x2_t o; o.x = pk_bf16(gelu_fast(v[0]), gelu_fast(v[1])); o.y = pk_bf16(gelu_fast(v[2]), gelu_fast(v[3])); *(LAS u32x2_t*)(lds + HOFF + r * HP + c * 2) = o; } }
        __syncthreads();
        const bf16* W2 = WSP(bf16, WS_CW2_T) + (size_t)(l * 2 + kv) * 64 * 128;
        const float* gk = p.nsa_k_norm_g + (l * 3 + 0) * 64;
#pragma unroll
        for (int rt = 0; rt < 2; ++rt) {
            f32x4m o[4];
#pragma unroll
            for (int ct = 0; ct < 4; ++ct) o[ct] = (f32x4m){0.f, 0.f, 0.f, 0.f};
#pragma unroll
            for (int s = 0; s < 4; ++s) { const s16x8_t a = *(const LAS s16x8_t*)(lds + HOFF + (32 * w + 16 * rt + fr) * HP + (32 * s + 8 * fq) * 2);
#pragma unroll
                for (int ct = 0; ct < 4; ++ct) { const s16x8_t b = *(const s16x8_t*)(W2 + (16 * ct + fr) * 128 + 32 * s + 8 * fq); o[ct] = MFMA16(a, b, o[ct]); } }
            float csv[4][4];
            if (kv == 0) {
#pragma unroll
                for (int reg = 0; reg < 4; ++reg) { const int R = u.pm * 256 + 32 * w + 16 * rt + 4 * fq + reg, b = R >> 7, n = R & 127, nn = n < NCMP ? n : NCMP - 1;
                    const float* cs = WSP(float, WS_CS) + ((size_t)b * NS + 16 * nn + 31) * 64; csv[reg][0] = cs[fr]; csv[reg][1] = cs[32 + fr]; csv[reg][2] = cs[16 + fr]; csv[reg][3] = cs[48 + fr]; } }
#pragma unroll
            for (int reg = 0; reg < 4; ++reg) { const int R = u.pm * 256 + 32 * w + 16 * rt + 4 * fq + reg, b = R >> 7, n = R & 127;
                float v0 = o[0][reg], v1 = o[1][reg], v2 = o[2][reg], v3 = o[3][reg];
                if (kv == 0) { float ss = v0 * v0 + v1 * v1 + v2 * v2 + v3 * v3;
                    ss += __shfl_xor(ss, 1); ss += __shfl_xor(ss, 2); ss += __shfl_xor(ss, 4); ss += __shfl_xor(ss, 8);
                    const float r = 1.0f / sqrtf(ss * (1.f / 64.f) + EPS);
                    v0 *= r * gk[fr]; v1 *= r * gk[16 + fr]; v2 *= r * gk[32 + fr]; v3 *= r * gk[48 + fr];
                    const float c0 = csv[reg][0], s0 = csv[reg][1], c1 = csv[reg][2], s1 = csv[reg][3];
                    const float a0 = v0 * c0 - v2 * s0, a2 = v0 * s0 + v2 * c0, a1 = v1 * c1 - v3 * s1, a3 = v1 * s1 + v3 * c1; v0 = a0; v1 = a1; v2 = a2; v3 = a3; }
                { if (n >= NCMP) { v0 = 0.f; v1 = 0.f; v2 = 0.f; v3 = 0.f; }
                    bf16* dst = (kv ? WSP(bf16, WS_VC) : WSP(bf16, WS_KC)) + ((size_t)(b * 2 + g) * (NCMP + 1) + n) * 64;
                    dst[fr] = f2bf(v0); dst[16 + fr] = f2bf(v1); dst[32 + fr] = f2bf(v2); dst[48 + fr] = f2bf(v3); } }
        }
        __syncthreads();
    }
};
__device__ __forceinline__ void ret_kv_unit(const P& p, LAS unsigned char* lds, int l, int unit) {
    const int tid = tid_fresh(), lane = tid & 63, w = tid >> 6, fr = lane & 15, fq = lane >> 4;
    const int c = unit % NCH, h = (unit / NCH) % 4, b = unit / (NCH * 4);
    const bf16* Z = WSP(bf16, WS_Z); const size_t m0 = (size_t)b * NS + (size_t)c * 128;
    const float lg2 = log2f(1.f - exp2f(-5.f - (float)h));
    LAS unsigned char* KL = lds; LAS unsigned char* VL = lds + 128 * LP;
#pragma unroll
    for (int i = 0; i < 2; ++i) { const int pc = tid + i * NTH, r = pc >> 3, q = pc & 7;
        const u32x4_t kw = *(const u32x4_t*)(Z + (m0 + r) * ZW + C_RK + 64 * h + q * 8), vw = *(const u32x4_t*)(Z + (m0 + r) * ZW + C_RV + 64 * h + q * 8);
        const float dk = exp2f((float)(127 - r) * lg2); u32x4_t ko;
#pragma unroll
        for (int j = 0; j < 4; ++j) ko[j] = pk_bf16(bflo(kw[j]) * dk, bfhi(kw[j]) * dk);
        *(LAS u32x4_t*)(KL + r * LP + q * 16) = ko; *(LAS u32x4_t*)(VL + r * LP + q * 16) = vw; }
    __syncthreads();
    const int et = w >> 1, d0 = 2 * (w & 1);
    f32x4m a0 = {0.f, 0.f, 0.f, 0.f}, a1 = {0.f, 0.f, 0.f, 0.f};
#pragma unroll
    for (int ks = 0; ks < 4; ++ks) { const s16x8_t va = tr_frag(VL, LP, 32 * ks, 16 * et, lane);
        a0 = MFMA16(va, tr_frag(KL, LP, 32 * ks, 16 * d0, lane), a0); a1 = MFMA16(va, tr_frag(KL, LP, 32 * ks, 16 * (d0 + 1), lane), a1); }
    float* KV = WSP(float, WS_KVS) + (size_t)unit * 4096;
#pragma unroll
    for (int reg = 0; reg < 4; ++reg) { const int e = 16 * et + 4 * fq + reg; KV[e * 64 + 16 * d0 + fr] = a0[reg]; KV[e * 64 + 16 * (d0 + 1) + fr] = a1[reg]; }
    __syncthreads();
}

__device__ __forceinline__ void ret_out_unit(const P& p, LAS unsigned char* lds, int l, int unit) {
    const int tid = tid_fresh(), lane = tid & 63, w = tid >> 6, fr = lane & 15, fq = lane >> 4;
    const int c = unit % NCH, h = (unit / NCH) % 4, b = unit / (NCH * 4);
    const bf16* Z = WSP(bf16, WS_Z); bf16* MIX = WSP(bf16, WS_MIX); const size_t m0 = (size_t)b * NS + (size_t)c * 128;
    const float lg2 = log2f(1.f - exp2f(-5.f - (float)h));
    LAS unsigned char* KL = lds; LAS unsigned char* VL = lds + 128 * LP; LAS unsigned char* ST = lds + 256 * LP;
#pragma unroll
    for (int i = 0; i < 2; ++i) { const int pc = tid + i * NTH, r = pc >> 3, q = pc & 7;
        *(LAS u32x4_t*)(KL + r * LP + q * 16) = *(const u32x4_t*)(Z + (m0 + r) * ZW + C_RK + 64 * h + q * 8);
        *(LAS u32x4_t*)(VL + r * LP + q * 16) = *(const u32x4_t*)(Z + (m0 + r) * ZW + C_RV + 64 * h + q * 8); }
    {
        const float lgc = 128.f * lg2; const float* KV = WSP(float, WS_KVS) + (size_t)(unit - c) * 4096 + tid * 8;
        f32x4m s0 = {0.f, 0.f, 0.f, 0.f}, s1 = {0.f, 0.f, 0.f, 0.f};
        f32x4m ld0[NCH - 1], ld1[NCH - 1];
#pragma unroll
        for (int cc = 0; cc < NCH - 1; ++cc) { ld0[cc] = *(const f32x4m*)(KV + (size_t)cc * 4096); ld1[cc] = *(const f32x4m*)(KV + (size_t)cc * 4096 + 4); }
#pragma unroll
        for (int cc = 0; cc < NCH - 1; ++cc) { const float wgt = cc < c ? __builtin_amdgcn_exp2f((float)(c - 1 - cc) * lgc) : 0.f; s0 += ld0[cc] * wgt; s1 += ld1[cc] * wgt; }
        const int e = tid >> 3, d = (tid & 7) * 8; u32x4_t o; o.x = pk_bf16(s0[0], s0[1]); o.y = pk_bf16(s0[2], s0[3]); o.z = pk_bf16(s1[0], s1[1]); o.w = pk_bf16(s1[2], s1[3]);
        *(LAS u32x4_t*)(ST + e * LP + d * 2) = o; }
    __syncthreads();
    const size_t mq = m0 + 16 * w + fr; const int nq = 16 * w + fr;
    s16x8_t qf[2];
#pragma unroll
    for (int s = 0; s < 2; ++s) qf[s] = *(const s16x8_t*)(Z + mq * ZW + C_RQ + 64 * h + 32 * s + 8 * fq);
    f32x4m O[4];
#pragma unroll
    for (int dt = 0; dt < 4; ++dt) O[dt] = (f32x4m){0.f, 0.f, 0.f, 0.f};
    for (int ks = 0; ks <= (w >> 1); ++ks) {
        f32x4m S2[2];
#pragma unroll
        for (int t = 0; t < 2; ++t) { const int kt = 2 * ks + t; f32x4m sacc = {0.f, 0.f, 0.f, 0.f};
#pragma unroll
            for (int s = 0; s < 2; ++s) sacc = MFMA16(*(const LAS s16x8_t*)(KL + (16 * kt + fr) * LP + (32 * s + 8 * fq) * 2), qf[s], sacc);
#pragma unroll
            for (int reg = 0; reg < 4; ++reg) { const int kk = 16 * kt + 4 * fq + reg; sacc[reg] = kk <= nq ? sacc[reg] * __builtin_amdgcn_exp2f((float)(nq - kk) * lg2) : 0.f; }
            S2[t] = sacc; }
        const s16x8_t pf = pack8(S2[0], S2[1]);
#pragma unroll
        for (int dt = 0; dt < 4; ++dt) O[dt] = MFMA16(tr_frag_perm(VL, LP, 32 * ks, 16 * dt, lane), pf, O[dt]);
    }
    { const float dq = exp2f((float)(nq + 1) * lg2);
#pragma unroll
      for (int dt = 0; dt < 4; ++dt) { f32x4m t = {0.f, 0.f, 0.f, 0.f};
#pragma unroll
          for (int s = 0; s < 2; ++s) t = MFMA16(*(const LAS s16x8_t*)(ST + (16 * dt + fr) * LP + (32 * s + 8 * fq) * 2), qf[s], t);
          O[dt] += t * dq; } }
    float ss = 0.f;
#pragma unroll
    for (int dt = 0; dt < 4; ++dt) ss += O[dt][0] * O[dt][0] + O[dt][1] * O[dt][1] + O[dt][2] * O[dt][2] + O[dt][3] * O[dt][3];
    ss += __shfl_xor(ss, 16); ss += __shfl_xor(ss, 32);
    const float r = 1.0f / sqrtf(ss * (1.f / 64.f) + EPS);
    f32x4m gnv[4]; u32x2_t rgv[4];
#pragma unroll
    for (int dt = 0; dt < 4; ++dt) { const int e = 16 * dt + 4 * fq; gnv[dt] = *(const f32x4m*)(p.ret_norm_g + (l * 4 + h) * 64 + e); rgv[dt] = *(const u32x2_t*)(Z + mq * ZW + C_RG + 64 * h + e); }
#pragma unroll
    for (int dt = 0; dt < 4; ++dt) { const int e = 16 * dt + 4 * fq; const f32x4m gn = gnv[dt];
        const u32x2_t rg = rgv[dt];
        u32x2_t o; o.x = pk_bf16(O[dt][0] * r * gn[0] * bflo(rg.x), O[dt][1] * r * gn[1] * bfhi(rg.x)); o.y = pk_bf16(O[dt][2] * r * gn[2] * bflo(rg.y), O[dt][3] * r * gn[3] * bfhi(rg.y));
        *(u32x2_t*)(MIX + mq * D + 64 * h + e) = o; }
    __syncthreads();
}
__device__ __forceinline__ void gmlp_unit(const P& p, LAS unsigned char* lds, int l, int unit) {
    const int tid = tid_fresh(), lane = tid & 63, w = tid >> 6, fr = lane & 15, fq = lane >> 4;
    const bf16* Z = WSP(bf16, WS_Z); bf16* MIX = WSP(bf16, WS_MIX); const size_t m0 = (size_t)unit * 128;
    constexpr int VP = 528;
    { const int r = tid >> 2, q = tid & 3; const bf16* src = Z + (m0 + r) * ZW + C_GV + q * 64;
      u32x4_t v[8]; float s = 0.f;
#pragma unroll
      for (int i = 0; i < 8; ++i) { v[i] = *(const u32x4_t*)(src + i * 8);
#pragma unroll
          for (int j = 0; j < 4; ++j) s += bflo(v[i][j]) + bfhi(v[i][j]); }
      s += __shfl_xor(s, 1); s += __shfl_xor(s, 2); const float mu = s * (1.f / 256.f); float s2 = 0.f;
#pragma unroll
      for (int i = 0; i < 8; ++i)
#pragma unroll
          for (int j = 0; j < 4; ++j) { const float a = bflo(v[i][j]) - mu, b2 = bfhi(v[i][j]) - mu; s2 += a * a + b2 * b2; }
      s2 += __shfl_xor(s2, 1); s2 += __shfl_xor(s2, 2); const float rstd = 1.0f / sqrtf(s2 * (1.f / 256.f) + EPS);
      const float* gl = p.gmlp_ln_g + l * 256 + q * 64;
#pragma unroll
      for (int i = 0; i < 8; ++i) { u32x4_t o;
#pragma unroll
          for (int j = 0; j < 4; ++j) o[j] = pk_bf16((bflo(v[i][j]) - mu) * rstd * gl[i * 8 + 2 * j], (bfhi(v[i][j]) - mu) * rstd * gl[i * 8 + 2 * j + 1]);
          *(LAS u32x4_t*)(lds + r * VP + (q * 64 + i * 8) * 2) = o; } }
    __syncthreads();
    const int t0 = 16 * w, nks = (w >> 1) + 1;
    constexpr int SOFF = 128 * VP;
    LAS unsigned char* ST = lds + SOFF + w * 16 * VP;
    s16x8_t wf[4][4];
#pragma unroll
    for (int g = 0; g < 4; ++g)
#pragma unroll
        for (int ks = 0; ks < 4; ++ks) wf[g][ks] = ks < nks ? *(const s16x8_t*)(WSP(bf16, WS_GWS) + (size_t)(l * 4 + g) * 128 * 128 + (t0 + fr) * 128 + 32 * ks + 8 * fq) : (s16x8_t){0, 0, 0, 0, 0, 0, 0, 0};
    float bsv[4][4];
#pragma unroll
    for (int g = 0; g < 4; ++g)
#pragma unroll
        for (int reg = 0; reg < 4; ++reg) bsv[g][reg] = p.gmlp_b[(l * 4 + g) * 128 + t0 + 4 * fq + reg];
    const int orow = lane >> 2, oseg = lane & 3; u32x4_t uv[8];
#pragma unroll
    for (int k = 0; k < 8; ++k) uv[k] = *(const u32x4_t*)(Z + (m0 + t0 + orow) * ZW + C_GU + 64 * oseg + 8 * k);
#pragma unroll
    for (int g = 0; g < 4; ++g) {
        f32x4m acc[4];
#pragma unroll
        for (int ct = 0; ct < 4; ++ct) acc[ct] = (f32x4m){0.f, 0.f, 0.f, 0.f};
#pragma unroll
        for (int ks = 0; ks < 4; ++ks) { if (ks < nks) {
#pragma unroll
            for (int ct = 0; ct < 4; ++ct) acc[ct] = MFMA16(wf[g][ks], tr_frag(lds, VP, 32 * ks, 64 * g + 16 * ct, lane), acc[ct]); } }
#pragma unroll
        for (int reg = 0; reg < 4; ++reg)
#pragma unroll
            for (int ct = 0; ct < 4; ++ct) *(LAS bf16*)(ST + (4 * fq + reg) * VP + (64 * g + 16 * ct + fr) * 2) = f2bf(acc[ct][reg] + bsv[g][reg]);
    }
#pragma unroll
    for (int k = 0; k < 8; ++k) { const u32x4_t sv = *(const LAS u32x4_t*)(ST + orow * VP + (64 * oseg + 8 * k) * 2); u32x4_t o;
#pragma unroll
        for (int q = 0; q < 4; ++q) o[q] = pk_bf16(bflo(uv[k][q]) * bflo(sv[q]), bfhi(uv[k][q]) * bfhi(sv[q]));
        *(u32x4_t*)(MIX + (m0 + t0 + orow) * D + 256 + 64 * oseg + 8 * k) = o; }
    __syncthreads();
}
__device__ __forceinline__ void premix_phase(const P& p, LAS unsigned char* lds, int l) {
    { CmpSched S; S.pp = &p; S.l = l; S.c = bid_fresh(); EpiCmp E{&p, l}; pg8::gemm_phase(lds, S, E); }
    const int G = grid_fresh(), bx = bid_fresh();
    if (G > 64) { if (bx >= 32) { for (int u = bx - 32; u < NB * 4 * NCH; u += G - 32) ret_kv_unit(p, lds, l, u); for (int u = bx - 32; u < NB * NCH; u += G - 32) gmlp_unit(p, lds, l, u); } }
    else { for (int u = bx; u < NB * 4 * NCH; u += G) ret_kv_unit(p, lds, l, u); for (int u = bx; u < NB * NCH; u += G) gmlp_unit(p, lds, l, u); }
}

__device__ __forceinline__ s16x8_t tr_frag_perm_swz(LAS const unsigned char* X, int k0, int c0, int lane) {
    const int fq = lane >> 4, q = (lane & 15) >> 2, pp = lane & 3, row = k0 + 4 * fq + q, col = c0 + 4 * pp;
    LAS const unsigned char* a = X + row * 128 + ((((col >> 3) ^ (row & 7))) << 4) + (col & 7) * 2;
    const s16x4_t lo = lds_tr4(a), hi = lds_tr4(a + 16 * 128);
    return (s16x8_t){lo[0], lo[1], lo[2], lo[3], hi[0], hi[1], hi[2], hi[3]};
}
constexpr int NSA_KV = 2 * 64 * 128;
constexpr int NSA_IMP = 4 * NSA_KV, NSA_INVL = NSA_IMP + 8 * 8192, NSA_SELM = NSA_INVL + 64 * 4 * 4;
static_assert(NSA_SELM + 256 <= 147456 - 64, "NSA LDS map");
__device__ __forceinline__ void nsa_unit(const P& p, LAS unsigned char* lds, int l, int b, int g, int i) {
    const int tid = tid_fresh(), lane = tid & 63, w = tid >> 6, fr = lane & 15, fq = lane >> 4;
    const bf16* Z = WSP(bf16, WS_Z); bf16* MIX = WSP(bf16, WS_MIX); const float* GL = WSP(float, WS_GL);
    const size_t mb = (size_t)b * NS;
    const int nc = (i >= 16) ? 2 : 1, wlo = i > 8 ? i - 8 : 0, nblk = nc + (i + 1) + (i - wlo + 1);
    LAS float* IMPH = (LAS float*)(lds + NSA_IMP + w * 8192); LAS float* INVL = (LAS float*)(lds + NSA_INVL); LAS unsigned* SELM = (LAS unsigned*)(lds + NSA_SELM);
    LAS f32x4m* OFL = (LAS f32x4m*)(lds + NSA_IMP + w * 8192 + lane * 16);
    int tok[2]; s16x8_t qf[2][2];
#pragma unroll
    for (int qt = 0; qt < 2; ++qt) { tok[qt] = 8 * w + 4 * qt + (fr >> 2);
#pragma unroll
        for (int s = 0; s < 2; ++s) qf[qt][s] = *(const s16x8_t*)(Z + (mb + 64 * i + tok[qt]) * ZW + C_NQ + 64 * (4 * g + (fr & 3)) + 32 * s + 8 * fq); }
    f32x4m O[2][4]; float lsum[2] = {0.f, 0.f}; float carry[2] = {0.f, 0.f}; unsigned selm[2] = {0u, 0u};
#pragma unroll
    for (int qt = 0; qt < 2; ++qt)
#pragma unroll
        for (int dt = 0; dt < 4; ++dt) O[qt][dt] = (f32x4m){0.f, 0.f, 0.f, 0.f};
    const int skey = tid >> 3, spx = (tid & 7) ^ (skey & 7);
    auto kv_ptrs = [&](int it, const bf16*& kp, const bf16*& vp) {
        if (it < nc) { const size_t o = ((size_t)(b * 2 + g) * (NCMP + 1) + 64 * it + skey) * 64 + spx * 8; kp = WSP(bf16, WS_KC) + o; vp = WSP(bf16, WS_VC) + o; }
        else if (it < nc + i + 1) { const size_t o = (mb + 64 * (it - nc) + skey) * ZW + 64 * g + spx * 8; kp = Z + o + C_KS; vp = Z + o + C_VS; }
        else { const size_t o = (mb + 64 * (wlo + it - nc - i - 1) + skey) * ZW + 64 * g + spx * 8; kp = Z + o + C_KW; vp = Z + o + C_VW; } };
    asm volatile("" : "+v"(qf[0][0]), "+v"(qf[0][1]), "+v"(qf[1][0]), "+v"(qf[1][1]));
    float bnd_c = WSP(float, WS_BND)[l * 3 + 0], bnd_s = WSP(float, WS_BND)[l * 3 + 1], bnd_w = WSP(float, WS_BND)[l * 3 + 2];
    asm volatile("" : "+v"(bnd_c), "+v"(bnd_s), "+v"(bnd_w));
#define NSA_DMA(IT, BUF) do { const bf16 *kp_, *vp_; kv_ptrs((IT), kp_, vp_); \
        const unsigned lb_ = (unsigned)__builtin_amdgcn_readfirstlane((int)((unsigned)(size_t)lds + (unsigned)((BUF) * NSA_KV) + (unsigned)w * 1024u)); unsigned sv_; \
        asm volatile("s_mov_b32 %0, m0\n\ts_mov_b32 m0, %3\n\ts_nop 0\n\tglobal_load_lds_dwordx4 %1, off\n\ts_add_u32 m0, m0, 0x2000\n\ts_nop 0\n\tglobal_load_lds_dwordx4 %2, off\n\ts_mov_b32 m0, %0" \
                     : "=&s"(sv_) : "v"(kp_), "v"(vp_), "s"(lb_) : "memory"); } while (0)
    __syncthreads();
    NSA_DMA(0, 0);
    if (nblk > 1) NSA_DMA(1, 1);
    asm volatile("s_waitcnt vmcnt(0)" ::: "memory");
    __builtin_amdgcn_s_barrier(); asm volatile("" ::: "memory");
#pragma unroll 1
    for (int it = 0; it < nblk; ++it) {
        const int bufc = it & 3;
        if ((it & 1) == 0) { if (it + 2 < nblk) NSA_DMA(it + 2, (it + 2) & 3); if (it + 3 < nblk) NSA_DMA(it + 3, (it + 3) & 3); }
        LAS const unsigned char* Kb = lds + bufc * NSA_KV; LAS const unsigned char* Vb = Kb + 8192;
        const int br = it < nc ? 0 : (it < nc + i + 1 ? 1 : 2);
        const int j = br == 0 ? it : (br == 1 ? it - nc : wlo + it - nc - i - 1);
        const float bnd = br == 0 ? bnd_c : (br == 1 ? bnd_s : bnd_w);
        const bool needmask = (br == 0) || (j == i) || (br == 2 && j == i - 8);
        const bool lower = (br == 2 && j == i - 8);
        bool rowok[2]; int thr[2]; float oa[2], ob[2];
#pragma unroll
        for (int qt = 0; qt < 2; ++qt) {
            rowok[qt] = (br == 1) ? (((selm[qt] >> j) & 1u) != 0u) : true;
            thr[qt] = (br == 0) ? ((64 * i + tok[qt] - 31) >> 4) - 64 * j : tok[qt];
            const float on = rowok[qt] ? bnd : 1e30f;
            oa[qt] = lower ? 1e30f : on; ob[qt] = lower ? on : 1e30f; }
        const bool act0 = __ballot(rowok[0]) != 0ull, act1 = __ballot(rowok[1]) != 0ull;
        if (act0 || act1) {
            f32x4m pv[2][4];
#pragma unroll
            for (int qt = 0; qt < 2; ++qt)
#pragma unroll
                for (int kt = 0; kt < 4; ++kt) pv[qt][kt] = (f32x4m){0.f, 0.f, 0.f, 0.f};
#pragma unroll
            for (int sI = 0; sI < 2; ++sI) { s16x8_t kf[4];
#pragma unroll
                for (int kt = 0; kt < 4; ++kt) kf[kt] = *(const LAS s16x8_t*)(Kb + (16 * kt + fr) * 128 + (((4 * sI + fq) ^ (fr & 7)) << 4));
#pragma unroll
                for (int kt = 0; kt < 4; ++kt)
#pragma unroll
                    for (int qt = 0; qt < 2; ++qt) pv[qt][kt] = MFMA16(kf[kt], qf[qt][sI], pv[qt][kt]); }
            s16x8_t vf[2][4];
#pragma unroll
            for (int ks = 0; ks < 2; ++ks)
#pragma unroll
                for (int dt = 0; dt < 4; ++dt) vf[ks][dt] = tr_frag_perm_swz(Vb, 32 * ks, 16 * dt, lane);
#pragma unroll
            for (int qt = 0; qt < 2; ++qt) {
                if (needmask) {
#pragma unroll
                    for (int kt = 0; kt < 4; ++kt)
#pragma unroll
                        for (int reg = 0; reg < 4; ++reg) { const int kk = 16 * kt + 4 * fq + reg; const float off = kk <= thr[qt] ? oa[qt] : ob[qt];
                            pv[qt][kt][reg] = __builtin_amdgcn_exp2f(pv[qt][kt][reg] * 1.4426950408889634f - off); lsum[qt] += pv[qt][kt][reg]; } }
                else {
#pragma unroll
                    for (int kt = 0; kt < 4; ++kt)
#pragma unroll
                        for (int reg = 0; reg < 4; ++reg) { pv[qt][kt][reg] = __builtin_amdgcn_exp2f(pv[qt][kt][reg] * 1.4426950408889634f - oa[qt]); lsum[qt] += pv[qt][kt][reg]; } }
                if (br == 0) {
                    const int src = (lane + 48) & 63;
#pragma unroll
                    for (int kt = 0; kt < 4; ++kt) { const float a4 = pv[qt][kt][0] + pv[qt][kt][1] + pv[qt][kt][2] + pv[qt][kt][3];
                        const float xs = __shfl(pv[qt][kt][3], src), xp = __shfl(kt == 0 ? carry[qt] : pv[qt][kt > 0 ? kt - 1 : 0][3], src);
                        IMPH[((4 * qt + (fr >> 2)) * 4 + (fr & 3)) * 32 + 16 * j + 4 * kt + fq] = a4 + (fq == 0 ? xp : xs); }
                    carry[qt] = pv[qt][3][3]; }
                const s16x8_t pfa = pack8(pv[qt][0], pv[qt][1]), pfb = pack8(pv[qt][2], pv[qt][3]);
#pragma unroll
                for (int dt = 0; dt < 4; ++dt) O[qt][dt] = MFMA16(vf[0][dt], pfa, O[qt][dt]);
#pragma unroll
                for (int dt = 0; dt < 4; ++dt) O[qt][dt] = MFMA16(vf[1][dt], pfb, O[qt][dt]);
                __builtin_amdgcn_sched_barrier(0);
            }
        }
        const bool bend = (it == nc - 1) || (it == nc + i) || (it == nblk - 1);
        if (bend) {
            float scl[2];
#pragma unroll
            for (int qt = 0; qt < 2; ++qt) { float ls = lsum[qt]; ls += __shfl_xor(ls, 16); ls += __shfl_xor(ls, 32);
                const float inv = ls > 0.f ? 1.0f / ls : 0.f;
                const float gate = 1.0f / (1.0f + __expf(-GL[(mb + 64 * i + tok[qt]) * 24 + (4 * g + (fr & 3)) * 3 + br]));
                scl[qt] = gate * inv; lsum[qt] = 0.f;
                if (br == 0 && fq == 0) INVL[tok[qt] * 4 + (fr & 3)] = inv; }
            if (br == 0) {
#pragma unroll 1
                for (int rnd = 0; rnd < 4; ++rnd) { const int tk = 8 * w + 2 * rnd + (lane >> 5), jj = lane & 31;
                    const bool forced = (jj == 0) || (jj == i) || (jj == i - 1);
                    float sc = -1.f;
                    if (jj <= i) { sc = 0.f;
#pragma unroll
                        for (int r = 0; r < 4; ++r) sc += IMPH[((2 * rnd + (lane >> 5)) * 4 + r) * 32 + jj] * INVL[tk * 4 + r]; }
                    if (forced) sc = 1e4f;
                    int rank = 0;
#pragma unroll
                    for (int d = 1; d < 32; ++d) { const int oj = (jj + d) & 31; const float o = __shfl(sc, (lane & 32) | oj); rank += (o > sc || (o == sc && oj < jj)) ? 1 : 0; }
                    const unsigned long long bal = __ballot(rank < 8);
                    if (lane == 0) { SELM[8 * w + 2 * rnd] = (unsigned)bal; SELM[8 * w + 2 * rnd + 1] = (unsigned)(bal >> 32); } }
                selm[0] = SELM[tok[0]]; selm[1] = SELM[tok[1]];
            }
#pragma unroll
            for (int qt = 0; qt < 2; ++qt)
#pragma unroll
                for (int dt = 0; dt < 4; ++dt) { const f32x4m prev = br == 0 ? (f32x4m){0.f, 0.f, 0.f, 0.f} : OFL[(qt * 4 + dt) * 64]; OFL[(qt * 4 + dt) * 64] = prev + O[qt][dt] * scl[qt]; O[qt][dt] = (f32x4m){0.f, 0.f, 0.f, 0.f}; }
        }
        if ((it & 1) || it + 1 == nblk) {
            asm volatile("s_waitcnt vmcnt(0)" ::: "memory");
            asm volatile("s_waitcnt lgkmcnt(0)" ::: "memory");
            __builtin_amdgcn_s_barrier(); asm volatile("" ::: "memory"); }
    }
#undef NSA_DMA
#pragma unroll
    for (int qt = 0; qt < 2; ++qt)
#pragma unroll
        for (int dt = 0; dt < 4; ++dt) { const f32x4m of = OFL[(qt * 4 + dt) * 64]; u32x2_t o; o.x = pk_bf16(of[0], of[1]); o.y = pk_bf16(of[2], of[3]);
            *(u32x2_t*)(MIX + (mb + 64 * i + tok[qt]) * D + 512 + 64 * (4 * g + (fr & 3)) + 16 * dt + 4 * fq) = o; }
}
__device__ __forceinline__ void nsa_units(const P& p, LAS unsigned char* lds, int l, int vcu, int G) {
    for (int u = vcu; u < NB * 2 * NSEL; u += G) { const int k = u >> 8, v = u & 255, bg = v >> 3, r8 = v & 7;
        const int i = k == 0 ? 31 - r8 : (k == 1 ? 16 + r8 : (k == 2 ? 15 - r8 : r8));
        nsa_unit(p, lds, l, bg >> 1, bg & 1, i); }
}
constexpr int MOE_TAB = 131072;
constexpr size_t WS_ACT = WS_Z;
static_assert((size_t)(M + 24 * 256) * 1024 * 2 <= (size_t)M * ZW * 2, "ACT must fit inside Z");
__device__ __forceinline__ void moe_table(const P& p, LAS unsigned char* lds, int l) {
    LAS int* tab = LDSP(int, MOE_TAB);
    if (tid_fresh() == 0) { int acc = 0; for (int c = 0; c < 24; ++c) { const int n = WSP(int, WS_CTL)[CW_CNT + l * 64 + c]; tab[c] = acc; tab[25 + c] = n; acc += (n + 255) >> 8; } tab[24] = acc; }
    __syncthreads();
}
__device__ __forceinline__ void pair_experts(int cls, int& ea, int& eb) { const int g = cls / 6, pr = cls % 6; const int lo = pr < 3 ? 0 : (pr < 5 ? 1 : 2), hi = pr < 3 ? pr + 1 : (pr < 5 ? pr - 1 : 3); ea = g * 4 + lo; eb = g * 4 + hi; }
template <int NPN> struct MoeSchedBase {
    const P* pp; LAS int* tab; int l, G, c;
    __device__ __forceinline__ bool next(int i, pg8::Unit& u) const {
        int L, hf; if (!pg8::deal_unit(i, G, c, tab[24] * NPN, L, hf)) return false; u.half = hf;
        const int rt = L / NPN; int cls = 0;
        for (int k = 1; k < 24; ++k) cls = (tab[k] <= rt) ? k : cls;
        while (tab[25 + cls] == 0 && cls > 0) --cls;
        u.pm = rt; u.pn = L % NPN; u.aux = cls | ((rt - tab[cls]) << 8); return true;
    }
};
struct MoeSchedA : MoeSchedBase<8> {
    static constexpr bool GATHER = true; static constexpr int GOFF_LDS = MOE_TAB + 1024;
    __device__ __forceinline__ int ktiles() const { return D / 64; }
    __device__ __forceinline__ size_t a_kstep() const { return 128; }
    __device__ __forceinline__ const char* a_base() const { return (const char*)(pp->ws + WS_H); }
    __device__ __forceinline__ unsigned a_off(const pg8::Unit& u, int row, int C) const {
        const P& p = *pp; const int cls = u.aux & 255, slot = (u.aux >> 8) * 256 + row, n = tab[25 + cls];
        const int tok = WSP(int, WS_CTOK)[(size_t)cls * M + (slot < n ? slot : 0)];
        return (unsigned)(tok * D + C) * 2u; }
    __device__ __forceinline__ unsigned b_ld() const { return D * 2u; }
    __device__ __forceinline__ const char* b_tile(const pg8::Unit& u, int t) const {
        int ea, eb; pair_experts(u.aux & 255, ea, eb); const int e = u.pn < 4 ? ea : eb;
        return (const char*)(pp->ws + WS_WGU_T) + ((size_t)(l * 16 + e) * 1024 + (size_t)(u.pn & 3) * 256) * D * 2 + (size_t)t * 128; }
};
struct MoeSchedB : MoeSchedBase<4> {
    static constexpr bool GATHER = false; static constexpr int GOFF_LDS = 0;
    __device__ __forceinline__ int ktiles() const { return 16; }
    __device__ __forceinline__ size_t a_kstep() const { return 128; }
    __device__ __forceinline__ const char* a_base() const { return (const char*)(pp->ws + WS_ACT); }
    __device__ __forceinline__ unsigned a_off(const pg8::Unit& u, int row, int C) const { return (unsigned)((u.pm * 256 + row) * 1024 + C) * 2u; }
    __device__ __forceinline__ unsigned b_ld() const { return 512 * 2u; }
    __device__ __forceinline__ const char* b_tile(const pg8::Unit& u, int t) const {
        int ea, eb; pair_experts(u.aux & 255, ea, eb); const int e = t < 8 ? ea : eb;
        return (const char*)(pp->ws + WS_WD_T) + ((size_t)(l * 16 + e) * D + (size_t)u.pn * 256) * 512 * 2 + (size_t)(t & 7) * 128; }
};
struct EpiMoeA {
    static constexpr bool PERM = true, AFTER_DRAIN = false;
    const P* pp; LAS int* tab;
    __device__ __forceinline__ void operator()(const pg8::f32x4 (&acc)[2][2][4][2], const pg8::Unit& u, int wr, int wc, int fr, int fq) const {
        const P& p = *pp; const int cls = u.aux & 255, s0 = (u.aux >> 8) * 256, n = tab[25 + cls], which = u.pn >> 2;
        bf16* O = WSP(bf16, WS_ACT);
        float wts[2][4];
#pragma unroll
        for (int ai = 0; ai < 2; ++ai)
#pragma unroll
            for (int m = 0; m < 4; ++m) { const int slot = s0 + (u.half ? 0 : ai * 128) + wr * 64 + m * 16 + fr + (u.half == 2 ? 128 : 0); wts[ai][m] = slot < n ? WSP(float, WS_CWT)[((size_t)cls * M + slot) * 2 + which] : 0.f; }
#pragma unroll
        for (int ai = 0; ai < 2; ++ai)
#pragma unroll
            for (int m = 0; m < 4; ++m) { if (ai == 1 && u.half) continue; const int r = ai * 128 + wr * 64 + m * 16 + fr + (u.half == 2 ? 128 : 0);
                const float w = wts[ai][m];
                const pg8::f32x4 g0 = acc[ai][0][m][0], g1 = acc[ai][0][m][1], u0 = acc[ai][1][m][0], u1 = acc[ai][1][m][1];
                float v[8];
#pragma unroll
                for (int j = 0; j < 4; ++j) { v[j] = w * silu_fast(g0[j]) * u0[j]; v[4 + j] = w * silu_fast(g1[j]) * u1[j]; }
                pg8::u32x4 o; o.x = pk_bf16(v[0], v[1]); o.y = pk_bf16(v[2], v[3]); o.z = pk_bf16(v[4], v[5]); o.w = pk_bf16(v[6], v[7]);
                *(pg8::u32x4*)(O + (size_t)(u.pm * 256 + r) * 1024 + u.pn * 128 + wc * 32 + 8 * fq) = o; }
    }
};
struct EpiMoeB {
    static constexpr bool PERM = true, AFTER_DRAIN = false;
    const P* pp; LAS int* tab; int l; bool dry; const bf16* xin; void* xout; bool obf;
    __device__ __forceinline__ void operator()(const pg8::f32x4 (&acc)[2][2][4][2], const pg8::Unit& u, int wr, int wc, int fr, int fq) const {
        const P& p = *pp; const int cls = u.aux & 255, s0 = (u.aux >> 8) * 256, n = dry ? 0 : tab[25 + cls], col0 = u.pn * 256 + wc * 32 + 8 * fq;
        int toks[2][4];
#pragma unroll
        for (int ai = 0; ai < 2; ++ai)
#pragma unroll
            for (int m = 0; m < 4; ++m) { const int slot = s0 + (u.half ? 0 : ai * 128) + wr * 64 + m * 16 + fr + (u.half == 2 ? 128 : 0); toks[ai][m] = slot < n ? WSP(int, WS_CTOK)[(size_t)cls * M + slot] : -1; }
#pragma unroll
        for (int ai = 0; ai < 2; ++ai) { if (ai == 1 && u.half) continue;
#pragma unroll
            for (int mp = 0; mp < 2; ++mp) {
                pg8::u32x4 xw[2][2]; pg8::f32x4 ga[2][2], gb[2][2];
#pragma unroll
                for (int mm = 0; mm < 2; ++mm) { const int tok = toks[ai][2 * mp + mm], tk = tok < 0 ? 0 : tok;
                    const float* gp = WSP(float, WS_MOD) + ((size_t)l * NB + tk / NS) * 6144 + 5120 + col0; const size_t ro = (size_t)tk * D + col0;
#pragma unroll
                    for (int bj = 0; bj < 2; ++bj) { xw[mm][bj] = *(const pg8::u32x4*)(xin + ro + bj * 128); ga[mm][bj] = *(const pg8::f32x4*)(gp + bj * 128); gb[mm][bj] = *(const pg8::f32x4*)(gp + bj * 128 + 4); } }
#pragma unroll
                for (int mm = 0; mm < 2; ++mm) { const int m = 2 * mp + mm, tok = toks[ai][m]; if (tok < 0) continue; const size_t ro = (size_t)tok * D + col0;
#pragma unroll
                    for (int bj = 0; bj < 2; ++bj) { const pg8::u32x4 w = xw[mm][bj];
                        pg8::f32x4 x0 = {__builtin_bit_cast(float, w.x << 16), __builtin_bit_cast(float, w.x & 0xffff0000u), __builtin_bit_cast(float, w.y << 16), __builtin_bit_cast(float, w.y & 0xffff0000u)};
                        pg8::f32x4 x1 = {__builtin_bit_cast(float, w.z << 16), __builtin_bit_cast(float, w.z & 0xffff0000u), __builtin_bit_cast(float, w.w << 16), __builtin_bit_cast(float, w.w & 0xffff0000u)};
                        x0 += ga[mm][bj] * acc[ai][bj][m][0]; x1 += gb[mm][bj] * acc[ai][bj][m][1];
                        if (obf) { pg8::u32x4 o; o.x = pk_bf16(x0[0], x0[1]); o.y = pk_bf16(x0[2], x0[3]); o.z = pk_bf16(x1[0], x1[1]); o.w = pk_bf16(x1[2], x1[3]); *(pg8::u32x4*)((bf16*)xout + ro + bj * 128) = o; }
                        else { *(pg8::f32x4*)((float*)xout + ro + bj * 128) = x0; *(pg8::f32x4*)((float*)xout + ro + bj * 128 + 4) = x1; } } } } }
    }
};
__device__ __forceinline__ void moe_a_phase(const P& p, LAS unsigned char* lds, int l) {
    moe_table(p, lds, l);
    MoeSchedA S; S.pp = &p; S.tab = LDSP(int, MOE_TAB); S.l = l; S.G = grid_fresh(); S.c = bid_fresh();
    EpiMoeA E{&p, LDSP(int, MOE_TAB)}; pg8::gemm_phase(lds, S, E);
}
__device__ __forceinline__ void moe_b_phase(const P& p, LAS unsigned char* lds, int l, bool dry = false, void* xout = nullptr, int obf = -1) {
    if (!xout) xout = p.out;
    if (obf < 0) obf = (l + 1 < NL);
    moe_table(p, lds, l);
    MoeSchedB S; S.pp = &p; S.tab = LDSP(int, MOE_TAB); S.l = l; S.G = grid_fresh(); S.c = bid_fresh();
    EpiMoeB E{&p, LDSP(int, MOE_TAB), l, dry, WSP(bf16, WS_XB), xout, obf != 0}; pg8::gemm_phase(lds, S, E);
}
constexpr int LDS_BYTES = 147456;
struct Args { P p; };
typedef const __attribute__((address_space(4))) P* KargP;
__device__ __forceinline__ KargP p_fresh() { KargP k = (KargP)__builtin_amdgcn_kernarg_segment_ptr(); asm volatile("" : "+s"(k)); return k; }
__device__ __forceinline__ P load_p() { KargP k = p_fresh(); P q; const void* const __attribute__((address_space(4)))* src = (const void* const __attribute__((address_space(4)))*)k; const void** dst = (const void**)&q;
#pragma unroll
    for (int i = 0; i < (int)(sizeof(P) / sizeof(void*)); ++i) dst[i] = src[i];
    return q; }
#define LAYER_BODY(l) do { \
        { const P p = load_p(); norm_phase(p, lds, l ? (const void*)p.out : (const void*)p.x, l != 0, l, 0); } \
        GRID_BAR(); \
        { const P p = load_p(); pg8::StaticSched S; S.init(WSP(bf16, WS_H), WSP(bf16, WS_WIN_T) + (size_t)l * ZW * D, M, ZW, D, grid_fresh(), bid_fresh()); EpiZ E{&p, l}; pg8::gemm_phase(lds, S, E); gl_tail(p, l); } \
        GRID_BAR(); \
        { const P p = load_p(); premix_phase(p, lds, l); } \
        GRID_BAR(); \
        { const P p = load_p(); { const int G_ = grid_fresh(), bx_ = bid_fresh(); nsa_units(p, lds, l, (G_ & 7) == 0 ? (bx_ & 7) * (G_ >> 3) + (bx_ >> 3) : bx_, G_); } }        \
        { const P p = load_p(); for (int u = bid_fresh(); u < NB * 4 * NCH; u += grid_fresh()) ret_out_unit(p, lds, l, u); } \
        GRID_BAR(); \
        { const P p = load_p(); pg8::StaticSched S; S.init(WSP(bf16, WS_MIX), WSP(bf16, WS_WOUT_T) + (size_t)l * D * D, M, D, D, grid_fresh(), bid_fresh()); \
          pg8::EpiResidual E{l ? (const void*)p.out : (const void*)p.x, l != 0, WSP(bf16, WS_XB), WSP(float, WS_MOD) + (size_t)l * NB * 6144 + 2048}; pg8::gemm_phase(lds, S, E); } \
        GRID_BAR(); \
        { const P p = load_p(); norm_phase(p, lds, WSP(bf16, WS_XB), true, l, 1); } \
        GRID_BAR(); \
        { const P p = load_p(); moe_a_phase(p, lds, l); } \
        GRID_BAR(); \
        { const P p = load_p(); moe_b_phase(p, lds, l); } \
} while (0)
__global__ void __launch_bounds__(NTH, 2) fwd_kernel(Args a) {
    extern __shared__ __attribute__((aligned(16))) unsigned char lds_raw[];
    LAS unsigned char* lds = (LAS unsigned char*)lds_raw;
    volatile LAS unsigned* MISC = (volatile LAS unsigned*)(lds + LDS_BYTES - 64);
    if (threadIdx.x < 16) MISC[threadIdx.x] = 0u;
    __syncthreads();
    (void)xcd_barrier_post((unsigned*)(a.p.ws + WS_CTL) + CW_BAR, MISC);
#define GRID_BAR() do { XcdBarrier bar_; bar_.bar = (unsigned*)(load_p().ws + WS_CTL) + CW_BAR; bar_.x = xb_xcc_id(); bar_.st = (volatile LAS unsigned*)(lds + LDS_BYTES - 64); xcd_barrier(bar_); } while (0)
    { const P p = load_p(); p0_prologue(p, lds); }
    GRID_BAR();
    LAYER_BODY(0);
    GRID_BAR();
    LAYER_BODY(1);
}
extern "C" void kernel_launch(void* const* d_in, const int* in_sizes, int n_in, void* d_out, int out_size, void* d_ws, size_t ws_size, hipStream_t stream) {
    static int grid = 0;
    if (grid == 0) {
        int dev = 0, cus = 0, per_cu = 0;
        if (n_in != 26 || out_size != M * D || ws_size < WS_END) { fprintf(stderr, "kernel_launch: unexpected shapes (n_in %d out %d ws %zu need %zu)\n", n_in, out_size, ws_size, (size_t)WS_END); grid = -1; return; }
        if (hipGetDevice(&dev) != hipSuccess || hipDeviceGetAttribute(&cus, hipDeviceAttributeMultiprocessorCount, dev) != hipSuccess) { grid = -1; return; }
        if (hipFuncSetAttribute((const void*)fwd_kernel, hipFuncAttributeMaxDynamicSharedMemorySize, LDS_BYTES) != hipSuccess) { fprintf(stderr, "kernel_launch: hipFuncSetAttribute failed\n"); grid = -1; return; }
        if (hipOccupancyMaxActiveBlocksPerMultiprocessor(&per_cu, (const void*)fwd_kernel, NTH, LDS_BYTES) != hipSuccess || per_cu < 1) { fprintf(stderr, "kernel_launch: occupancy query reports %d workgroups per CU\n", per_cu); per_cu = 1; }
        (void)hipGetLastError();
        grid = cus;
    }
    if (grid < 0) return;
    (void)hipMemsetAsync((char*)d_ws + WS_CTL, 0, 1u << 20, stream);
    Args a{};
    const void** pp = (const void**)&a.p;
    for (int i = 0; i < 26; ++i) pp[i] = d_in[i];
    a.p.out = (float*)d_out; a.p.ws = (unsigned char*)d_ws;
    hipLaunchKernelGGL(fwd_kernel, dim3(grid), dim3(NTH), LDS_BYTES, stream, a);
}
```
